# Optimizing an MI355X kernel written in HIP

```python
import math
import jax, jax.numpy as jnp
from jax import lax
import numpy as np

D_MODEL = 1024
BATCH = 2
SEQ = 8192
DEPTH = 4
DEC_BATCH = 128
DEC_SEQ = 4
PAST_LEN = 8192
PAGE_SIZE = 128

N_MIXERS = 2
N_META = 16
EPS = 1e-6
NEG_INF = -1e30
N_HEADS = 16
HEAD_DIM = D_MODEL // N_HEADS
N_KV_HEADS = 4
GROUP = N_HEADS // N_KV_HEADS
ATT_WIDTH = N_HEADS * HEAD_DIM
KV_WIDTH = N_KV_HEADS * HEAD_DIM
WINDOW = 128
ATT_BLOCK = 128
N_BUCKETS = 32
MAX_DISTANCE = 128
M_PROJ_FACTOR = 2
M_INNER = M_PROJ_FACTOR * D_MODEL
M_HEADS = 4
M_HEAD_DIM = M_INNER // M_HEADS
CONV_WIDTH = 4
MLSTM_CHUNK = 64

kernel_name = 'hybrid_swa_mlstm_meta_decode_step'


def n_layers_of(mixer):
    return len(range(mixer, DEPTH, N_MIXERS))


def rmsnorm(x, w):
    xf = x.astype(jnp.float32)
    y = xf * lax.rsqrt(jnp.mean(xf * xf, axis=-1, keepdims=True) + EPS)
    return (y * w.astype(jnp.float32)).astype(x.dtype)


def rel_bucket(dist):
    n = jnp.maximum(dist, 0)
    max_exact = N_BUCKETS // 2
    nf = jnp.maximum(n, 1).astype(jnp.float32)
    large = max_exact + (jnp.log(nf / max_exact) / math.log(MAX_DISTANCE / max_exact)
                         * (N_BUCKETS - max_exact)).astype(jnp.int32)
    large = jnp.minimum(large, N_BUCKETS - 1)
    return jnp.where(n < max_exact, n, large)


def swa_project(h, w_in, q_norm, k_norm):
    B, T, _ = h.shape
    proj = h @ w_in
    q = proj[..., :ATT_WIDTH].reshape(B, T, N_KV_HEADS, GROUP, HEAD_DIM)
    k = proj[..., ATT_WIDTH:ATT_WIDTH + KV_WIDTH].reshape(B, T, N_KV_HEADS, HEAD_DIM)
    v = proj[..., ATT_WIDTH + KV_WIDTH:ATT_WIDTH + 2 * KV_WIDTH].reshape(B, T, N_KV_HEADS, HEAD_DIM)
    gate = proj[..., ATT_WIDTH + 2 * KV_WIDTH:]
    return rmsnorm(q, q_norm), rmsnorm(k, k_norm), v, gate


def swa_attend(q, k, v, q_pos, k_pos, k_valid, rel_bias, sinks):
    n_blk, t_q = q_pos.shape
    t_k = k_pos.shape[1]
    dist = q_pos[:, :, None] - k_pos[:, None, :]
    mask = k_valid[:, None, :] & (dist >= 0) & ((dist <= WINDOW) | (k_pos[:, None, :] < N_META))
    bias = jnp.transpose(rel_bias.astype(jnp.float32)[rel_bucket(dist)], (0, 3, 1, 2))
    bias = bias.reshape(n_blk, N_KV_HEADS, GROUP, t_q, t_k)
    logits = jnp.einsum('bnqkgd,bnskd->bnkgqs', q, k).astype(jnp.float32) * (HEAD_DIM ** -0.5) + bias[None]
    logits = jnp.where(mask[None, :, None, None], logits, NEG_INF)
    sink = jnp.broadcast_to(sinks.astype(jnp.float32).reshape(1, 1, N_KV_HEADS, GROUP, 1, 1),
                            logits.shape[:-1] + (1,))
    probs = jax.nn.softmax(jnp.concatenate([logits, sink], axis=-1), axis=-1)[..., :-1]
    return jnp.einsum('bnkgqs,bnskd->bnqkgd', probs.astype(v.dtype), v)


def swa_prompt(h, rel_bias, w_in, q_norm, k_norm, sinks, w_out):
    B, T, _ = h.shape
    n_real = T - N_META
    n_blk = n_real // ATT_BLOCK
    q, k, v, gate = swa_project(h, w_in, q_norm, k_norm)
    meta_pos = jnp.arange(N_META, dtype=jnp.int32)
    o_meta = swa_attend(q[:, None, :N_META], k[:, None, :N_META], v[:, None, :N_META],
                        meta_pos[None], meta_pos[None], jnp.ones((1, N_META), bool), rel_bias, sinks)
    qb = q[:, N_META:].reshape(B, n_blk, ATT_BLOCK, N_KV_HEADS, GROUP, HEAD_DIM)

    def band_rows(a):
        cur = a[:, N_META:].reshape(B, n_blk, ATT_BLOCK, N_KV_HEADS, HEAD_DIM)
        prev = jnp.concatenate([jnp.zeros_like(cur[:, :1]), cur[:, :-1]], axis=1)
        meta = jnp.broadcast_to(a[:, None, :N_META], (B, n_blk, N_META, N_KV_HEADS, HEAD_DIM))
        return jnp.concatenate([meta, prev, cur], axis=2)

    blk = jnp.arange(n_blk, dtype=jnp.int32)[:, None]
    q_pos = N_META + blk * ATT_BLOCK + jnp.arange(ATT_BLOCK, dtype=jnp.int32)[None]
    band_pos = N_META + (blk - 1) * ATT_BLOCK + jnp.arange(2 * ATT_BLOCK, dtype=jnp.int32)[None]
    k_pos = jnp.concatenate([jnp.broadcast_to(meta_pos[None], (n_blk, N_META)), band_pos], axis=1)
    k_valid = jnp.concatenate([jnp.ones((n_blk, N_META), bool), band_pos >= N_META], axis=1)
    o_real = swa_attend(qb, band_rows(k), band_rows(v), q_pos, k_pos, k_valid, rel_bias, sinks)
    o = jnp.concatenate([o_meta.reshape(B, N_META, ATT_WIDTH), o_real.reshape(B, n_real, ATT_WIDTH)], axis=1)
    y = (o * jax.nn.silu(gate)) @ w_out
    n_buf = min(WINDOW, T)
    return y, k[:, T - n_buf:], v[:, T - n_buf:], k[:, :N_META], v[:, :N_META]


def swa_sample(h, cache_k, cache_v, meta_k, meta_v, rel_bias, w_in, q_norm, k_norm, sinks, w_out):
    B, T, _ = h.shape
    n_buf = cache_k.shape[1]
    q, k, v, gate = swa_project(h, w_in, q_norm, k_norm)
    win_k = jnp.concatenate([cache_k.astype(k.dtype), k], axis=1)
    win_v = jnp.concatenate([cache_v.astype(v.dtype), v], axis=1)
    keys = jnp.concatenate([meta_k.astype(k.dtype), win_k], axis=1)[:, None]
    vals = jnp.concatenate([meta_v.astype(v.dtype), win_v], axis=1)[:, None]
    buf_pos = PAST_LEN - n_buf + jnp.arange(n_buf, dtype=jnp.int32)
    new_pos = PAST_LEN + jnp.arange(T, dtype=jnp.int32)
    k_pos = jnp.concatenate([jnp.arange(N_META, dtype=jnp.int32), buf_pos, new_pos])[None]
    k_valid = jnp.concatenate([jnp.ones((N_META,), bool), buf_pos >= N_META, jnp.ones((T,), bool)])[None]
    o = swa_attend(q[:, None], keys, vals, new_pos[None], k_pos, k_valid, rel_bias, sinks)
    y = (o.reshape(B, T, ATT_WIDTH) * jax.nn.silu(gate)) @ w_out
    return y, win_k[:, T:], win_v[:, T:]


def mlstm_chunkwise(q, k, v, i_pre, log_f, state, chunk):
    B, T, H, D = q.shape
    n_chunks = T // chunk

    def to_chunks(a):
        return jnp.moveaxis(a.reshape((B, n_chunks, chunk) + a.shape[2:]), 1, 0)

    causal = jnp.tril(jnp.ones((chunk, chunk), bool))

    def step(carry, xs):
        C, n, m = carry
        qc, kc, vc, ic, fc = xs
        b = jnp.cumsum(fc, axis=1)
        g = b[:, -1]
        log_d = b[:, :, None, :] - b[:, None, :, :] + ic[:, None, :, :]
        log_d = jnp.where(causal[None, :, :, None], log_d, -jnp.inf)
        inter = b + m[:, None, :]
        m_t = jnp.maximum(inter, jnp.max(log_d, axis=2))
        w_intra = jnp.exp(log_d - m_t[:, :, None, :])
        w_inter = jnp.exp(inter - m_t)
        s = jnp.einsum('bthd,bjhd->btjh', qc, kc) * w_intra
        num = jnp.einsum('btjh,bjhd->bthd', s, vc) + w_inter[..., None] * jnp.einsum('bthd,bhde->bthe', qc, C)
        den = jnp.sum(s, axis=2) + w_inter * jnp.einsum('bthd,bhd->bth', qc, n)
        h = num / jnp.maximum(jnp.abs(den), jnp.exp(-m_t))[..., None]
        lw = g[:, None, :] - b + ic
        m_new = jnp.maximum(g + m, jnp.max(lw, axis=1))
        wk = jnp.exp(lw - m_new[:, None, :])
        decay = jnp.exp(g + m - m_new)
        C_new = decay[..., None, None] * C + jnp.einsum('bjhd,bjhe->bhde', kc * wk[..., None], vc)
        n_new = decay[..., None] * n + jnp.einsum('bjh,bjhd->bhd', wk, kc)
        return (C_new, n_new, m_new), h

    state, hs = lax.scan(step, state, tuple(to_chunks(a) for a in (q, k, v, i_pre, log_f)))
    return state, jnp.moveaxis(hs, 0, 1).reshape(B, T, H, D)


def mlstm_branch(h, conv_state, cell_state, plan, w_in, conv_w, conv_b, wq, wk, wv,
                 w_gates, b_gates, head_norm, skip, w_out):
    B, T, _ = h.shape
    proj = h @ w_in
    xm, z, o_pre = proj[..., :M_INNER], proj[..., M_INNER:2 * M_INNER], proj[..., 2 * M_INNER:]
    xpad = jnp.concatenate([conv_state.astype(xm.dtype), xm], axis=1)
    xc = jax.nn.silu(sum(xpad[:, w:w + T] * conv_w[w] for w in range(CONV_WIDTH)) + conv_b)
    xc_h = xc.reshape(B, T, M_HEADS, M_HEAD_DIM)
    q = jnp.einsum('bthd,hde->bthe', xc_h, wq)
    k = jnp.einsum('bthd,hde->bthe', xc_h, wk) * (M_HEAD_DIM ** -0.5)
    v = jnp.einsum('bthd,hde->bthe', xm.reshape(B, T, M_HEADS, M_HEAD_DIM), wv)
    gates = (q.reshape(B, T, M_INNER) @ w_gates[:M_INNER]
             + k.reshape(B, T, M_INNER) @ w_gates[M_INNER:2 * M_INNER]
             + v.reshape(B, T, M_INNER) @ w_gates[2 * M_INNER:] + b_gates).astype(jnp.float32)
    i_pre = gates[..., :M_HEADS]
    log_f = jax.nn.log_sigmoid(gates[..., M_HEADS:])
    qf, kf, vf = (a.astype(jnp.float32) for a in (q, k, v))
    state = tuple(s.astype(jnp.float32) for s in cell_state)
    outs, start = [], 0
    for seg_len, chunk in plan:
        seg = slice(start, start + seg_len)
        state, h_seg = mlstm_chunkwise(qf[:, seg], kf[:, seg], vf[:, seg], i_pre[:, seg], log_f[:, seg], state, chunk)
        outs.append(h_seg)
        start += seg_len
    h_cell = jnp.concatenate(outs, axis=1)
    mu = jnp.mean(h_cell, axis=-1, keepdims=True)
    var = jnp.mean(jnp.square(h_cell - mu), axis=-1, keepdims=True)
    h_norm = ((h_cell - mu) * lax.rsqrt(var + EPS)).reshape(B, T, M_INNER) * head_norm.astype(jnp.float32)
    h_out = (jax.nn.sigmoid(o_pre.astype(jnp.float32)) * h_norm).astype(h.dtype)
    y = ((h_out + skip * xc) * jax.nn.silu(z)) @ w_out
    return y, (state[0], state[1], state[2], xpad[:, T:])


def setup_inputs(seed: int = 0) -> dict:
    key = jax.random.key(seed)
    keys = iter(jax.random.split(key, 64))

    def rnd(shape, scale):
        return scale * jax.random.normal(next(keys), shape, jnp.float32)

    n_swa, n_ml = n_layers_of(0), n_layers_of(1)
    n_buf = min(WINDOW, PAST_LEN)
    in_width = 2 * ATT_WIDTH + 2 * KV_WIDTH
    f_bias = jnp.linspace(3.0, 6.0, M_HEADS, dtype=jnp.float32)[None] + rnd((n_ml, M_HEADS), 0.1)
    return {
        'x_prompt': rnd((BATCH, SEQ, D_MODEL), 1.0),
        'x_sample': rnd((DEC_BATCH, DEC_SEQ, D_MODEL), 1.0),
        'cache_swa_k': rnd((n_swa, DEC_BATCH, n_buf, N_KV_HEADS, HEAD_DIM), 1.0),
        'cache_swa_v': rnd((n_swa, DEC_BATCH, n_buf, N_KV_HEADS, HEAD_DIM), 1.0),
        'cache_swa_meta_k': rnd((n_swa, DEC_BATCH, N_META, N_KV_HEADS, HEAD_DIM), 1.0),
        'cache_swa_meta_v': rnd((n_swa, DEC_BATCH, N_META, N_KV_HEADS, HEAD_DIM), 1.0),
        'state_mlstm_c': rnd((n_ml, DEC_BATCH, M_HEADS, M_HEAD_DIM, M_HEAD_DIM), 0.02),
        'state_mlstm_n': rnd((n_ml, DEC_BATCH, M_HEADS, M_HEAD_DIM), 0.02),
        'state_mlstm_m': rnd((n_ml, DEC_BATCH, M_HEADS), 1.0),
        'state_mlstm_conv': rnd((n_ml, DEC_BATCH, CONV_WIDTH - 1, M_INNER), 1.0),
        'meta_tokens': rnd((N_META, D_MODEL), 1.0),
        'rel_bias': rnd((N_BUCKETS, N_HEADS), 0.5),
        'norm_w': 1.0 + rnd((DEPTH, D_MODEL), 0.02),
        'swa_w_in': rnd((n_swa, D_MODEL, in_width), D_MODEL ** -0.5),
        'swa_q_norm': 1.0 + rnd((n_swa, HEAD_DIM), 0.02),
        'swa_k_norm': 1.0 + rnd((n_swa, HEAD_DIM), 0.02),
        'swa_sinks': rnd((n_swa, N_HEADS), 0.5),
        'swa_w_out': rnd((n_swa, ATT_WIDTH, D_MODEL), ATT_WIDTH ** -0.5),
        'mlstm_w_in': rnd((n_ml, D_MODEL, 3 * M_INNER), D_MODEL ** -0.5),
        'mlstm_conv_w': rnd((n_ml, CONV_WIDTH, M_INNER), CONV_WIDTH ** -0.5),
        'mlstm_conv_b': rnd((n_ml, M_INNER), 0.02),
        'mlstm_wq': rnd((n_ml, M_HEADS, M_HEAD_DIM, M_HEAD_DIM), M_HEAD_DIM ** -0.5),
        'mlstm_wk': rnd((n_ml, M_HEADS, M_HEAD_DIM, M_HEAD_DIM), M_HEAD_DIM ** -0.5),
        'mlstm_wv': rnd((n_ml, M_HEADS, M_HEAD_DIM, M_HEAD_DIM), M_HEAD_DIM ** -0.5),
        'mlstm_w_gates': rnd((n_ml, 3 * M_INNER, 2 * M_HEADS), (3 * M_INNER) ** -0.5),
        'mlstm_b_gates': jnp.concatenate([rnd((n_ml, M_HEADS), 0.1), f_bias], axis=-1),
        'mlstm_head_norm': 1.0 + rnd((n_ml, M_INNER), 0.02),
        'mlstm_skip': 1.0 + rnd((n_ml, M_INNER), 0.02),
        'mlstm_w_out': rnd((n_ml, M_INNER, D_MODEL), M_INNER ** -0.5),
    }


def stack_rows(rows, idx):
    return jnp.stack([r[idx] for r in rows])


def reference(x_prompt, x_sample, cache_swa_k, cache_swa_v, cache_swa_meta_k, cache_swa_meta_v,
              state_mlstm_c, state_mlstm_n, state_mlstm_m, state_mlstm_conv,
              meta_tokens, rel_bias, norm_w, swa_w_in, swa_q_norm, swa_k_norm, swa_sinks, swa_w_out,
              mlstm_w_in, mlstm_conv_w, mlstm_conv_b, mlstm_wq, mlstm_wk, mlstm_wv,
              mlstm_w_gates, mlstm_b_gates, mlstm_head_norm, mlstm_skip, mlstm_w_out):
    B, n_real, _ = x_prompt.shape
    meta = jnp.broadcast_to(meta_tokens.astype(x_prompt.dtype)[None], (B, N_META, D_MODEL))
    xp = jnp.concatenate([meta, x_prompt], axis=1)
    xs = x_sample
    prompt_plan = ((N_META, N_META), (n_real, MLSTM_CHUNK))
    sample_plan = ((x_sample.shape[1], x_sample.shape[1]),)
    swa_p, swa_s, ml_p, ml_s = [], [], [], []
    for layer in range(DEPTH):
        j = layer // N_MIXERS
        hp = rmsnorm(xp, norm_w[layer])
        hs = rmsnorm(xs, norm_w[layer])
        if layer % N_MIXERS == 0:
            aw = (swa_w_in[j], swa_q_norm[j], swa_k_norm[j], swa_sinks[j], swa_w_out[j])
            yp, *p_rows = swa_prompt(hp, rel_bias, *aw)
            ys, *s_rows = swa_sample(hs, cache_swa_k[j], cache_swa_v[j], cache_swa_meta_k[j],
                                     cache_swa_meta_v[j], rel_bias, *aw)
            swa_p.append(p_rows)
            swa_s.append(s_rows)
        else:
            mw = (mlstm_w_in[j], mlstm_conv_w[j], mlstm_conv_b[j], mlstm_wq[j], mlstm_wk[j], mlstm_wv[j],
                  mlstm_w_gates[j], mlstm_b_gates[j], mlstm_head_norm[j], mlstm_skip[j], mlstm_w_out[j])
            zero_cell = (jnp.zeros((B, M_HEADS, M_HEAD_DIM, M_HEAD_DIM), jnp.float32),
                         jnp.zeros((B, M_HEADS, M_HEAD_DIM), jnp.float32),
                         jnp.zeros((B, M_HEADS), jnp.float32))
            zero_conv = jnp.zeros((B, CONV_WIDTH - 1, M_INNER), xp.dtype)
            yp, p_rows = mlstm_branch(hp, zero_conv, zero_cell, prompt_plan, *mw)
            ys, s_rows = mlstm_branch(hs, state_mlstm_conv[j],
                                      (state_mlstm_c[j], state_mlstm_n[j], state_mlstm_m[j]), sample_plan, *mw)
            ml_p.append(p_rows)
            ml_s.append(s_rows)
        xp = xp + yp
        xs = xs + ys
    sd = state_mlstm_c.dtype
    return (xp[:, N_META:], xs,
            stack_rows(swa_p, 0), stack_rows(swa_p, 1), stack_rows(swa_p, 2), stack_rows(swa_p, 3),
            stack_rows(ml_p, 0).astype(sd), stack_rows(ml_p, 1).astype(sd), stack_rows(ml_p, 2).astype(sd),
            stack_rows(ml_p, 3),
            stack_rows(swa_s, 0), stack_rows(swa_s, 1),
            stack_rows(ml_s, 0).astype(sd), stack_rows(ml_s, 1).astype(sd), stack_rows(ml_s, 2).astype(sd),
            stack_rows(ml_s, 3))
```

```cpp
#include <hip/hip_runtime.h>
#include <cstdio>
#include <cstring>
#include <cmath>
#define HD __device__ static
#define UNROLL _Pragma("unroll")
#ifndef SEQ
#define SEQ 8192
#endif
#ifndef BATCH
#define BATCH 2
#endif
#ifndef DECB
#define DECB 128
#endif
typedef unsigned short bf16;
constexpr int D = 1024, NMETA = 16, TS = 4, PAST = 8192;
constexpr int NP = BATCH * SEQ, NM = BATCH * NMETA, NS = DECB * TS;
constexpr int ROW_META = NP, ROW_SAMP = NP + NM, NROWS = NP + NM + NS, MPAD = (NROWS + 255) / 256 * 256;
constexpr int SWA_N = 2560, MI = 2048, MH = 4, MD = 512, ML_N = 6144;
constexpr int LCH = 256, NCH = SEQ / LCH + 1;
constexpr int KCN = 160;
constexpr float EPS = 1e-6f;

enum { I_XP = 0, I_XS, I_CK, I_CV, I_CMK, I_CMV, I_SC, I_SN, I_SM, I_SCONV, I_META, I_RELB, I_NORMW, I_SWIN, I_SQN, I_SKN, I_SSINK, I_SWOUT,
       I_MWIN, I_MCW, I_MCB, I_MWQ, I_MWK, I_MWV, I_MWG, I_MBG, I_MHN, I_MSKIP, I_MWOUT, N_IN };
constexpr size_t O_YP = 0, O_YS = O_YP + (size_t)NP * D, O_PK = O_YS + (size_t)NS * D, O_PV = O_PK + (size_t)2 * BATCH * 128 * 256,
    O_PMK = O_PV + (size_t)2 * BATCH * 128 * 256, O_PMV = O_PMK + (size_t)2 * BATCH * 16 * 256, O_PC = O_PMV + (size_t)2 * BATCH * 16 * 256,
    O_PN = O_PC + (size_t)2 * BATCH * 4 * 512 * 512, O_PM = O_PN + (size_t)2 * BATCH * 4 * 512, O_PCONV = O_PM + (size_t)2 * BATCH * 4,
    O_SK = O_PCONV + (size_t)2 * BATCH * 3 * 2048, O_SV = O_SK + (size_t)2 * DECB * 128 * 256, O_SCC = O_SV + (size_t)2 * DECB * 128 * 256,
    O_SNN = O_SCC + (size_t)2 * DECB * 4 * 512 * 512, O_SMM = O_SNN + (size_t)2 * DECB * 4 * 512, O_SCONV = O_SMM + (size_t)2 * DECB * 4,
    O_END = O_SCONV + (size_t)2 * DECB * 3 * 2048;
constexpr size_t al(size_t x) { return (x + 255) / 256 * 256; }
constexpr size_t W_CTL = 0;
constexpr size_t W_X = 1u << 20;
constexpr size_t W_XN = W_X + al((size_t)MPAD * D * 4);
constexpr size_t W_SWIN = W_XN + al((size_t)MPAD * D * 2);
constexpr size_t W_SWOUT = W_SWIN + al((size_t)2 * SWA_N * D * 2);
constexpr size_t W_MWIN = W_SWOUT + al((size_t)2 * D * D * 2);
constexpr size_t W_MWQ = W_MWIN + al((size_t)2 * ML_N * D * 2);
constexpr size_t W_MWOUT = W_MWQ + al((size_t)2 * 3 * 4 * 512 * 512 * 2);
constexpr size_t W_G = W_MWOUT + al((size_t)2 * D * MI * 2);
constexpr size_t W_BIAS = W_G + al((size_t)2 * 4096 * 8 * 4);
constexpr size_t W_Q = W_BIAS + al(16 * 132 * 4);
constexpr size_t W_K = W_Q + al((size_t)MPAD * D * 2);
constexpr size_t W_VT = W_K + al((size_t)MPAD * 256 * 2);
constexpr size_t W_GS = W_VT + al((size_t)MPAD * 256 * 2);
constexpr size_t W_OG = W_GS + al((size_t)MPAD * D * 2);
constexpr size_t W_KC = W_OG + al((size_t)MPAD * D * 2);
constexpr size_t W_VTC = W_KC + al((size_t)2 * DECB * KCN * 256 * 2);
constexpr size_t W_XM = W_VTC + al((size_t)2 * DECB * KCN * 256 * 2);
constexpr size_t W_ZS = W_XM + al((size_t)MPAD * MI * 2);
constexpr size_t W_OS = W_ZS + al((size_t)MPAD * MI * 2);
constexpr size_t W_XC = W_OS + al((size_t)MPAD * MI * 2);
constexpr size_t W_GATES = W_XC + al((size_t)MPAD * MI * 2);
constexpr size_t W_MQ = W_GATES + al((size_t)MPAD * 8 * 4);
constexpr size_t W_MK = W_MQ + al((size_t)MPAD * MI * 2);
constexpr size_t W_MKT = W_MK + al((size_t)MPAD * MI * 2);
constexpr size_t W_MVT = W_MKT + al((size_t)MPAD * MI * 2);
constexpr size_t W_SA = W_MVT + al((size_t)(MPAD / 256) * 512 * 2048 * 2);
constexpr size_t W_SCJ = W_SA + al((size_t)MPAD * 4 * 4);
constexpr size_t W_SWI = W_SCJ + al((size_t)MPAD * 4 * 4);
constexpr size_t W_SEM = W_SWI + al((size_t)MPAD * 4 * 4);
constexpr size_t W_SWK = W_SEM + al((size_t)MPAD * 4 * 4);
constexpr size_t W_DEC = W_SWK + al((size_t)MPAD * 4 * 4);
constexpr size_t W_P = W_DEC + al((size_t)(BATCH * 4 * NCH + DECB * 4) * 4);
constexpr size_t W_DENI = W_P + al((size_t)NP * 2048 * 2);
constexpr size_t W_DEN = W_DENI + al((size_t)NP * 16 * 4);
constexpr size_t W_CT = W_DEN + al((size_t)MPAD * 4 * 4);
constexpr size_t W_CST = W_CT + al((size_t)BATCH * 4 * (NCH - 1) * 512 * 512 * 2);
constexpr size_t W_NST = W_CST + al((size_t)BATCH * 4 * 512 * 512 * 4);
constexpr size_t W_NRUN = W_NST + al((size_t)BATCH * 4 * NCH * 512 * 4);
constexpr size_t W_PSM = W_NRUN + al((size_t)BATCH * 4 * 512 * 4);
constexpr size_t W_H = W_PSM + al((size_t)(BATCH + DECB) * 4 * 256 * 4);
constexpr size_t W_A2 = W_H + al((size_t)MPAD * MI * 2);
constexpr size_t W_TMP = W_A2 + al((size_t)MPAD * MI * 2);
constexpr size_t W_END = W_TMP + al((size_t)MPAD * ML_N * 4);
constexpr size_t W_X16 = W_TMP;

struct Params {
    const float* in[N_IN];
    float* out;
    unsigned char* ws;
};
#define WSP(T, off) ((T*)(P.ws + (off)))

HD inline float bf2f(bf16 v) { unsigned u = (unsigned)v << 16; float f; __builtin_memcpy(&f, &u, 4); return f; }
HD inline bf16 f2bf(float f) { unsigned u; __builtin_memcpy(&u, &f, 4); u += 0x7fffu + ((u >> 16) & 1u); return (bf16)(u >> 16); }
HD inline float siluf(float x) { return x / (1.f + expf(-x)); }
HD inline float sigmf(float x) { return 1.f / (1.f + expf(-x)); }
HD inline float logsigf(float x) { return x >= 0.f ? -log1pf(expf(-x)) : x - log1pf(expf(x)); }

HD inline int swa_pos2orig(int n) { const int t = n & ~255, l = n & 255; return t + (((l >> 5) & 3) << 6) + ((l >> 7) << 5) + (l & 31); }
HD inline int swa_orig2pos(int o) { const int t = o & ~255, l = o & 255; return t + (((l >> 5) & 1) << 7) + ((l >> 6) << 5) + (l & 31); }

HD inline size_t vtb_idx(int row, int h, int e) { return ((size_t)(row >> 8) * 512 + e) * 2048 + h * 512 + (row & 255); }
HD inline size_t ctb_idx(int c, int b, int h, int e, int d) { return (((size_t)(c - 1) * BATCH + b) * 512 + e) * 2048 + h * 512 + d; }
HD inline int rel_bucket(int n) {
    if (n < 16) return n;
    int v = 16 + (int)(logf((float)n / 16.f) / 2.0794415416798357f * 16.f);
    return v > 31 ? 31 : v;
}

HD inline int prev_row(int r) {
    if (r < NP) { const int t = r % SEQ; return t > 0 ? r - 1 : ROW_META + (r / SEQ) * NMETA + (NMETA - 1); }
    if (r < ROW_SAMP) { const int i = (r - ROW_META) % NMETA; return i > 0 ? r - 1 : -1; }
    return ((r - ROW_SAMP) % TS) > 0 ? r - 1 : -2;
}

enum { PH_WCONV = 0, PH_GMAT, PH_INITX, PH_CACHE, PH_NORM, PH_S1E, PH_ATT, PH_RESID, PH_M1E, PH_CONV, PH_GATES, PH_SCAL, PH_PMAT, PH_STATE, PH_DEN, PH_NUM,
       PH_SMALLS, PH_SMALLM, PH_HNORM, PH_SWAOUT, PH_FINAL };

HD inline void ph_wconv(const Params& P, long gt, long gs) {
    for (int j = 0; j < 2; ++j) {
        { bf16* dst = WSP(bf16, W_SWIN) + (size_t)j * SWA_N * D; const float* src = P.in[I_SWIN] + (size_t)j * D * SWA_N;
          for (long i = gt; i < (long)SWA_N * D; i += gs) { const int n = (int)(i / D), k = (int)(i % D); dst[i] = f2bf(src[(size_t)k * SWA_N + swa_pos2orig(n)]); } }
        { bf16* dst = WSP(bf16, W_SWOUT) + (size_t)j * D * D; const float* src = P.in[I_SWOUT] + (size_t)j * D * D;
          for (long i = gt; i < (long)D * D; i += gs) { const int n = (int)(i / D), k = (int)(i % D); dst[i] = f2bf(src[(size_t)k * D + n]); } }
        { bf16* dst = WSP(bf16, W_MWIN) + (size_t)j * ML_N * D; const float* src = P.in[I_MWIN] + (size_t)j * D * ML_N;
          for (long i = gt; i < (long)ML_N * D; i += gs) { const int n = (int)(i / D), k = (int)(i % D); dst[i] = f2bf(src[(size_t)k * ML_N + n]); } }
        for (int w = 0; w < 3; ++w) { bf16* dst = WSP(bf16, W_MWQ) + (size_t)(j * 3 + w) * 4 * 512 * 512; const float* src = P.in[I_MWQ + w] + (size_t)j * 4 * 512 * 512;
          const float sc = (w == 1) ? 0.044194173824159216f : 1.f;
          for (long i = gt; i < (long)4 * 512 * 512; i += gs) { const int e = (int)(i >> 11), h = (int)((i >> 9) & 3), d = (int)(i & 511); dst[i] = f2bf(src[((size_t)h * 512 + d) * 512 + e] * sc); } }
        { bf16* dst = WSP(bf16, W_MWOUT) + (size_t)j * D * MI; const float* src = P.in[I_MWOUT] + (size_t)j * MI * D;
          for (long i = gt; i < (long)D * MI; i += gs) { const int n = (int)(i / MI), k = (int)(i % MI); dst[i] = f2bf(src[(size_t)k * D + n]); } }
    }
    { float* bt = WSP(float, W_BIAS); const float* rb = P.in[I_RELB];
      for (long i = gt; i < 16 * 132; i += gs) { const int h = (int)(i / 132), dd = (int)(i % 132); bt[i] = rb[rel_bucket(dd > 128 ? 128 : dd) * 16 + h]; } }
}
HD inline void ph_gmat(const Params& P, long gt, long gs) {
    float* G = WSP(float, W_G);
    for (long i = gt; i < 2L * 4096 * 8; i += gs) {
        const int j = (int)(i / (4096 * 8)), c = (int)((i / 8) % 4096), g = (int)(i % 8);
        const float* wg = P.in[I_MWG] + (size_t)j * 6144 * 8;
        float acc = 0.f;
        if (c < 2048) { const int h = c >> 9, d = c & 511;
            const float* wq = P.in[I_MWQ] + ((size_t)(j * 4 + h) * 512 + d) * 512; const float* wk = P.in[I_MWK] + ((size_t)(j * 4 + h) * 512 + d) * 512;
            float a = 0.f, b = 0.f;
            for (int e = 0; e < 512; ++e) { a += wq[e] * wg[(size_t)(h * 512 + e) * 8 + g]; b += wk[e] * wg[(size_t)(2048 + h * 512 + e) * 8 + g]; }
            acc = a + b * 0.044194173824159216f;
        } else { const int cc = c - 2048, h = cc >> 9, d = cc & 511;
            const float* wv = P.in[I_MWV] + ((size_t)(j * 4 + h) * 512 + d) * 512;
            for (int e = 0; e < 512; ++e) acc += wv[e] * wg[(size_t)(4096 + h * 512 + e) * 8 + g];
        }
        G[i] = acc;
    }
}
HD inline void ph_initx(const Params& P, long gt, long gs) {
    float* X = WSP(float, W_X);
    for (long i = gt; i < (long)MPAD * D; i += gs) { const int r = (int)(i / D), c = (int)(i % D); float v = 0.f;
        if (r < NP) v = P.in[I_XP][i]; else if (r < ROW_SAMP) v = P.in[I_META][(size_t)((r - ROW_META) % NMETA) * D + c]; else if (r < NROWS) v = P.in[I_XS][(size_t)(r - ROW_SAMP) * D + c];
        X[i] = v; }
}
HD inline void ph_cache(const Params& P, long gt, long gs) {
    bf16* KC = WSP(bf16, W_KC); bf16* VTC = WSP(bf16, W_VTC);
    for (long i = gt; i < 2L * DECB * KCN * 256; i += gs) {
        const int c = (int)(i % 256), key = (int)((i / 256) % KCN); const long jb = i / (256 * KCN);
        float kv = 0.f, vv = 0.f;
        if (key < 16) { kv = P.in[I_CMK][((size_t)jb * 16 + key) * 256 + c]; vv = P.in[I_CMV][((size_t)jb * 16 + key) * 256 + c]; }
        else if (key < 144) { kv = P.in[I_CK][((size_t)jb * 128 + key - 16) * 256 + c]; vv = P.in[I_CV][((size_t)jb * 128 + key - 16) * 256 + c]; }
        { KC[i] = f2bf(kv); VTC[((size_t)jb * 256 + c) * KCN + key] = f2bf(vv); }
    }
    for (long i = gt; i < 2L * DECB * 124 * 256; i += gs) { const int c = (int)(i % 256), key = (int)((i / 256) % 124); const long jb = i / (256 * 124);
        P.out[O_SK + ((size_t)jb * 128 + key) * 256 + c] = P.in[I_CK][((size_t)jb * 128 + key + 4) * 256 + c];
        P.out[O_SV + ((size_t)jb * 128 + key) * 256 + c] = P.in[I_CV][((size_t)jb * 128 + key + 4) * 256 + c]; }
}
HD inline void ph_norm(const Params& P, int layer, long gt, long gs) {
    const float* X = WSP(float, W_X); bf16* XN = WSP(bf16, W_XN); const float* w = P.in[I_NORMW] + (size_t)layer * D;
    for (long r = gt; r < MPAD; r += gs) {
        const float* x = X + (size_t)r * D; bf16* o = XN + (size_t)r * D;
        if (r >= NROWS) { for (int c = 0; c < D; ++c) o[c] = 0; continue; }
        float s = 0.f; for (int c = 0; c < D; ++c) s += x[c] * x[c];
        const float rs = 1.f / sqrtf(s / D + EPS);
        for (int c = 0; c < D; ++c) o[c] = f2bf(x[c] * rs * w[c]);
    }
}
HD inline void swa_store_kv(const Params& P, int j, int r, int kvh, int d, float val, bool isv) {
    if (!isv) WSP(bf16, W_K)[(size_t)r * 256 + kvh * 64 + d] = f2bf(val); else WSP(bf16, W_VT)[(size_t)(kvh * 64 + d) * MPAD + r] = f2bf(val);
}
HD inline void ph_swaout(const Params& P, int j, long gt, long gs) {
    const bf16* K = WSP(bf16, W_K); const bf16* VT = WSP(bf16, W_VT);
    constexpr int NOR = BATCH * 128 + NM + NS;
    for (long i = gt; i < (long)NOR * 256; i += gs) { const int c = (int)(i % 256); int q = (int)(i / 256); int r; size_t ok, ov;
        if (q < BATCH * 128) { const int b = q / 128, tt = q % 128; r = b * SEQ + SEQ - 128 + tt; ok = O_PK + (((size_t)j * BATCH + b) * 128 + tt) * 256 + c; ov = ok - O_PK + O_PV; }
        else if (q < BATCH * 128 + NM) { q -= BATCH * 128; r = ROW_META + q; ok = O_PMK + ((size_t)j * NM + q) * 256 + c; ov = ok - O_PMK + O_PMV; }
        else { q -= BATCH * 128 + NM; r = ROW_SAMP + q; const int bs = q / TS, t = q % TS; ok = O_SK + (((size_t)j * DECB + bs) * 128 + 124 + t) * 256 + c; ov = ok - O_SK + O_SV; }
        P.out[ok] = bf2f(K[(size_t)r * 256 + c]); P.out[ov] = bf2f(VT[(size_t)c * MPAD + r]); }
}
HD inline void ph_s1e(const Params& P, int j, long gt, long gs) {
    const float* T = WSP(float, W_TMP);
    for (long i = gt; i < (long)MPAD * 40; i += gs) {
        const int r = (int)(i / 40), g = (int)(i % 40);
        float x[64];
        UNROLL for (int d = 0; d < 64; ++d) x[d] = T[(size_t)r * SWA_N + swa_orig2pos(g * 64 + d)];
        if (g < 20) {
            float s = 0.f; UNROLL for (int d = 0; d < 64; ++d) s += x[d] * x[d];
            const float rs = 1.f / sqrtf(s / 64.f + EPS);
            if (g < 16) { const float* qn = P.in[I_SQN] + j * 64; bf16* Q = WSP(bf16, W_Q) + (size_t)r * D + g * 64;
                UNROLL for (int d = 0; d < 64; ++d) Q[d] = f2bf(x[d] * rs * qn[d] * 0.125f); }
            else { const float* kn = P.in[I_SKN] + j * 64; UNROLL for (int d = 0; d < 64; ++d) swa_store_kv(P, j, r, g - 16, d, x[d] * rs * kn[d], false); }
        } else if (g < 24) { UNROLL for (int d = 0; d < 64; ++d) swa_store_kv(P, j, r, g - 20, d, x[d], true); }
        else { bf16* GS = WSP(bf16, W_GS) + (size_t)r * D + (g - 24) * 64; UNROLL for (int d = 0; d < 64; ++d) GS[d] = f2bf(siluf(x[d])); }
    }
}
HD inline void att_key(const bf16* kp, const bf16* vp, long vstride, const bf16* q, float bias, float& m, float& l, float* o) {
    float s = 0.f; UNROLL for (int d = 0; d < 64; ++d) s += bf2f(q[d]) * bf2f(kp[d]);
    s += bias;
    if (s > m) { const float c = expf(m - s); l *= c; UNROLL for (int d = 0; d < 64; ++d) o[d] *= c; m = s; }
    const float p = expf(s - m); l += p;
    UNROLL for (int d = 0; d < 64; ++d) o[d] += p * bf2f(vp[(size_t)d * vstride]);
}
HD inline void ph_att(const Params& P, int j, long gt, long gs) {
    const bf16* Q = WSP(bf16, W_Q); const bf16* K = WSP(bf16, W_K); const bf16* VT = WSP(bf16, W_VT); const float* BT = WSP(float, W_BIAS);
    const bf16* GS = WSP(bf16, W_GS); bf16* OG = WSP(bf16, W_OG);
    for (long i = gt; i < (long)NROWS * 16; i += gs) {
        const int r = (int)(i / 16), h = (int)(i % 16), kvh = h >> 2;
        float o[64]; UNROLL for (int d = 0; d < 64; ++d) o[d] = 0.f; const bf16* q = Q + (size_t)r * D + h * 64;
        float m = P.in[I_SSINK][j * 16 + h], l = 1.f; const float* bt = BT + h * 132;
        if (r < ROW_SAMP) {
            int b, pos; if (r < NP) { b = r / SEQ; pos = r % SEQ + 16; } else { b = (r - ROW_META) / NMETA; pos = (r - ROW_META) % NMETA; }
            for (int mi = 0; mi < 16 && mi <= pos; ++mi) { const int kr = ROW_META + b * NMETA + mi; const int dist = pos - mi;
                att_key(K + (size_t)kr * 256 + kvh * 64, VT + (size_t)(kvh * 64) * MPAD + kr, MPAD, q, bt[dist > 128 ? 128 : dist], m, l, o); }
            if (r < NP) { const int t = pos - 16; for (int t2 = (t > 128 ? t - 128 : 0); t2 <= t; ++t2) { const int kr = b * SEQ + t2;
                att_key(K + (size_t)kr * 256 + kvh * 64, VT + (size_t)(kvh * 64) * MPAD + kr, MPAD, q, bt[t - t2], m, l, o); } }
        } else {
            const int bs = (r - ROW_SAMP) / TS, t = (r - ROW_SAMP) % TS;
            const bf16* kc = WSP(bf16, W_KC) + ((size_t)j * DECB + bs) * KCN * 256 + kvh * 64; const bf16* vc = WSP(bf16, W_VTC) + (((size_t)j * DECB + bs) * 256 + kvh * 64) * KCN;
            for (int key = 0; key < 148; ++key) {
                int dist; if (key < 16) dist = PAST + t - key; else if (key < 144) { dist = 128 + t - (key - 16); if (dist > 128) continue; } else { dist = t - (key - 144); if (dist < 0) continue; }
                if (key < 144) att_key(kc + (size_t)key * 256, vc + key, KCN, q, bt[dist > 128 ? 128 : dist], m, l, o);
                else { const int kr = ROW_SAMP + bs * TS + (key - 144); att_key(K + (size_t)kr * 256 + kvh * 64, VT + (size_t)(kvh * 64) * MPAD + kr, MPAD, q, bt[dist], m, l, o); } }
        }
        const float inv = 1.f / l;
        UNROLL for (int d = 0; d < 64; ++d) OG[(size_t)r * D + h * 64 + d] = f2bf(o[d] * inv * bf2f(GS[(size_t)r * D + h * 64 + d]));
    }
}
HD inline void ph_resid(const Params& P, int last, long gt, long gs) {
    float* X = WSP(float, W_X); const float* T = WSP(float, W_TMP);
    for (long i = gt; i < (long)NROWS * D; i += gs) { const float v = X[i] + T[i]; X[i] = v;
        if (last) { const int r = (int)(i / D); if (r < NP) P.out[O_YP + i] = v; else if (r >= ROW_SAMP) P.out[O_YS + (i - (size_t)ROW_SAMP * D)] = v; } }
}
HD inline void ph_m1e(const Params& P, int j, long gt, long gs) {
    const float* T = WSP(float, W_TMP); bf16* XM = WSP(bf16, W_XM); bf16* ZS = WSP(bf16, W_ZS); bf16* OS = WSP(bf16, W_OS);
    for (long i = gt; i < (long)MPAD * ML_N; i += gs) { const int r = (int)(i / ML_N), c = (int)(i % ML_N); const float v = T[i];
        if (c < 2048) { XM[(size_t)r * MI + c] = f2bf(v);
            if (r < NP) { const int b = r / SEQ, t = r % SEQ; if (t >= SEQ - 3) P.out[O_PCONV + (((size_t)j * BATCH + b) * 3 + (t - (SEQ - 3))) * 2048 + c] = v; }
            else if (r >= ROW_SAMP && r < NROWS) { const int bs = (r - ROW_SAMP) / TS, t = (r - ROW_SAMP) % TS; if (t >= 1) P.out[O_SCONV + (((size_t)j * DECB + bs) * 3 + (t - 1)) * 2048 + c] = v; } }
        else if (c < 4096) ZS[(size_t)r * MI + c - 2048] = f2bf(siluf(v));
        else OS[(size_t)r * MI + c - 4096] = f2bf(sigmf(v)); }
}
HD inline float conv_in(const Params& P, int j, int r, int back, int c) {
    int rr = r;
    for (int s = 0; s < back; ++s) { const int p = prev_row(rr);
        if (p == -1) return 0.f;
        if (p == -2) { const int bs = (r - ROW_SAMP) / TS; const int remaining = back - s;
            return P.in[I_SCONV][(((size_t)j * DECB + bs) * 3 + (3 - remaining)) * 2048 + c]; }
        rr = p; }
    return bf2f(WSP(bf16, W_XM)[(size_t)rr * MI + c]);
}
HD inline void ph_conv(const Params& P, int j, long gt, long gs) {
    bf16* XC = WSP(bf16, W_XC); const float* cw = P.in[I_MCW] + (size_t)j * 4 * 2048; const float* cb = P.in[I_MCB] + (size_t)j * 2048;
    for (long i = gt; i < (long)MPAD * MI; i += gs) { const int r = (int)(i / MI), c = (int)(i % MI);
        if (r >= NROWS) { XC[i] = 0; continue; }
        float a = cb[c];
        for (int w = 0; w < 4; ++w) a += conv_in(P, j, r, 3 - w, c) * cw[w * 2048 + c];
        XC[i] = f2bf(siluf(a)); }
}
HD inline void ph_gates(const Params& P, int j, long gt, long gs) {
    const bf16* XC = WSP(bf16, W_XC); const bf16* XM = WSP(bf16, W_XM); const float* G = WSP(float, W_G) + (size_t)j * 4096 * 8; float* GA = WSP(float, W_GATES);
    for (long i = gt; i < (long)NROWS * 8; i += gs) { const int r = (int)(i / 8), g = (int)(i % 8);
        float a = P.in[I_MBG][j * 8 + g];
        for (int c = 0; c < 2048; ++c) a += bf2f(XC[(size_t)r * MI + c]) * G[(size_t)c * 8 + g] + bf2f(XM[(size_t)r * MI + c]) * G[(size_t)(2048 + c) * 8 + g];
        GA[i] = a; }
}
HD inline void scal_chunk(const float* GA, int h, int row0, int L, float& m, float* SA, float* SCJ, float* SWI, float* SEM, float* SWK, float& decay) {
    float b = 0.f, pm = -3.0e38f; const float m_prev = m; float mt = m_prev;
    for (int t = 0; t < L; ++t) { const int r = row0 + t; const float ip = GA[(size_t)r * 8 + h], lf = logsigf(GA[(size_t)r * 8 + 4 + h]);
        b += lf; const float cj = ip - b; pm = cj > pm ? cj : pm; const float mx = m_prev > pm ? m_prev : pm;
        mt = b + mx; SA[r * 4 + h] = -mx; SCJ[r * 4 + h] = cj; SWI[r * 4 + h] = expf(m_prev - mx); SEM[r * 4 + h] = expf(-mt); }
    const float g = b, m_new = mt;
    for (int t = 0; t < L; ++t) { const int r = row0 + t; SWK[r * 4 + h] = expf(g + SCJ[r * 4 + h] - m_new); }
    decay = expf(g + m_prev - m_new); m = m_new;
}
HD inline void ph_scal(const Params& P, int j, long gt, long gs) {
    const float* GA = WSP(float, W_GATES); float* SA = WSP(float, W_SA); float* SCJ = WSP(float, W_SCJ); float* SWI = WSP(float, W_SWI); float* SEM = WSP(float, W_SEM); float* SWK = WSP(float, W_SWK);
    float* DEC = WSP(float, W_DEC);
    for (long i = gt; i < (long)(BATCH + DECB) * 4; i += gs) {
        if (i < BATCH * 4) { const int b = (int)(i / 4), h = (int)(i % 4); float m = 0.f;
            for (int c = 0; c < NCH; ++c) { float dec; const int row0 = c == 0 ? ROW_META + b * NMETA : b * SEQ + (c - 1) * LCH;
                scal_chunk(GA, h, row0, c == 0 ? NMETA : LCH, m, SA, SCJ, SWI, SEM, SWK, dec); DEC[(size_t)i * NCH + c] = dec; }
            P.out[O_PM + (size_t)j * BATCH * 4 + i] = m;
        } else { const long k = i - BATCH * 4; const int bs = (int)(k / 4), h = (int)(k % 4); float m = P.in[I_SM][(size_t)j * DECB * 4 + k]; float dec;
            scal_chunk(GA, h, ROW_SAMP + bs * TS, TS, m, SA, SCJ, SWI, SEM, SWK, dec); DEC[(size_t)BATCH * 4 * NCH + k] = dec;
            P.out[O_SMM + (size_t)j * DECB * 4 + k] = m; }
    }
}
HD inline void ph_pmat(const Params& P, long gt, long gs) {
    const bf16* Q = WSP(bf16, W_MQ); const bf16* K = WSP(bf16, W_MK); const float* SA = WSP(float, W_SA); const float* SCJ = WSP(float, W_SCJ); bf16* PM = WSP(bf16, W_P);
    for (long i = gt; i < (long)NP * 4 * 64; i += gs) { const int j4 = (int)(i % 64) * 4, h = (int)((i / 64) % 4), r = (int)(i / 256);
        const int tt = r % LCH, r0 = r - tt; const bf16* q = Q + (size_t)r * MI + h * 512;
        for (int jj = j4; jj < j4 + 4; ++jj) { float v = 0.f;
            if (jj <= tt) { const bf16* k = K + (size_t)(r0 + jj) * MI + h * 512; float s = 0.f; for (int d = 0; d < 512; ++d) s += bf2f(q[d]) * bf2f(k[d]);
                v = s * expf(SA[r * 4 + h] + SCJ[(r0 + jj) * 4 + h]); }
            PM[(size_t)r * 2048 + h * 512 + jj] = f2bf(v); } }
}
HD inline void ph_state(const Params& P, int j, int c, long gt, long gs) {
    const bf16* KT = WSP(bf16, W_MKT); const bf16* VT = WSP(bf16, W_MVT); const float* SWK = WSP(float, W_SWK); const float* DEC = WSP(float, W_DEC);
    float* CST = WSP(float, W_CST); bf16* CT = WSP(bf16, W_CT); float* NST = WSP(float, W_NST); float* NRUN = WSP(float, W_NRUN);
    const int L = c == 0 ? NMETA : LCH;
    for (long i = gt; i < (long)BATCH * 4 * 512 * 128; i += gs) { const int d4 = (int)(i % 128) * 4, e = (int)((i / 128) % 512), bh = (int)(i / (128 * 512)); const int b = bh / 4, h = bh % 4;
        const int row0 = c == 0 ? ROW_META + b * NMETA : b * SEQ + (c - 1) * LCH; const float dec = DEC[(size_t)bh * NCH + c];
        float acc[4] = {0.f, 0.f, 0.f, 0.f};
        const bf16* vt = VT + vtb_idx(row0, h, e);
        for (int t = 0; t < L; ++t) { const float wv = SWK[(row0 + t) * 4 + h] * bf2f(vt[t]);
            UNROLL for (int u = 0; u < 4; ++u) acc[u] += wv * bf2f(KT[(size_t)(h * 512 + d4 + u) * MPAD + row0 + t]); }
        UNROLL for (int u = 0; u < 4; ++u) { const size_t si = ((size_t)bh * 512 + e) * 512 + d4 + u; const float old = c == 0 ? 0.f : CST[si];
            if (c >= 1) CT[ctb_idx(c, b, h, e, d4 + u)] = f2bf(old);
            const float nv = dec * old + acc[u]; CST[si] = nv;
            if (c == NCH - 1) P.out[O_PC + (((size_t)j * BATCH * 4 + bh) * 512 + d4 + u) * 512 + e] = nv; }
        if (e == 0) UNROLL for (int u = 0; u < 4; ++u) { const int d = d4 + u; float a = 0.f;
            for (int t = 0; t < L; ++t) a += SWK[(row0 + t) * 4 + h] * bf2f(KT[(size_t)(h * 512 + d) * MPAD + row0 + t]);
            const float old = c == 0 ? 0.f : NRUN[bh * 512 + d]; NST[((size_t)bh * NCH + c) * 512 + d] = old; const float nv = dec * old + a; NRUN[bh * 512 + d] = nv;
            if (c == NCH - 1) P.out[O_PN + ((size_t)j * BATCH * 4 + bh) * 512 + d] = nv; }
    }
}
HD inline void ph_den(const Params& P, long gt, long gs) {
    const bf16* Q = WSP(bf16, W_MQ); const bf16* PM = WSP(bf16, W_P); const float* NST = WSP(float, W_NST); const float* SWI = WSP(float, W_SWI); float* DEN = WSP(float, W_DEN);
    for (long i = gt; i < (long)NP * 4; i += gs) { const int r = (int)(i / 4), h = (int)(i % 4), b = r / SEQ, c = (r % SEQ) / LCH + 1, bh = b * 4 + h;
        float s = 0.f; for (int jj = 0; jj < 256; ++jj) s += bf2f(PM[(size_t)r * 2048 + h * 512 + jj]);
        float qn = 0.f; const float* n = NST + ((size_t)bh * NCH + c) * 512; for (int d = 0; d < 512; ++d) qn += bf2f(Q[(size_t)r * MI + h * 512 + d]) * n[d];
        DEN[r * 4 + h] = s + SWI[r * 4 + h] * qn; }
}
HD inline void ph_num(const Params& P, long gt, long gs) {
    const bf16* Q = WSP(bf16, W_MQ); const bf16* PM = WSP(bf16, W_P); const bf16* CT = WSP(bf16, W_CT); const bf16* VT = WSP(bf16, W_MVT);
    const float* SWI = WSP(float, W_SWI); const float* SEM = WSP(float, W_SEM); const float* DEN = WSP(float, W_DEN); bf16* H = WSP(bf16, W_H);
    for (long i = gt; i < (long)NP * 4 * 128; i += gs) { const int e4 = (int)(i % 128) * 4, h = (int)((i / 128) % 4), r = (int)(i / 512); const int b = r / SEQ, tt = r % LCH, r0 = r - tt, c = (r % SEQ) / LCH + 1, bh = b * 4 + h;
        const bf16* q = Q + (size_t)r * MI + h * 512; const bf16* p = PM + (size_t)r * 2048 + h * 512;
        const float wi = SWI[r * 4 + h]; const float den = DEN[r * 4 + h]; const float dd = fmaxf(fabsf(den), SEM[r * 4 + h]);
        UNROLL for (int u = 0; u < 4; ++u) { const int e = e4 + u; const bf16* ct = CT + ctb_idx(c, b, h, e, 0);
            float a = 0.f; for (int d = 0; d < 512; ++d) a += bf2f(q[d]) * bf2f(ct[d]);
            a *= wi; const bf16* vt = VT + vtb_idx(r0, h, e);
            for (int jj = 0; jj <= tt; ++jj) a += bf2f(p[jj]) * bf2f(vt[jj]);
            H[(size_t)r * MI + h * 512 + e] = f2bf(a / dd); } }
}
HD inline void small_item(long it, int& h, int& row0, int& L, bool& samp, int& idx) {
    if (it < BATCH * 4) { idx = (int)(it / 4); h = (int)(it % 4); row0 = ROW_META + idx * NMETA; L = NMETA; samp = false; }
    else { const long k = it - BATCH * 4; idx = (int)(k / 4); h = (int)(k % 4); row0 = ROW_SAMP + idx * TS; L = TS; samp = true; }
}
HD inline void ph_smalls(const Params& P, int j, int only_meta, long gt, long gs) {
    const bf16* Q = WSP(bf16, W_MQ); const bf16* K = WSP(bf16, W_MK); const float* SA = WSP(float, W_SA); const float* SCJ = WSP(float, W_SCJ); const float* SWI = WSP(float, W_SWI);
    float* PSM = WSP(float, W_PSM); float* DEN = WSP(float, W_DEN);
    for (long i = gt; i < (long)(only_meta ? BATCH : BATCH + DECB) * 4 * 16; i += gs) { const long it = i / 16; const int t = (int)(i % 16); int h, row0, L, idx; bool samp; small_item(it, h, row0, L, samp, idx);
        if (t >= L) continue; const int r = row0 + t; const bf16* q = Q + (size_t)r * MI + h * 512; float s = 0.f;
        for (int jj = 0; jj < 16; ++jj) { float v = 0.f;
            if (jj <= t) { const bf16* k = K + (size_t)(row0 + jj) * MI + h * 512; float a = 0.f; for (int d = 0; d < 512; ++d) a += bf2f(q[d]) * bf2f(k[d]); v = a * expf(SA[r * 4 + h] + SCJ[(row0 + jj) * 4 + h]); }
            PSM[(size_t)it * 256 + t * 16 + jj] = v; s += v; }
        float qn = 0.f;
        if (samp) { const float* n = P.in[I_SN] + (((size_t)j * DECB + idx) * 4 + h) * 512; for (int d = 0; d < 512; ++d) qn += bf2f(q[d]) * n[d]; }
        DEN[r * 4 + h] = s + SWI[r * 4 + h] * qn; }
}
HD inline void ph_smallm(const Params& P, int j, int only_meta, long gt, long gs) {
    const bf16* Q = WSP(bf16, W_MQ); const bf16* K = WSP(bf16, W_MK); const bf16* VT = WSP(bf16, W_MVT); const float* PSM = WSP(float, W_PSM);
    const float* SWI = WSP(float, W_SWI); const float* SEM = WSP(float, W_SEM); const float* SWK = WSP(float, W_SWK); const float* DEN = WSP(float, W_DEN); const float* DEC = WSP(float, W_DEC); bf16* H = WSP(bf16, W_H);
    for (long i = gt; i < (long)(only_meta ? BATCH : BATCH + DECB) * 4 * 512; i += gs) { const long it = i / 512; const int x = (int)(i % 512); int h, row0, L, idx; bool samp; small_item(it, h, row0, L, samp, idx);
        float v[16];
        UNROLL for (int t = 0; t < 16; ++t) v[t] = t < L ? bf2f(VT[vtb_idx(row0 + t, h, x)]) : 0.f;
        float acc0 = 0.f, acc1 = 0.f, acc2 = 0.f, acc3 = 0.f;
        if (samp) { const size_t so = (((size_t)j * DECB + idx) * 4 + h) * 512 * 512; const float* cin = P.in[I_SC] + so; float* cout = P.out + O_SCC + so; const float dec = DEC[(size_t)BATCH * 4 * NCH + (it - BATCH * 4)];
            const float wv0 = SWK[(row0 + 0) * 4 + h] * v[0], wv1 = SWK[(row0 + 1) * 4 + h] * v[1], wv2 = SWK[(row0 + 2) * 4 + h] * v[2], wv3 = SWK[(row0 + 3) * 4 + h] * v[3];
            const bf16* q0 = Q + (size_t)row0 * MI + h * 512; const bf16* k0 = K + (size_t)row0 * MI + h * 512;
            for (int d = 0; d < 512; ++d) { const float ci = cin[(size_t)d * 512 + x]; float a = dec * ci;
                acc0 += bf2f(q0[d]) * ci; acc1 += bf2f(q0[MI + d]) * ci; acc2 += bf2f(q0[2 * MI + d]) * ci; acc3 += bf2f(q0[3 * MI + d]) * ci;
                a += wv0 * bf2f(k0[d]) + wv1 * bf2f(k0[MI + d]) + wv2 * bf2f(k0[2 * MI + d]) + wv3 * bf2f(k0[3 * MI + d]);
                cout[(size_t)d * 512 + x] = a; }
            const size_t no = (((size_t)j * DECB + idx) * 4 + h) * 512 + x; float a = dec * P.in[I_SN][no];
            for (int t = 0; t < 4; ++t) a += SWK[(row0 + t) * 4 + h] * bf2f(K[(size_t)(row0 + t) * MI + h * 512 + x]);
            P.out[O_SNN + no] = a; }
        UNROLL for (int t = 0; t < 16; ++t) { if (t < L) { const int r = row0 + t; const float ac = t == 0 ? acc0 : t == 1 ? acc1 : t == 2 ? acc2 : t == 3 ? acc3 : 0.f; float a = SWI[r * 4 + h] * ac;
            UNROLL for (int jj = 0; jj < 16; ++jj) if (jj <= t) a += PSM[(size_t)it * 256 + t * 16 + jj] * v[jj];
            H[(size_t)r * MI + h * 512 + x] = f2bf(a / fmaxf(fabsf(DEN[r * 4 + h]), SEM[r * 4 + h])); } } }
}
HD inline void ph_hnorm(const Params& P, int j, long gt, long gs) {
    const bf16* H = WSP(bf16, W_H); const bf16* OS = WSP(bf16, W_OS); const bf16* XC = WSP(bf16, W_XC); const bf16* ZS = WSP(bf16, W_ZS); bf16* A2 = WSP(bf16, W_A2);
    const float* hn = P.in[I_MHN] + (size_t)j * 2048; const float* sk = P.in[I_MSKIP] + (size_t)j * 2048;
    for (long i = gt; i < (long)MPAD * 4; i += gs) { const int r = (int)(i / 4), h = (int)(i % 4); const size_t o = (size_t)r * MI + h * 512;
        if (r >= NROWS) { for (int e = 0; e < 512; ++e) A2[o + e] = 0; continue; }
        float s = 0.f; for (int e = 0; e < 512; ++e) s += bf2f(H[o + e]); const float mu = s / 512.f;
        float q = 0.f; for (int e = 0; e < 512; ++e) { const float dlt = bf2f(H[o + e]) - mu; q += dlt * dlt; } const float rs = 1.f / sqrtf(q / 512.f + EPS);
        for (int e = 0; e < 512; ++e) { const int c = h * 512 + e; const float y = (bf2f(H[o + e]) - mu) * rs * hn[c];
            A2[o + e] = f2bf((bf2f(OS[o + e]) * y + sk[c] * bf2f(XC[o + e])) * bf2f(ZS[o + e])); } }
}

template <int PH> HD inline void dispatch(const Params& P, int a0, int a1, long gt, long gs) {
    if constexpr (PH == PH_WCONV) ph_wconv(P, gt, gs);
    else if constexpr (PH == PH_GMAT) ph_gmat(P, gt, gs);
    else if constexpr (PH == PH_INITX) ph_initx(P, gt, gs);
    else if constexpr (PH == PH_CACHE) ph_cache(P, gt, gs);
    else if constexpr (PH == PH_NORM) ph_norm(P, a0, gt, gs);
    else if constexpr (PH == PH_S1E) ph_s1e(P, a0, gt, gs);
    else if constexpr (PH == PH_ATT) ph_att(P, a0, gt, gs);
    else if constexpr (PH == PH_RESID) ph_resid(P, a0, gt, gs);
    else if constexpr (PH == PH_M1E) ph_m1e(P, a0, gt, gs);
    else if constexpr (PH == PH_CONV) ph_conv(P, a0, gt, gs);
    else if constexpr (PH == PH_GATES) ph_gates(P, a0, gt, gs);
    else if constexpr (PH == PH_SCAL) ph_scal(P, a0, gt, gs);
    else if constexpr (PH == PH_PMAT) ph_pmat(P, gt, gs);
    else if constexpr (PH == PH_STATE) ph_state(P, a0, a1, gt, gs);
    else if constexpr (PH == PH_DEN) ph_den(P, gt, gs);
    else if constexpr (PH == PH_NUM) ph_num(P, gt, gs);
    else if constexpr (PH == PH_SMALLS) ph_smalls(P, a0, a1, gt, gs);
    else if constexpr (PH == PH_SMALLM) ph_smallm(P, a0, a1, gt, gs);
    else if constexpr (PH == PH_HNORM) ph_hnorm(P, a0, gt, gs);
    else if constexpr (PH == PH_SWAOUT) ph_swaout(P, a0, gt, gs);
}
struct GemmDesc { const bf16* A; const bf16* B; void* C; long lda, ldb, ldc; int M, N, K, mode; };
HD inline void ph_gemm(const GemmDesc& g, long gt, long gs) {
    const int nm = g.M / 4, nn = g.N / 4;
    for (long i = gt; i < (long)nm * nn; i += gs) { const int m0 = (int)(i / nn) * 4, n0 = (int)(i % nn) * 4;
        float acc[4][4]; UNROLL for (int a = 0; a < 4; ++a) UNROLL for (int b = 0; b < 4; ++b) acc[a][b] = 0.f;
        for (int k = 0; k < g.K; k += 8) {
            float av[4][8], bv[4][8];
            UNROLL for (int a = 0; a < 4; ++a) UNROLL for (int kk = 0; kk < 8; ++kk) av[a][kk] = bf2f(g.A[(size_t)(m0 + a) * g.lda + k + kk]);
            UNROLL for (int b = 0; b < 4; ++b) UNROLL for (int kk = 0; kk < 8; ++kk) bv[b][kk] = bf2f(g.B[(size_t)(n0 + b) * g.ldb + k + kk]);
            UNROLL for (int a = 0; a < 4; ++a) UNROLL for (int b = 0; b < 4; ++b) UNROLL for (int kk = 0; kk < 8; ++kk) acc[a][b] += av[a][kk] * bv[b][kk];
        }
        UNROLL for (int a = 0; a < 4; ++a) UNROLL for (int b = 0; b < 4; ++b) { const float v = acc[a][b];
            if (g.mode == 0) ((float*)g.C)[(size_t)(m0 + a) * g.ldc + n0 + b] = v;
            else if (g.mode == 1) ((bf16*)g.C)[(size_t)(m0 + a) * g.ldc + n0 + b] = f2bf(v);
            else ((bf16*)g.C)[(size_t)(n0 + b) * g.ldc + m0 + a] = f2bf(v); }
    }
}
#define LAS __attribute__((address_space(3)))
#define XB_TMO      128
#define XB_XCNT(j)  (256  + 64 * (j))
#define XB_XSUB(j)  (1280 + 64 * (j))
#define XB_XGEN(j)  (2304 + 64 * (j))
#define XB_TOP      3328
#define XB_TOPGEN   3392
#define XCD_BAR_WORDS 3456
#define XB_SPIN_CAP (1u << 24)

__device__ __forceinline__ unsigned xb_ld(unsigned* p)              { return __hip_atomic_load(p, __ATOMIC_RELAXED, __HIP_MEMORY_SCOPE_AGENT); }
__device__ __forceinline__ unsigned xb_add(unsigned* p, unsigned v) { return __hip_atomic_fetch_add(p, v, __ATOMIC_RELAXED, __HIP_MEMORY_SCOPE_AGENT); }
__device__ __forceinline__ unsigned xb_xcc_id() { return (unsigned)__builtin_amdgcn_s_getreg((3 << 11) | 20) & 0xFu; }
#define XB_SPIN(cond, bar) do { unsigned _sp = 0; while (cond) { __builtin_amdgcn_s_sleep(1); \
    if ((++_sp & 255u) == 0u) { if (xb_ld(&(bar)[XB_TMO])) break; if (_sp > XB_SPIN_CAP) { atomicAdd(&(bar)[XB_TMO], 1u); break; } } } } while (0)

struct XcdBarrier {
    unsigned* bar; unsigned x;
    volatile LAS unsigned* st;
};

__device__ __forceinline__ XcdBarrier xcd_barrier_post(unsigned* bar, volatile LAS unsigned* st) {
    XcdBarrier b; b.bar = bar; b.x = xb_xcc_id(); b.st = st;
    if (threadIdx.x == 0) (void)xb_add(&bar[XB_XCNT(b.x)], 1u);
    return b;
}
__device__ __forceinline__ void xcd_barrier_complete(unsigned* bar, unsigned x, unsigned& nloc, unsigned& nx) {
    const unsigned G = gridDim.x * gridDim.y * gridDim.z;
    unsigned sum, cnt, mine, sp = 0u;
    for (;;) {
        sum = 0u; cnt = 0u; mine = 0u;
#pragma unroll
        for (unsigned j = 0; j < 16; ++j) { const unsigned c = xb_ld(&bar[XB_XCNT(j)]); sum += c; cnt += (c > 0u) ? 1u : 0u; mine = (j == x) ? c : mine; }
        if (sum == G) break;
        __builtin_amdgcn_s_sleep(1);
        if ((++sp & 255u) == 0u) { if (xb_ld(&bar[XB_TMO])) break; if (sp > XB_SPIN_CAP) { atomicAdd(&bar[XB_TMO], 1u); break; } }
    }
    nloc = mine > 0u ? mine : 1u; nx = cnt > 0u ? cnt : 1u;
}

__device__ __forceinline__ void xcd_barrier(const XcdBarrier& b) {
    asm volatile("s_waitcnt vmcnt(0)" ::: "memory");
    __syncthreads();
    if (threadIdx.x == 0) {
        unsigned* bar = b.bar;
        __builtin_amdgcn_s_waitcnt(0);
        unsigned nloc = b.st[0], nx = b.st[1];
        if (nloc == 0u) { xcd_barrier_complete(bar, b.x, nloc, nx); b.st[0] = nloc; b.st[1] = nx; }
        const unsigned old = xb_add(&bar[XB_XSUB(b.x)], 1u);
        const unsigned gen = old / nloc;
        if (old + 1u == (gen + 1u) * nloc) {
            __builtin_amdgcn_fence(__ATOMIC_RELEASE, "agent");
            asm volatile("s_waitcnt vmcnt(0)" ::: "memory");
            const unsigned og = xb_add(&bar[XB_TOP], 1u);
            const unsigned tg = og / nx;
            if (og + 1u == (tg + 1u) * nx) xb_add(&bar[XB_TOPGEN], 1u);
            else XB_SPIN(xb_ld(&bar[XB_TOPGEN]) == tg, bar);
            __builtin_amdgcn_fence(__ATOMIC_ACQUIRE, "agent");
            xb_add(&bar[XB_XGEN(b.x)], 1u);
            asm volatile("s_waitcnt vmcnt(0)" ::: "memory");
        } else {
            XB_SPIN(xb_ld(&bar[XB_XGEN(b.x)]) == gen, bar);
            __builtin_amdgcn_fence(__ATOMIC_ACQUIRE, "agent");
            asm volatile("s_waitcnt vmcnt(0)" ::: "memory");
        }
    }
    __syncthreads();
}

#define WSP2(PP, T, off) ((T*)((PP).ws + (off)))
namespace pg8 {
typedef short bf16x8 __attribute__((ext_vector_type(8)));
typedef float f32x4 __attribute__((ext_vector_type(4)));
typedef unsigned u32x2 __attribute__((ext_vector_type(2)));
constexpr int BM = 256, BK = 64, HALF = 128, HTB = HALF * BK * 2, STAGE_BYTES = 8 * HTB;
__device__ __forceinline__ int lds_byte(int r, int c) { const int st = (r >> 4) * 2 + (c >> 5), rr = r & 15, cc = c & 31, ob = rr * 64 + cc * 2; return st * 1024 + (ob ^ (((ob >> 9) & 1) << 5)); }
__device__ __forceinline__ void stage_rc(int b, int& R, int& C) { const int st = b / 1024, sb = b % 1024, swz = sb ^ (((sb >> 9) & 1) << 5); R = (st >> 1) * 16 + swz / 64; C = (st & 1) * 32 + (swz % 64) / 2; }
__device__ __forceinline__ unsigned cvt_pk_bf16(float lo, float hi) {
    typedef __bf16 b2_t __attribute__((ext_vector_type(2))); typedef float f2_t __attribute__((ext_vector_type(2)));
    const f2_t v = {lo, hi}; const b2_t r = __builtin_convertvector(v, b2_t); return __builtin_bit_cast(unsigned, r); }
__device__ __forceinline__ int perm32(int rho) { const int n = rho >> 4, i = rho & 15; return 8 * (i >> 2) + 4 * n + (i & 3); }
struct Unit { const char* A; const char* B; int pm, pn, aux, nt; };
template <class Epi, class Sched>
__device__ __forceinline__ void gemm_phase(LAS unsigned char* lds, const int lda, const int ldb, const Sched& S, const Epi& E) {
    int tid = threadIdx.x; asm volatile("" : "+v"(tid));
    const int wid = __builtin_amdgcn_readfirstlane(tid >> 6), lane = tid & 63, wr = wid >> 2, wc = wid & 3, fr = lane & 15, fq = lane >> 4;
    unsigned voffA[2], voffB[2];
#pragma unroll
    for (int i = 0; i < 2; ++i) { int R, C; stage_rc(tid * 16 + i * 8192, R, C); const int Rb = Epi::PERM ? ((R & ~31) + perm32(R & 31)) : R;
        voffA[i] = (unsigned)(R * lda + C) * 2u; voffB[i] = (unsigned)(Rb * ldb + C) * 2u; }
    const size_t kstep = (size_t)(BK * 2);
    const size_t hstepA = (size_t)HALF * lda * 2, hstepB = (size_t)HALF * ldb * 2;
    const unsigned ldsw = (unsigned)wid * 1024u;
    const int aoff = lds_byte(wr * 64 + fr, fq * 8), boff = lds_byte(wc * 32 + fr, fq * 8);
#define PG8_SA(b, h) (((b) * 2 + (h)) * HTB)
#define PG8_SB(b, h) ((4 + (b) * 2 + (h)) * HTB)
#define PG8_STAGE(bufoff, gbase, voff) do { _Pragma("unroll") for (int _i = 0; _i < 2; ++_i) \
        __builtin_amdgcn_global_load_lds((const unsigned*)((const char*)(gbase) + (voff)[_i]), (LAS unsigned*)(lds + (bufoff) + ldsw + _i * 8192), 16, 0, 0); } while (0)
#define PG8_LDA(dst, b, h) do { _Pragma("unroll") for (int m = 0; m < 4; ++m) _Pragma("unroll") for (int k = 0; k < 2; ++k) dst[m][k] = *(const LAS bf16x8*)(lds + PG8_SA(b, h) + aoff + m * 2048 + k * 1024); } while (0)
#define PG8_LDB(dst, b, h) do { _Pragma("unroll") for (int n = 0; n < 2; ++n) _Pragma("unroll") for (int k = 0; k < 2; ++k) dst[n][k] = *(const LAS bf16x8*)(lds + PG8_SB(b, h) + boff + n * 2048 + k * 1024); } while (0)
#define PG8_MMA(ai, bj, At, Bt) do { __builtin_amdgcn_s_setprio(1); _Pragma("unroll") for (int m = 0; m < 4; ++m) _Pragma("unroll") for (int n = 0; n < 2; ++n) _Pragma("unroll") for (int k = 0; k < 2; ++k) \
        acc[ai][bj][m][n] = __builtin_amdgcn_mfma_f32_16x16x32_bf16(Bt[n][k], At[m][k], acc[ai][bj][m][n], 0, 0, 0); __builtin_amdgcn_s_setprio(0); } while (0)
#define PG8_WAIT_V(n) asm volatile("s_waitcnt vmcnt(" #n ")" ::: "memory")
#define PG8_WAIT_L(n) asm volatile("s_waitcnt lgkmcnt(" #n ")" ::: "memory")
#define PG8_BAR __builtin_amdgcn_s_barrier()
#define PG8_SCHED __builtin_amdgcn_sched_barrier(0)
    Unit cur, nxt; int ui = 0;
    if (!S.next(0, cur)) return;
    f32x4 acc[2][2][4][2];
#pragma unroll
    for (int a = 0; a < 2; ++a)
#pragma unroll
        for (int b = 0; b < 2; ++b)
#pragma unroll
            for (int m = 0; m < 4; ++m)
#pragma unroll
                for (int n = 0; n < 2; ++n) acc[a][b][m][n] = (f32x4){0.f, 0.f, 0.f, 0.f};
    bf16x8 At[4][2], B0[2][2], B1[2][2];
    const char* cA = cur.A; const char* cB = cur.B;
    PG8_STAGE(PG8_SB(0, 0), cB, voffB); PG8_STAGE(PG8_SB(0, 1), cB + hstepB, voffB); PG8_STAGE(PG8_SA(0, 0), cA, voffA); PG8_STAGE(PG8_SA(0, 1), cA + hstepA, voffA);
    if (wr == 1) PG8_BAR;
    PG8_WAIT_V(2); PG8_BAR;
    PG8_STAGE(PG8_SB(1, 0), cB + kstep, voffB); PG8_STAGE(PG8_SA(1, 0), cA + kstep, voffA); PG8_STAGE(PG8_SB(1, 1), cB + hstepB + kstep, voffB);
    PG8_WAIT_V(6); PG8_BAR;
    for (;;) {
        const bool has_next = S.next(ui + 1, nxt);
        const char* nA = has_next ? nxt.A : cA; const char* nB = has_next ? nxt.B : cB; const int nt = cur.nt;
        for (int t = 0; t < nt; t += 2) {
            const bool last = (t == nt - 2);
            const char* a1 = cA + (size_t)(t + 1) * kstep;
            const char* a2 = last ? nA : cA + (size_t)(t + 2) * kstep; const char* b2 = last ? nB : cB + (size_t)(t + 2) * kstep;
            const char* a3 = a2 + kstep; const char* b3 = b2 + kstep;
            PG8_LDB(B0, 0, 0); PG8_LDB(B1, 0, 1); PG8_SCHED; PG8_LDA(At, 0, 0); PG8_STAGE(PG8_SA(1, 1), a1 + hstepA, voffA);
            PG8_WAIT_V(8); PG8_WAIT_L(0); PG8_BAR; PG8_MMA(0, 0, At, B0); PG8_MMA(0, 1, At, B1); PG8_BAR; PG8_SCHED;
            PG8_LDA(At, 0, 1); PG8_STAGE(PG8_SB(0, 0), b2, voffB); PG8_STAGE(PG8_SB(0, 1), b2 + hstepB, voffB); PG8_STAGE(PG8_SA(0, 0), a2, voffA);
            PG8_WAIT_V(8); PG8_WAIT_L(0); PG8_BAR; PG8_MMA(1, 0, At, B0); PG8_MMA(1, 1, At, B1); PG8_BAR; PG8_SCHED;
            PG8_LDB(B0, 1, 0); PG8_LDB(B1, 1, 1); PG8_SCHED; PG8_LDA(At, 1, 0); PG8_STAGE(PG8_SA(0, 1), a2 + hstepA, voffA);
            PG8_WAIT_V(8); PG8_WAIT_L(0); PG8_BAR; PG8_MMA(0, 0, At, B0); PG8_MMA(0, 1, At, B1); PG8_BAR; PG8_SCHED;
            PG8_LDA(At, 1, 1); PG8_STAGE(PG8_SB(1, 0), b3, voffB); PG8_STAGE(PG8_SB(1, 1), b3 + hstepB, voffB); PG8_STAGE(PG8_SA(1, 0), a3, voffA);
            PG8_WAIT_V(8); PG8_WAIT_L(0); PG8_BAR; PG8_MMA(1, 0, At, B0); PG8_MMA(1, 1, At, B1); PG8_BAR; PG8_SCHED;
        }
        if (wr == 0) PG8_BAR;
        const bool keep = E(acc, cur, wr, wc, fr, fq);
        if (!has_next) break;
        if (!keep) {
#pragma unroll
        for (int a = 0; a < 2; ++a)
#pragma unroll
            for (int b = 0; b < 2; ++b)
#pragma unroll
                for (int m = 0; m < 4; ++m)
#pragma unroll
                    for (int n = 0; n < 2; ++n) acc[a][b][m][n] = (f32x4){0.f, 0.f, 0.f, 0.f};
        }
        cur = nxt; cA = nA; cB = nB; ++ui;
        if (wr == 1) PG8_BAR;
    }
    PG8_WAIT_V(0);
    PG8_BAR;
#undef PG8_SA
#undef PG8_SB
#undef PG8_STAGE
#undef PG8_LDA
#undef PG8_LDB
#undef PG8_MMA
#undef PG8_WAIT_V
#undef PG8_WAIT_L
#undef PG8_BAR
#undef PG8_SCHED
}
struct PlainOrder {
    const char* A; const char* B; size_t tstepA, tstepB; int nM, nN, nwg, G, c, nt;
    __device__ __forceinline__ void init(const bf16* A_, int lda, const bf16* B_, int ldb, int M, int N, int K, int G_, int c_) { nt = K / BK;
        A = (const char*)A_; B = (const char*)B_; tstepA = (size_t)BM * lda * 2; tstepB = (size_t)BM * ldb * 2; nM = M / BM; nN = N / BM; nwg = nM * nN; G = G_; c = c_; }
    __device__ __forceinline__ bool next(int i, Unit& u) const {
        const long L = (long)i * G + c; if (L >= nwg) return false;
        int wgid = (int)L; { const int q = nwg / 8, r = nwg % 8, xcd = wgid % 8, off = wgid / 8; wgid = (xcd < r ? xcd * (q + 1) : r * (q + 1) + (xcd - r) * q) + off; }
        const int nig = 8 * nN, gid = wgid / nig, fm = gid * 8, gsz = (nM - fm) < 8 ? (nM - fm) : 8;
        u.pm = fm + ((wgid % nig) % gsz); u.pn = (wgid % nig) / gsz; u.aux = 0; u.nt = nt;
        u.A = A + (size_t)u.pm * tstepA; u.B = B + (size_t)u.pn * tstepB; return true;
    }
};
struct SplitTailOrder {
    const char* A; const char* B; size_t tstepA, tstepB; int K, nmain, G, c, nM;
    __device__ __forceinline__ void init(const bf16* A_, int lda, const bf16* B_, int ldb, int K_, int G_, int c_) {
        A = (const char*)A_; B = (const char*)B_; tstepA = (size_t)BM * lda * 2; tstepB = (size_t)BM * ldb * 2; K = K_; nM = NP / BM; nmain = nM * 4; G = G_; c = c_; }
    __device__ __forceinline__ bool next(int i, Unit& u) const {
        const long L = (long)i * G + c;
        if (L < nmain) { int wgid = (int)L; { const int q = nmain / 8, r = nmain % 8, xcd = wgid % 8, off = wgid / 8; wgid = (xcd < r ? xcd * (q + 1) : r * (q + 1) + (xcd - r) * q) + off; }
            const int nig = 8 * 4, gid = wgid / nig, fm = gid * 8, gsz = (nM - fm) < 8 ? (nM - fm) : 8;
            u.pm = fm + ((wgid % nig) % gsz); u.pn = (wgid % nig) / gsz; u.aux = 0; u.nt = K / BK; u.A = A + (size_t)u.pm * tstepA; u.B = B + (size_t)u.pn * tstepB; return true; }
        const int s = (int)(L - nmain); if (s >= (MPAD / BM - nM) * 16) return false;
        const int kq = s & 3; u.pn = (s >> 2) & 3; u.pm = nM + (s >> 4); u.aux = 1; u.nt = K / BK / 4;
        u.A = A + (size_t)u.pm * tstepA + (size_t)kq * (K / 4) * 2; u.B = B + (size_t)u.pn * tstepB + (size_t)kq * (K / 4) * 2; return true;
    }
};
}
namespace pg8 {
__device__ __forceinline__ u32x2 pk4(f32x4 v) { u32x2 w; w.x = cvt_pk_bf16(v[0], v[1]); w.y = cvt_pk_bf16(v[2], v[3]); return w; }
typedef unsigned u32x4e __attribute__((ext_vector_type(4)));
__device__ __forceinline__ u32x4e pk8(f32x4 a, f32x4 b) { u32x4e w; w[0] = cvt_pk_bf16(a[0], a[1]); w[1] = cvt_pk_bf16(a[2], a[3]); w[2] = cvt_pk_bf16(b[0], b[1]); w[3] = cvt_pk_bf16(b[2], b[3]); return w; }
__device__ __forceinline__ float silu_fast(float x) { return x * __builtin_amdgcn_rcpf(1.f + __expf(-x)); }
__device__ __forceinline__ float sigm_fast(float x) { return __builtin_amdgcn_rcpf(1.f + __expf(-x)); }

struct EpiResid {
    static constexpr bool PERM = true;
    const float* xin; bf16* X16; float* X32; float* out; int mode; long dummy_off;
    __device__ __forceinline__ bool operator()(f32x4 (&acc)[2][2][4][2], const Unit& u, int wr, int wc, int fr_, int fq_) const {
        int fr = fr_, fq = fq_; asm volatile("" : "+v"(fr), "+v"(fq));
        const int row0 = u.pm * BM + wr * 64 + fr, col0 = u.pn * BM + wc * 32 + 8 * fq;
        if (u.aux == 1) {
#pragma unroll
            for (int ai = 0; ai < 2; ++ai)
#pragma unroll
                for (int m = 0; m < 4; ++m) { const int row = row0 + ai * HALF + m * 16;
                    if (row < NROWS) { float* ap = X32 + (size_t)row * D + col0 + dummy_off;
#pragma unroll
                        for (int bj = 0; bj < 2; ++bj)
#pragma unroll
                            for (int n = 0; n < 2; ++n)
#pragma unroll
                                for (int e = 0; e < 4; ++e) __hip_atomic_fetch_add(ap + bj * HALF + n * 4 + e, acc[ai][bj][m][n][e], __ATOMIC_RELAXED, __HIP_MEMORY_SCOPE_AGENT); } }
            return false;
        }
#pragma unroll
        for (int ai = 0; ai < 2; ++ai) { f32x4 xv[4][2][2];
#pragma unroll
            for (int m = 0; m < 4; ++m) { const size_t o = (size_t)(row0 + ai * HALF + m * 16) * D + col0;
#pragma unroll
                for (int bj = 0; bj < 2; ++bj) {
                    if (mode == 0) { xv[m][bj][0] = *(const f32x4*)(xin + o + bj * HALF); xv[m][bj][1] = *(const f32x4*)(xin + o + bj * HALF + 4); }
                    else { const u32x4e t = *(const u32x4e*)(X16 + o + bj * HALF);
                        xv[m][bj][0] = (f32x4){__uint_as_float(t[0] << 16), __uint_as_float(t[0] & 0xffff0000u), __uint_as_float(t[1] << 16), __uint_as_float(t[1] & 0xffff0000u)};
                        xv[m][bj][1] = (f32x4){__uint_as_float(t[2] << 16), __uint_as_float(t[2] & 0xffff0000u), __uint_as_float(t[3] << 16), __uint_as_float(t[3] & 0xffff0000u)}; } } }
#pragma unroll
            for (int m = 0; m < 4; ++m) { const size_t o = (size_t)(row0 + ai * HALF + m * 16) * D + col0;
#pragma unroll
                for (int bj = 0; bj < 2; ++bj) { const f32x4 v0 = xv[m][bj][0] + acc[ai][bj][m][0], v1 = xv[m][bj][1] + acc[ai][bj][m][1];
                    if (dummy_off) *(u32x4e*)(X16 + (size_t)NP * D + o + bj * HALF) = pk8(v0, v1);
                    else if (mode == 2) { *(f32x4*)(out + O_YP + o + bj * HALF) = v0; *(f32x4*)(out + O_YP + o + bj * HALF + 4) = v1; }
                    else *(u32x4e*)(X16 + o + bj * HALF) = pk8(v0, v1); } }
            asm volatile("" ::: "memory"); }
        return false;
    }
};
struct EpiSwaIn {
    static constexpr bool PERM = true;
    Params P; int j;
    __device__ __forceinline__ static float rownorm(const f32x4 (&acc)[2][2][4][2], int ai, int m) {
        float ss = 0.f;
#pragma unroll
        for (int bj = 0; bj < 2; ++bj)
#pragma unroll
            for (int n = 0; n < 2; ++n) { const f32x4 x = acc[ai][bj][m][n]; ss += (x[0] * x[0] + x[1] * x[1]) + (x[2] * x[2] + x[3] * x[3]); }
        ss += __shfl_xor(ss, 16); ss += __shfl_xor(ss, 32);
        return 1.f / sqrtf(ss * (1.f / 64.f) + EPS);
    }
    __device__ __forceinline__ bool operator()(f32x4 (&acc)[2][2][4][2], const Unit& u, int wr, int wc, int fr_, int fq_) const {
        int fr = fr_, fq = fq_; asm volatile("" : "+v"(fr), "+v"(fq));
        const int row0 = u.pm * BM + wr * 64 + fr, pn = u.pn;
        if (pn < 5) { const bool isq = pn < 4; const float* nw = (isq ? P.in[I_SQN] : P.in[I_SKN]) + j * 64 + 8 * fq;
            bf16* dst = isq ? WSP(bf16, W_Q) + (size_t)row0 * D + (pn * 4 + wc) * 64 + 8 * fq : WSP(bf16, W_K) + (size_t)row0 * 256 + wc * 64 + 8 * fq; const size_t ld = isq ? D : 256;
            const float sc = isq ? 0.18033688011112042f   : 1.f;
            const f32x4 w00 = *(const f32x4*)(nw), w01 = *(const f32x4*)(nw + 4), w10 = *(const f32x4*)(nw + 32), w11 = *(const f32x4*)(nw + 36);
#pragma unroll
            for (int ai = 0; ai < 2; ++ai)
#pragma unroll
                for (int m = 0; m < 4; ++m) { const float rs = rownorm(acc, ai, m) * sc; bf16* qp = dst + (size_t)(ai * HALF + m * 16) * ld;
                    *(u32x4e*)(qp) = pk8(acc[ai][0][m][0] * w00 * rs, acc[ai][0][m][1] * w01 * rs);
                    *(u32x4e*)(qp + 32) = pk8(acc[ai][1][m][0] * w10 * rs, acc[ai][1][m][1] * w11 * rs); }
        } else if (pn == 5) { bf16* VT = WSP(bf16, W_VT) + (size_t)(wc * 64 + 8 * fq) * MPAD + row0;
#pragma unroll
            for (int ai = 0; ai < 2; ++ai)
#pragma unroll
                for (int m = 0; m < 4; ++m) {
#pragma unroll
                    for (int bj = 0; bj < 2; ++bj)
#pragma unroll
                        for (int n = 0; n < 2; ++n) { const f32x4 v = acc[ai][bj][m][n]; const int dd = 32 * bj + 4 * n;
#pragma unroll
                            for (int e = 0; e < 4; ++e) VT[(size_t)(dd + e) * MPAD + ai * HALF + m * 16] = f2bf(v[e]); } }
        } else { bf16* GS = WSP(bf16, W_GS) + (size_t)row0 * D + (pn - 6) * 256 + wc * 64 + 8 * fq;
#pragma unroll
            for (int ai = 0; ai < 2; ++ai)
#pragma unroll
                for (int m = 0; m < 4; ++m) { bf16* gp = GS + (size_t)(ai * HALF + m * 16) * D;
#pragma unroll
                    for (int bj = 0; bj < 2; ++bj) { f32x4 v0, v1;
#pragma unroll
                        for (int e = 0; e < 4; ++e) { v0[e] = silu_fast(acc[ai][bj][m][0][e]); v1[e] = silu_fast(acc[ai][bj][m][1][e]); }
                        *(u32x4e*)(gp + 32 * bj) = pk8(v0, v1); } }
        }
        return false;
    }
};
struct EpiMlIn {
    static constexpr bool PERM = true;
    Params P; int j;
    __device__ __forceinline__ bool operator()(f32x4 (&acc)[2][2][4][2], const Unit& u, int wr, int wc, int fr_, int fq_) const {
        int fr = fr_, fq = fq_; asm volatile("" : "+v"(fr), "+v"(fq));
        const int row0 = u.pm * BM + wr * 64 + fr, pn = u.pn, kind = pn >> 3, col0 = (pn & 7) * BM + wc * 32 + 8 * fq;
        bf16* dst = kind == 0 ? WSP(bf16, W_XM) : kind == 1 ? WSP(bf16, W_ZS) : WSP(bf16, W_OS);
#pragma unroll
        for (int ai = 0; ai < 2; ++ai)
#pragma unroll
            for (int m = 0; m < 4; ++m) { const int row = row0 + ai * HALF + m * 16; bf16* dp = dst + (size_t)row * MI + col0;
                float* op = nullptr;
                if (kind == 0) { if (row < NP) { const int b = row / SEQ, t = row % SEQ; if (t >= SEQ - 3) op = P.out + O_PCONV + (((size_t)j * BATCH + b) * 3 + (t - (SEQ - 3))) * 2048 + col0; }
                    else if (row >= ROW_SAMP && row < NROWS) { const int bs = (row - ROW_SAMP) / TS, t = (row - ROW_SAMP) % TS; if (t >= 1) op = P.out + O_SCONV + (((size_t)j * DECB + bs) * 3 + (t - 1)) * 2048 + col0; } }
#pragma unroll
                for (int bj = 0; bj < 2; ++bj) { const f32x4 x0 = acc[ai][bj][m][0], x1 = acc[ai][bj][m][1]; f32x4 v0 = x0, v1 = x1;
                    if (kind == 1) {
#pragma unroll
                        for (int e = 0; e < 4; ++e) { v0[e] = silu_fast(x0[e]); v1[e] = silu_fast(x1[e]); } }
                    if (kind == 2) {
#pragma unroll
                        for (int e = 0; e < 4; ++e) { v0[e] = sigm_fast(x0[e]); v1[e] = sigm_fast(x1[e]); } }
                    *(u32x4e*)(dp + bj * HALF) = pk8(v0, v1);
                    if (op) { *(f32x4*)(op + bj * HALF) = x0; *(f32x4*)(op + bj * HALF + 4) = x1; } } }
        return false;
    }
};
struct EpiM3 {
    static constexpr bool PERM = true;
    Params P;
    __device__ __forceinline__ bool operator()(f32x4 (&acc)[2][2][4][2], const Unit& u, int wr, int wc, int fr_, int fq_) const {
        int fr = fr_, fq = fq_; asm volatile("" : "+v"(fr), "+v"(fq));
        const int kind = u.aux >> 2, h = u.aux & 3;
        bf16* C; size_t ldc;
        if (kind == 0) { C = WSP(bf16, W_MQ) + h * 512; ldc = MI; } else if (kind == 1) { C = WSP(bf16, W_MK) + h * 512; ldc = MI; }
        else if (kind == 2) { C = WSP(bf16, W_MKT) + (size_t)h * 512 * MPAD; ldc = MPAD; } else { C = WSP(bf16, W_MVT) + (size_t)u.pn * 512 * 2048 + h * 512; ldc = 2048; }
        const int row0 = u.pm * BM + wr * 64 + fr, col0 = (kind == 3 ? 0 : u.pn * BM) + wc * 32 + 8 * fq;
#pragma unroll
        for (int ai = 0; ai < 2; ++ai)
#pragma unroll
            for (int m = 0; m < 4; ++m) { bf16* dp = C + (size_t)(row0 + ai * HALF + m * 16) * ldc + col0;
#pragma unroll
                for (int bj = 0; bj < 2; ++bj) *(u32x4e*)(dp + bj * HALF) = pk8(acc[ai][bj][m][0], acc[ai][bj][m][1]); }
        return false;
    }
};
struct M3Order {
    const char* XC; const char* XM; const char* W; int ntt, Gp, c, kmode;
    __device__ __forceinline__ bool next(int i, Unit& u) const {
        const int x = c & 7, r = c >> 3, nx = (Gp - x + 7) >> 3, id = i * nx + r;
        if (id >= ntt * 3) return false;
        const int tt = id / 3, kk = id - 3 * tt, kind = kk == 2 ? 3 : kk;
        const int h = x >> 1, half = x & 1;
        const char* act = (kind == 3 ? XM : XC) + ((size_t)tt * 256 * MI + h * 512) * 2;
        const char* w = W + ((size_t)(kind == 0 ? 0 : kind == 3 ? 2 : 1) * 512 * MI + (size_t)half * 256 * MI + h * 512) * 2;
        u.aux = kind * 4 + h; u.nt = 8;
        if (kind < 2) { u.A = act; u.B = w; u.pm = tt; u.pn = half; } else { u.A = w; u.B = act; u.pm = half; u.pn = tt; }
        return true;
    }
};
struct EpiP {
    static constexpr bool PERM = true;
    Params P;
    __device__ __forceinline__ bool operator()(f32x4 (&acc)[2][2][4][2], const Unit& u, int wr, int wc, int fr_, int fq_) const {
        int fr = fr_, fq = fq_; asm volatile("" : "+v"(fr), "+v"(fq));
        const int h = u.aux, r0 = u.pm * BM; const float* SA = WSP(float, W_SA); const float* SCJ = WSP(float, W_SCJ); bf16* PB = WSP(bf16, W_P); float* DENI = WSP(float, W_DENI);
        float cj[2][2][4];
#pragma unroll
        for (int bj = 0; bj < 2; ++bj)
#pragma unroll
            for (int n = 0; n < 2; ++n)
#pragma unroll
                for (int e = 0; e < 4; ++e) cj[bj][n][e] = SCJ[(size_t)(r0 + bj * HALF + wc * 32 + 8 * fq + 4 * n + e) * 4 + h];
#pragma unroll
        for (int ai = 0; ai < 2; ++ai)
#pragma unroll
            for (int m = 0; m < 4; ++m) { const int tl = ai * HALF + wr * 64 + m * 16 + fr; const float at = SA[(size_t)(r0 + tl) * 4 + h]; float s = 0.f;
                bf16* pp = PB + (size_t)(r0 + tl) * 2048 + h * 512 + wc * 32 + 8 * fq;
#pragma unroll
                for (int bj = 0; bj < 2; ++bj) { f32x4 v[2];
#pragma unroll
                    for (int n = 0; n < 2; ++n) { const int j0 = bj * HALF + wc * 32 + 8 * fq + 4 * n;
#pragma unroll
                        for (int e = 0; e < 4; ++e) { v[n][e] = (j0 + e <= tl) ? acc[ai][bj][m][n][e] * __expf(at + cj[bj][n][e]) : 0.f; s += v[n][e]; } }
                    *(u32x4e*)(pp + bj * HALF) = pk8(v[0], v[1]); }
                s += __shfl_xor(s, 16); s += __shfl_xor(s, 32);
                if (fq == 0) DENI[((size_t)(r0 + tl) * 4 + h) * 4 + wc] = s; }
        return false;
    }
};
struct POrder {
    const char* Q; const char* K; int nwg, G, c;
    __device__ __forceinline__ bool next(int i, Unit& u) const {
        const long L = (long)i * G + c; if (L >= nwg) return false;
        const int tt = (int)L >> 2, h = (int)L & 3; const size_t off = ((size_t)tt * 256 * MI + h * 512) * 2;
        u.A = Q + off; u.B = K + off; u.pm = tt; u.pn = 0; u.aux = h; u.nt = 8; return true;
    }
};
struct EpiNum {
    static constexpr bool PERM = true;
    Params P;
    __device__ __forceinline__ bool operator()(f32x4 (&acc)[2][2][4][2], const Unit& u, int wr, int wc, int fr_, int fq_) const {
        int fr = fr_, fq = fq_; asm volatile("" : "+v"(fr), "+v"(fq));
        const int h = u.aux >> 1, seg = u.aux & 1, row0 = u.pm * BM + wr * 64 + fr;
        if (seg == 0) { const float* SWI = WSP(float, W_SWI);
#pragma unroll
            for (int ai = 0; ai < 2; ++ai)
#pragma unroll
                for (int m = 0; m < 4; ++m) { const float wi = SWI[(size_t)(row0 + ai * HALF + m * 16) * 4 + h];
#pragma unroll
                    for (int bj = 0; bj < 2; ++bj)
#pragma unroll
                        for (int n = 0; n < 2; ++n) acc[ai][bj][m][n] *= wi; }
            return true;
        }
        const float* DEN = WSP(float, W_DEN); const float* SEM = WSP(float, W_SEM); bf16* H = WSP(bf16, W_H) + h * 512 + u.pn * BM + wc * 32 + 8 * fq;
#pragma unroll
        for (int ai = 0; ai < 2; ++ai)
#pragma unroll
            for (int m = 0; m < 4; ++m) { const size_t row = row0 + ai * HALF + m * 16; const float inv = 1.f / fmaxf(fabsf(DEN[row * 4 + h]), SEM[row * 4 + h]); bf16* hp = H + row * MI;
#pragma unroll
                for (int bj = 0; bj < 2; ++bj) *(u32x4e*)(hp + bj * HALF) = pk8(acc[ai][bj][m][0] * inv, acc[ai][bj][m][1] * inv); }
        return false;
    }
};
struct NumOrder {
    const char* Q; const char* PB; const char* CT; const char* VT; int njob, G, c;
    __device__ __forceinline__ int job(int k) const { const long L = (long)k * G + c; if (L >= njob) return -1; int id = (int)L; { const int q = njob / 8, r = njob % 8, xcd = id % 8, off = id / 8; id = (xcd < r ? xcd * (q + 1) : r * (q + 1) + (xcd - r) * q) + off; } return id; }
    __device__ __forceinline__ bool next(int i, Unit& u) const {
        const int id = job(i >> 2); if (id < 0) return false;
        const int tt = id >> 2, h = id & 3, half = (i >> 1) & 1, seg = i & 1;
        const int b = tt / (SEQ / 256), c1 = tt % (SEQ / 256) + 1;
        u.pm = tt; u.pn = half; u.aux = h * 2 + seg;
        if (seg == 0) { u.A = Q + ((size_t)tt * 256 * MI + h * 512) * 2; u.B = CT + ctb_idx(c1, b, h, half * 256, 0) * 2; u.nt = 8; }
        else { u.A = PB + ((size_t)tt * 256 * 2048 + h * 512) * 2; u.B = VT + (((size_t)tt * 512 + half * 256) * 2048 + h * 512) * 2; u.nt = 4; }
        return true;
    }
};
}
__device__ __forceinline__ void ph_den_fast(const Params& P, int gw, int ngw, int lane) {
    const bf16* Q = WSP(bf16, W_MQ); const float* NST = WSP(float, W_NST); const float* SWI = WSP(float, W_SWI); const float* DENI = WSP(float, W_DENI); float* DEN = WSP(float, W_DEN);
    const int h = lane >> 4, sub = lane & 15;
    for (int r = gw; r < NP; r += ngw) { const int b = r / SEQ, c = (r % SEQ) / LCH + 1;
        const bf16* q = Q + (size_t)r * MI + h * 512 + sub * 32; const float* n = NST + ((size_t)(b * 4 + h) * NCH + c) * 512 + sub * 32; float a = 0.f;
#pragma unroll
        for (int k = 0; k < 32; k += 8) { const pg8::bf16x8 qv = *(const pg8::bf16x8*)(q + k);
#pragma unroll
            for (int e = 0; e < 8; ++e) a += bf2f((bf16)qv[e]) * n[k + e]; }
        a += __shfl_xor(a, 1); a += __shfl_xor(a, 2); a += __shfl_xor(a, 4); a += __shfl_xor(a, 8);
        if (sub == 0) { const float* dp = DENI + ((size_t)r * 4 + h) * 4; DEN[(size_t)r * 4 + h] = (dp[0] + dp[1]) + (dp[2] + dp[3]) + SWI[(size_t)r * 4 + h] * a; } }
}

namespace st {
typedef short bf16x8 __attribute__((ext_vector_type(8)));
typedef float f32x16 __attribute__((ext_vector_type(16)));
typedef float f32x4 __attribute__((ext_vector_type(4)));
typedef unsigned u32x2 __attribute__((ext_vector_type(2)));
typedef unsigned u32x4 __attribute__((ext_vector_type(4)));
__device__ __forceinline__ bf16x8 scale8(bf16x8 v, const LAS float* w) {
    const f32x4 w0 = *(const LAS f32x4*)w, w1 = *(const LAS f32x4*)(w + 4);
    const u32x4 u = __builtin_bit_cast(u32x4, v); u32x4 r;
    r[0] = pg8::cvt_pk_bf16(__uint_as_float(u[0] << 16) * w0[0], __uint_as_float(u[0] & 0xffff0000u) * w0[1]);
    r[1] = pg8::cvt_pk_bf16(__uint_as_float(u[1] << 16) * w0[2], __uint_as_float(u[1] & 0xffff0000u) * w0[3]);
    r[2] = pg8::cvt_pk_bf16(__uint_as_float(u[2] << 16) * w1[0], __uint_as_float(u[2] & 0xffff0000u) * w1[1]);
    r[3] = pg8::cvt_pk_bf16(__uint_as_float(u[3] << 16) * w1[2], __uint_as_float(u[3] & 0xffff0000u) * w1[3]);
    return __builtin_bit_cast(bf16x8, r);
}
constexpr int ST_STAGE = 65536, ST_WK_OFF = 131072 + 1024;
__device__ __forceinline__ unsigned kkey(unsigned row) { return ((row & 3u) << 2) | ((row >> 2) & 3u); }
__device__ __forceinline__ void st_issue(LAS unsigned char* lds, int buf, const char* kbase, const char* vbase, int wave, int lane) {
    const int rsub = lane >> 4, q = lane & 15;
#pragma unroll
    for (int i = 0; i < 4; ++i) { const int row = wave * 16 + i * 4 + rsub;
        __builtin_amdgcn_global_load_lds((const unsigned*)(kbase + (size_t)row * 4096 + 16 * (q ^ kkey(row))), (LAS unsigned*)(lds + buf * ST_STAGE + (wave * 16 + i * 4) * 256), 16, 0, 0);
        __builtin_amdgcn_global_load_lds((const unsigned*)(vbase + (size_t)row * 4096 + 16 * (q ^ (row & 15))), (LAS unsigned*)(lds + buf * ST_STAGE + 32768 + (wave * 16 + i * 4) * 256), 16, 0, 0); }
}
typedef unsigned short u16x4 __attribute__((ext_vector_type(4)));
__device__ __forceinline__ void state_scan(const Params& P, int j, LAS unsigned char* lds, int w, int tid_) {
    int tid = tid_; asm volatile("" : "+v"(tid));
    const int bh = w >> 4, b = bh >> 2, h = bh & 3, dg = (w >> 2) & 3, eg = w & 3;
    const int wave = __builtin_amdgcn_readfirstlane(tid >> 6), lane = tid & 63, l32 = lane & 31, lh = lane >> 5;
    const int dt = wave >> 1, et = (wave & 1) * 2;
    const int dbase = dg * 128 + dt * 32, ebase = eg * 128 + et * 32;
    const bool do_n = (eg == 0) && ((wave & 1) == 0);
    const bf16* MK = WSP(bf16, W_MK); const bf16* VT = WSP(bf16, W_MVT); const float* SWK = WSP(float, W_SWK); const float* DEC = WSP(float, W_DEC);
    bf16* CT = WSP(bf16, W_CT); float* NST = WSP(float, W_NST);
    LAS float* wk = (LAS float*)(lds + ST_WK_OFF);
    f32x16 acc0, acc1, accn;
#pragma unroll
    for (int i = 0; i < 16; ++i) { acc0[i] = 0.f; acc1[i] = 0.f; accn[i] = 0.f; }
    u32x4 onesu; onesu[0] = onesu[1] = onesu[2] = onesu[3] = 0x3f803f80u; const bf16x8 ones = __builtin_bit_cast(bf16x8, onesu);
    {   const int row0 = ROW_META + b * NMETA;
        if (tid < NMETA) wk[tid] = SWK[(size_t)(row0 + tid) * 4 + h];
        __syncthreads();
        if (do_n && l32 == 0) {
#pragma unroll
            for (int i = 0; i < 16; ++i) NST[((size_t)bh * NCH + 0) * 512 + dbase + 8 * (i >> 2) + 4 * lh + (i & 3)] = 0.f; }
        u32x4 au;
#pragma unroll
        for (int i = 0; i < 4; ++i) { const unsigned lo = MK[(size_t)(row0 + 8 * lh + 2 * i) * MI + h * 512 + dbase + l32], hi = MK[(size_t)(row0 + 8 * lh + 2 * i + 1) * MI + h * 512 + dbase + l32]; au[i] = lo | (hi << 16); }
        const bf16x8 a = scale8(__builtin_bit_cast(bf16x8, au), wk + 8 * lh);
        const bf16* v0 = VT + vtb_idx(row0, h, ebase + l32) + 8 * lh;
        const bf16x8 b0 = *(const bf16x8*)v0, b1 = *(const bf16x8*)(v0 + (size_t)32 * 2048);
        acc0 = __builtin_amdgcn_mfma_f32_32x32x16_bf16(a, b0, acc0, 0, 0, 0); acc1 = __builtin_amdgcn_mfma_f32_32x32x16_bf16(a, b1, acc1, 0, 0, 0);
        if (do_n) accn = __builtin_amdgcn_mfma_f32_32x32x16_bf16(a, ones, accn, 0, 0, 0);
    }
    const int row1 = b * SEQ;
    const char* kcol = (const char*)(MK + h * 512 + dg * 128);
    st_issue(lds, 0, kcol + (size_t)row1 * 4096, (const char*)(VT + vtb_idx(row1, h, eg * 128)), wave, lane);
    unsigned tra[2];
    { const unsigned hh = lane >> 5, blk = (lane >> 4) & 1, q = (lane & 15) >> 2, p = lane & 3;
#pragma unroll
      for (unsigned t = 0; t < 2; ++t) { const unsigned row = 8 * hh + 4 * t + q, ch = 4 * dt + 2 * blk + (p >> 1); tra[t] = 256u * row + 16u * (ch ^ kkey(row)) + 8u * (p & 1); } }
    for (int sidx = 0; sidx < 2 * (NCH - 1); ++sidx) {
        const int c = 1 + (sidx >> 1), half = sidx & 1, row0 = row1 + (c - 1) * LCH, buf = sidx & 1;
        LAS float* wkc = wk + (c & 1) * 256;
        float dec = 1.f;
        if (half == 0) { if (tid < LCH) wkc[tid] = SWK[(size_t)(row0 + tid) * 4 + h]; dec = DEC[(size_t)bh * NCH + c]; }
        asm volatile("s_waitcnt vmcnt(0)" ::: "memory");
        __syncthreads();
        if (sidx + 1 < 2 * (NCH - 1)) { const int tok = row1 + (sidx + 1) * 128;
            st_issue(lds, buf ^ 1, kcol + (size_t)tok * 4096, (const char*)(VT + vtb_idx(tok, h, eg * 128)), wave, lane); }
        if (half == 0) {
#pragma unroll
            for (int g = 0; g < 4; ++g) { u32x2 p0, p1;
                p0.x = pg8::cvt_pk_bf16(acc0[4 * g], acc0[4 * g + 1]); p0.y = pg8::cvt_pk_bf16(acc0[4 * g + 2], acc0[4 * g + 3]);
                p1.x = pg8::cvt_pk_bf16(acc1[4 * g], acc1[4 * g + 1]); p1.y = pg8::cvt_pk_bf16(acc1[4 * g + 2], acc1[4 * g + 3]);
                *(u32x2*)(CT + ctb_idx(c, b, h, ebase + l32, dbase + 8 * g + 4 * lh)) = p0;
                *(u32x2*)(CT + ctb_idx(c, b, h, ebase + 32 + l32, dbase + 8 * g + 4 * lh)) = p1; }
            if (do_n && l32 == 0) {
#pragma unroll
                for (int i = 0; i < 16; ++i) NST[((size_t)bh * NCH + c) * 512 + dbase + 8 * (i >> 2) + 4 * lh + (i & 3)] = accn[i]; }
#pragma unroll
            for (int i = 0; i < 16; ++i) { acc0[i] *= dec; acc1[i] *= dec; accn[i] *= dec; }
        }
        u16x4 kt0[8], kt1[8];
        { const unsigned a0 = (unsigned)(buf * ST_STAGE) + tra[0], a1 = (unsigned)(buf * ST_STAGE) + tra[1];
          asm volatile(
            "ds_read_b64_tr_b16 %0, %16\n\tds_read_b64_tr_b16 %1, %17\n\tds_read_b64_tr_b16 %2, %16 offset:4096\n\tds_read_b64_tr_b16 %3, %17 offset:4096\n\t"
            "ds_read_b64_tr_b16 %4, %16 offset:8192\n\tds_read_b64_tr_b16 %5, %17 offset:8192\n\tds_read_b64_tr_b16 %6, %16 offset:12288\n\tds_read_b64_tr_b16 %7, %17 offset:12288\n\t"
            "ds_read_b64_tr_b16 %8, %16 offset:16384\n\tds_read_b64_tr_b16 %9, %17 offset:16384\n\tds_read_b64_tr_b16 %10, %16 offset:20480\n\tds_read_b64_tr_b16 %11, %17 offset:20480\n\t"
            "ds_read_b64_tr_b16 %12, %16 offset:24576\n\tds_read_b64_tr_b16 %13, %17 offset:24576\n\tds_read_b64_tr_b16 %14, %16 offset:28672\n\tds_read_b64_tr_b16 %15, %17 offset:28672\n\t"
            "s_waitcnt lgkmcnt(0)"
            : "=&v"(kt0[0]), "=&v"(kt1[0]), "=&v"(kt0[1]), "=&v"(kt1[1]), "=&v"(kt0[2]), "=&v"(kt1[2]), "=&v"(kt0[3]), "=&v"(kt1[3]),
              "=&v"(kt0[4]), "=&v"(kt1[4]), "=&v"(kt0[5]), "=&v"(kt1[5]), "=&v"(kt0[6]), "=&v"(kt1[6]), "=&v"(kt0[7]), "=&v"(kt1[7])
            : "v"(a0), "v"(a1) : "memory"); }
        const LAS unsigned char* v0 = lds + buf * ST_STAGE + 32768 + (et * 32 + l32) * 256; const LAS unsigned char* v1 = v0 + 32 * 256;
        const int sw = l32 & 15;
#pragma unroll
        for (int s = 0; s < 8; ++s) { const int slot = ((2 * s + lh) ^ sw) * 16;
            u32x4 au; { const u32x2 x0 = __builtin_bit_cast(u32x2, kt0[s]), x1 = __builtin_bit_cast(u32x2, kt1[s]); au[0] = x0.x; au[1] = x0.y; au[2] = x1.x; au[3] = x1.y; }
            const bf16x8 a = scale8(__builtin_bit_cast(bf16x8, au), wkc + half * 128 + s * 16 + 8 * lh);
            const bf16x8 b0 = *(const LAS bf16x8*)(v0 + slot), b1 = *(const LAS bf16x8*)(v1 + slot);
            acc0 = __builtin_amdgcn_mfma_f32_32x32x16_bf16(a, b0, acc0, 0, 0, 0);
            acc1 = __builtin_amdgcn_mfma_f32_32x32x16_bf16(a, b1, acc1, 0, 0, 0);
            if (do_n) accn = __builtin_amdgcn_mfma_f32_32x32x16_bf16(a, ones, accn, 0, 0, 0); }
    }
    float* oc = P.out + O_PC + ((size_t)j * BATCH * 4 + bh) * 512 * 512;
#pragma unroll
    for (int i = 0; i < 16; ++i) { const int d = dbase + 8 * (i >> 2) + 4 * lh + (i & 3); oc[(size_t)d * 512 + ebase + l32] = acc0[i]; oc[(size_t)d * 512 + ebase + 32 + l32] = acc1[i]; }
    if (do_n && l32 == 0) {
#pragma unroll
        for (int i = 0; i < 16; ++i) P.out[O_PN + ((size_t)j * BATCH * 4 + bh) * 512 + dbase + 8 * (i >> 2) + 4 * lh + (i & 3)] = accn[i]; }
    __syncthreads();
}
}
namespace at {
typedef short bf16x8 __attribute__((ext_vector_type(8)));
typedef float f32x16 __attribute__((ext_vector_type(16)));
typedef unsigned u32x2 __attribute__((ext_vector_type(2)));
typedef unsigned u32x4 __attribute__((ext_vector_type(4)));
constexpr int NI_P = (NP / 32) * 16, NI_M = BATCH * 16, NI_S = DECB * 4, NI = NI_P + NI_M + NI_S;
struct TileSrc { const bf16* k; const bf16* v; int vstride, kbase, thr, off, nval; };
__device__ __forceinline__ void att_phase(const Params& P, int j, LAS unsigned char* lds, int gw, int ngw, int tid_) {
    int tid = tid_; asm volatile("" : "+v"(tid));
    gw = __builtin_amdgcn_readfirstlane(gw);
    const int lane = tid & 63, l32 = lane & 31, lh = lane >> 5;
    LAS float* bt = (LAS float*)lds;
    LAS unsigned char* wl = lds + 16384 + ((tid >> 6) & 7) * 8192;
    { const float* BT = WSP(float, W_BIAS); for (int i = tid; i < 16 * 132; i += 512) bt[i] = BT[i] * 1.4426950408889634f; }
    __syncthreads();
    const bf16* Q = WSP(bf16, W_Q); const bf16* K = WSP(bf16, W_K); const bf16* VT = WSP(bf16, W_VT); const bf16* GS = WSP(bf16, W_GS); bf16* OG = WSP(bf16, W_OG);
    const bf16* KC = WSP(bf16, W_KC) + (size_t)j * DECB * KCN * 256; const bf16* VTC = WSP(bf16, W_VTC) + (size_t)j * DECB * 256 * KCN;
    const float* sinks = P.in[I_SSINK] + j * 16;
    for (int item = gw; item < NI; item += ngw) {
        int kind, b = 0, t0 = 0, bs = 0, h0, nq, pmask, hshift, qrow0, qpos0, ti0 = 0, ti1;
        if (item < NI_P) { kind = 0; const int qb = item >> 4; h0 = item & 15; qrow0 = qb * 32; b = qrow0 / SEQ; t0 = qrow0 % SEQ; nq = 32; pmask = 31; hshift = 5; qpos0 = 16 + t0; ti1 = 6; }
        else if (item < NI_P + NI_M) { kind = 1; const int i2 = item - NI_P; b = i2 >> 4; h0 = i2 & 15; qrow0 = ROW_META + b * NMETA; nq = 16; pmask = 15; hshift = 5; qpos0 = 0; ti1 = 1; }
        else { kind = 2; const int i3 = item - NI_P - NI_M; bs = i3 >> 2; h0 = (i3 & 3) * 4; qrow0 = ROW_SAMP + bs * TS; nq = 16; pmask = 3; hshift = 2; qpos0 = PAST; ti1 = 6; }
        const int kvh = h0 >> 2;
        const int cq = l32 < nq ? l32 : (l32 & (nq - 1));
        const int qrow = qrow0 + (cq & pmask), qhead = h0 + (cq >> hshift), qpos = qpos0 + (cq & pmask);
        auto tile_src = [&](int ti) -> TileSrc { TileSrc s;
            if (kind == 2) { if (ti < 5) { s.k = KC + ((size_t)bs * KCN + 32 * ti) * 256 + kvh * 64; s.v = VTC + ((size_t)bs * 256 + kvh * 64) * KCN + 32 * ti; s.vstride = KCN; s.kbase = 32 * ti; s.thr = 16; s.off = PAST - 128 - 16; s.nval = 144; }
                             else { s.k = K + (size_t)qrow0 * 256 + kvh * 64; s.v = VT + (size_t)(kvh * 64) * MPAD + qrow0; s.vstride = MPAD; s.kbase = PAST; s.thr = 0x7fffffff; s.off = 0; s.nval = PAST + TS; } }
            else if (ti == 0) { const int r = ROW_META + b * NMETA; s.k = K + (size_t)r * 256 + kvh * 64; s.v = VT + (size_t)(kvh * 64) * MPAD + r; s.vstride = MPAD; s.kbase = 0; s.thr = 0x7fffffff; s.off = 0; s.nval = 16; }
            else { const int tk0 = t0 - 128 + 32 * (ti - 1), r = b * SEQ + tk0; s.k = K + (size_t)r * 256 + kvh * 64; s.v = VT + (size_t)(kvh * 64) * MPAD + r; s.vstride = MPAD; s.kbase = 16 + tk0; s.thr = 0x7fffffff; s.off = 0; s.nval = 0x7fffffff; }
            return s; };
        auto next_ti = [&](int ti) -> int { int n = ti + 1; if (kind == 0 && ti == 0 && t0 < 128) n = 1 + (128 - t0) / 32; return n; };
        bf16x8 qf[4];
        { const bf16* qp = Q + (size_t)qrow * D + qhead * 64 + 8 * lh;
#pragma unroll
          for (int s = 0; s < 4; ++s) qf[s] = *(const bf16x8*)(qp + 16 * s); }
        const LAS float* bth = bt + qhead * 132;
        float m = sinks[qhead] * 1.4426950408889634f, l = 1.f;
        f32x16 o0, o1;
#pragma unroll
        for (int i = 0; i < 16; ++i) { o0[i] = 0.f; o1[i] = 0.f; }
        bf16x8 kr[4], vr[4];
        int ti = ti0; TileSrc cur = tile_src(ti);
        auto load_tile = [&](const TileSrc& s) {
            const bf16* kp = s.k + (size_t)(lane >> 3) * 256 + 8 * (lane & 7);
#pragma unroll
            for (int q = 0; q < 4; ++q) kr[q] = *(const bf16x8*)(kp + (size_t)q * 8 * 256);
            const bf16* vp = s.v + (size_t)(lane >> 2) * s.vstride + 8 * (lane & 3);
#pragma unroll
            for (int q = 0; q < 4; ++q) vr[q] = *(const bf16x8*)(vp + (size_t)q * 16 * s.vstride); };
        load_tile(cur);
        while (ti < ti1) {
#pragma unroll
            for (int q = 0; q < 4; ++q) { const int row = 8 * q + (lane >> 3); *(LAS bf16x8*)(wl + row * 128 + 16 * ((lane & 7) ^ ((row >> 1) & 7))) = kr[q]; }
#pragma unroll
            for (int q = 0; q < 4; ++q) { const int row = 16 * q + (lane >> 2); *(LAS bf16x8*)(wl + 4096 + row * 64 + 16 * ((lane & 3) ^ ((row >> 2) & 3))) = vr[q]; }
            const TileSrc me = cur;
            const int tn = next_ti(ti);
            if (tn < ti1) { cur = tile_src(tn); load_tile(cur); }
            bf16x8 kf[4];
#pragma unroll
            for (int s = 0; s < 4; ++s) kf[s] = *(const LAS bf16x8*)(wl + l32 * 128 + 16 * ((2 * s + lh) ^ ((l32 >> 1) & 7)));
            f32x16 sT;
#pragma unroll
            for (int i = 0; i < 16; ++i) sT[i] = 0.f;
#pragma unroll
            for (int s = 0; s < 4; ++s) sT = __builtin_amdgcn_mfma_f32_32x32x16_bf16(kf[s], qf[s], sT, 0, 0, 0);
            bf16x8 va[2][2];
#pragma unroll
            for (int dt = 0; dt < 2; ++dt)
#pragma unroll
                for (int s = 0; s < 2; ++s) { const int row = dt * 32 + l32, key = (row >> 2) & 3; const LAS unsigned char* rp = wl + 4096 + row * 64 + 8 * lh;
                    const u32x2 p0 = *(const LAS u32x2*)(rp + 16 * ((2 * s) ^ key)), p1 = *(const LAS u32x2*)(rp + 16 * ((2 * s + 1) ^ key));
                    u32x4 t; t[0] = p0.x; t[1] = p0.y; t[2] = p1.x; t[3] = p1.y; va[dt][s] = __builtin_bit_cast(bf16x8, t); }
            float mx = m;
            if (kind == 0 && ti >= 2 && ti <= 4) {
                const LAS float* bq = bth + (qpos - me.kbase - 31);
#pragma unroll
                for (int i = 0; i < 16; ++i) { const int kk = 8 * (i >> 2) + 4 * lh + (i & 3); const float sv = sT[i] + bq[31 - kk]; sT[i] = sv; mx = fmaxf(mx, sv); }
            } else {
#pragma unroll
                for (int i = 0; i < 16; ++i) { const int kk = 8 * (i >> 2) + 4 * lh + (i & 3), kg = me.kbase + kk, pos = kg + (kg >= me.thr ? me.off : 0), dist = qpos - pos;
                    const bool vis = (kg < me.nval) && (dist >= 0) && (dist <= 128 || pos < 16);
                    const int di = dist < 0 ? 0 : (dist > 128 ? 128 : dist);
                    const float sv = vis ? sT[i] + bth[di] : -3.0e38f; sT[i] = sv; mx = fmaxf(mx, sv); }
            }
            mx = fmaxf(mx, __shfl_xor(mx, 32));
            float ps = 0.f;
#pragma unroll
            for (int i = 0; i < 16; ++i) { const float p = __builtin_amdgcn_exp2f(sT[i] - mx); sT[i] = p; ps += p; }
            ps += __shfl_xor(ps, 32);
            if (__any(mx > m)) {
                const float corr = __builtin_amdgcn_exp2f(m - mx); m = mx; l *= corr;
#pragma unroll
                for (int i = 0; i < 16; ++i) { o0[i] *= corr; o1[i] *= corr; } }
            l += ps;
#pragma unroll
            for (int s = 0; s < 2; ++s) { u32x4 pk;
#pragma unroll
                for (int q = 0; q < 4; ++q) pk[q] = pg8::cvt_pk_bf16(sT[8 * s + 2 * q], sT[8 * s + 2 * q + 1]);
                const bf16x8 pb = __builtin_bit_cast(bf16x8, pk);
                o0 = __builtin_amdgcn_mfma_f32_32x32x16_bf16(va[0][s], pb, o0, 0, 0, 0);
                o1 = __builtin_amdgcn_mfma_f32_32x32x16_bf16(va[1][s], pb, o1, 0, 0, 0); }
            ti = tn;
        }
        if (l32 < nq) { const float inv = 1.f / l; const size_t ob = (size_t)qrow * D + qhead * 64 + 4 * lh;
#pragma unroll
            for (int g = 0; g < 4; ++g) {
                { const u32x2 gv = *(const u32x2*)(GS + ob + 8 * g); u32x2 w;
                  w.x = pg8::cvt_pk_bf16(o0[4 * g] * inv * __uint_as_float(gv.x << 16), o0[4 * g + 1] * inv * __uint_as_float(gv.x & 0xffff0000u));
                  w.y = pg8::cvt_pk_bf16(o0[4 * g + 2] * inv * __uint_as_float(gv.y << 16), o0[4 * g + 3] * inv * __uint_as_float(gv.y & 0xffff0000u)); *(u32x2*)(OG + ob + 8 * g) = w; }
                { const u32x2 gv = *(const u32x2*)(GS + ob + 32 + 8 * g); u32x2 w;
                  w.x = pg8::cvt_pk_bf16(o1[4 * g] * inv * __uint_as_float(gv.x << 16), o1[4 * g + 1] * inv * __uint_as_float(gv.x & 0xffff0000u));
                  w.y = pg8::cvt_pk_bf16(o1[4 * g + 2] * inv * __uint_as_float(gv.y << 16), o1[4 * g + 3] * inv * __uint_as_float(gv.y & 0xffff0000u)); *(u32x2*)(OG + ob + 32 + 8 * g) = w; } }
        }
    }
    __syncthreads();
}
}
namespace el {
__device__ __forceinline__ const float* lp(const float* p) { asm volatile("" : "+s"(p)); return p; }
typedef short bf16x8 __attribute__((ext_vector_type(8)));
typedef float f32x4 __attribute__((ext_vector_type(4)));
typedef unsigned u32x2 __attribute__((ext_vector_type(2)));
typedef unsigned u32x4 __attribute__((ext_vector_type(4)));
__device__ __forceinline__ float wsum(float v) {
#pragma unroll
    for (int o = 1; o < 64; o <<= 1) v += __shfl_xor(v, o);
    return v;
}
__device__ __forceinline__ void unpack8(bf16x8 v, float (&f)[8]) { const u32x4 u = __builtin_bit_cast(u32x4, v);
#pragma unroll
    for (int i = 0; i < 4; ++i) { f[2 * i] = __uint_as_float(u[i] << 16); f[2 * i + 1] = __uint_as_float(u[i] & 0xffff0000u); } }
__device__ __forceinline__ bf16x8 pack8(const float (&f)[8]) { u32x4 u;
#pragma unroll
    for (int i = 0; i < 4; ++i) u[i] = pg8::cvt_pk_bf16(f[2 * i], f[2 * i + 1]);
    return __builtin_bit_cast(bf16x8, u); }

__device__ __forceinline__ void norm_fast(const Params& P, int layer, int gw, int ngw, int lane) {
    float* X = WSP(float, W_X); const bf16* X16 = WSP(bf16, W_X16); bf16* XN = WSP(bf16, W_XN); const float* w = P.in[I_NORMW] + (size_t)layer * D;
    const float* xp_ = lp(P.in[I_XP]); const float* xm_ = lp(P.in[I_META]); const float* xs_ = lp(P.in[I_XS]);
    f32x4 wv[4];
#pragma unroll
    for (int k = 0; k < 4; ++k) wv[k] = *(const f32x4*)(w + 4 * lane + 256 * k);
    for (int r = gw; r < MPAD; r += ngw) {
        bf16* o = XN + (size_t)r * D + 4 * lane;
        if (r >= NROWS) {
#pragma unroll
            for (int k = 0; k < 4; ++k) *(u32x2*)(o + 256 * k) = (u32x2){0u, 0u};
            continue; }
        f32x4 v[4]; float s = 0.f;
        if (layer > 0 && r < NP) {
#pragma unroll
            for (int k = 0; k < 4; ++k) { const u32x2 t = *(const u32x2*)(X16 + (size_t)r * D + 4 * lane + 256 * k);
                v[k] = (f32x4){__uint_as_float(t.x << 16), __uint_as_float(t.x & 0xffff0000u), __uint_as_float(t.y << 16), __uint_as_float(t.y & 0xffff0000u)}; }
        } else { const float* src = X + (size_t)r * D;
            if (layer == 0) { if (r < NP) src = xp_ + (size_t)r * D; else if (r < ROW_SAMP) src = xm_ + (size_t)((r - ROW_META) % NMETA) * D; else src = xs_ + (size_t)(r - ROW_SAMP) * D; }
#pragma unroll
            for (int k = 0; k < 4; ++k) v[k] = *(const f32x4*)(src + 4 * lane + 256 * k); }
#pragma unroll
        for (int k = 0; k < 4; ++k) s += (v[k][0] * v[k][0] + v[k][1] * v[k][1]) + (v[k][2] * v[k][2] + v[k][3] * v[k][3]);
        const float rs = 1.f / sqrtf(wsum(s) * (1.f / D) + EPS);
#pragma unroll
        for (int k = 0; k < 4; ++k) { if (layer == 0 && r >= NP) *(f32x4*)(X + (size_t)r * D + 4 * lane + 256 * k) = v[k]; *(u32x2*)(o + 256 * k) = pg8::pk4(v[k] * wv[k] * rs); }
    }
}
__device__ __forceinline__ void convgates_fast(const Params& P, int j, LAS unsigned char* lds, int gw, int ngw, int lane, int tid) {
    const bf16* XM = WSP(bf16, W_XM); bf16* XC = WSP(bf16, W_XC); const float* G = WSP(float, W_G) + (size_t)j * 4096 * 8; float* GA = WSP(float, W_GATES);
    const float* cw = P.in[I_MCW] + (size_t)j * 4 * 2048; const float* cb = P.in[I_MCB] + (size_t)j * 2048;
    LAS float* Gt = (LAS float*)lds;
    for (int i = tid; i < 4096 * 2; i += 512) { const f32x4 v = *(const f32x4*)(G + (size_t)i * 4); const int c = i >> 1, g0 = (i & 1) * 4;
#pragma unroll
        for (int g = 0; g < 4; ++g) Gt[(g0 + g) * 4096 + c] = v[g]; }
    __syncthreads();
    for (int grp = gw; grp < MPAD / 4; grp += ngw) {
        const int r0 = grp * 4;
        if (r0 >= NROWS) { for (int t = 0; t < 4; ++t)
#pragma unroll
            for (int k = 0; k < 4; ++k) *(u32x4*)(XC + (size_t)(r0 + t) * MI + 8 * lane + 512 * k) = (u32x4){0u, 0u, 0u, 0u};
            continue; }
        int hmode, hrow = 0; const float* hs = nullptr;
        if (r0 < NP) { hmode = 1; const int t = r0 % SEQ; hrow = t > 0 ? r0 - 3 : ROW_META + (r0 / SEQ) * NMETA + NMETA - 3; }
        else if (r0 < ROW_SAMP) { const int i = (r0 - ROW_META) % NMETA; hmode = i > 0 ? 1 : 0; hrow = r0 - 3; }
        else { hmode = 2; hs = P.in[I_SCONV] + ((size_t)j * DECB + (r0 - ROW_SAMP) / TS) * 3 * 2048; }
        float ga[4][8];
#pragma unroll
        for (int t = 0; t < 4; ++t)
#pragma unroll
            for (int g = 0; g < 8; ++g) ga[t][g] = 0.f;
#pragma unroll 1
        for (int k = 0; k < 4; ++k) { const int c0 = 8 * lane + 512 * k;
            float x[7][8];
#pragma unroll
            for (int t = 0; t < 3; ++t) {
                if (hmode == 1) unpack8(*(const bf16x8*)(XM + (size_t)(hrow + t) * MI + c0), x[t]);
                else if (hmode == 2) { const f32x4 a = *(const f32x4*)(hs + (size_t)t * 2048 + c0), b = *(const f32x4*)(hs + (size_t)t * 2048 + c0 + 4);
#pragma unroll
                    for (int e = 0; e < 4; ++e) { x[t][e] = a[e]; x[t][4 + e] = b[e]; } }
                else {
#pragma unroll
                    for (int e = 0; e < 8; ++e) x[t][e] = 0.f; } }
#pragma unroll
            for (int t = 0; t < 4; ++t) unpack8(*(const bf16x8*)(XM + (size_t)(r0 + t) * MI + c0), x[3 + t]);
            float xc[4][8];
            { float wgt[5][8];
#pragma unroll
              for (int wv = 0; wv < 4; ++wv) { const f32x4 a = *(const f32x4*)(cw + (size_t)wv * 2048 + c0), b = *(const f32x4*)(cw + (size_t)wv * 2048 + c0 + 4);
#pragma unroll
                  for (int e = 0; e < 4; ++e) { wgt[wv][e] = a[e]; wgt[wv][4 + e] = b[e]; } }
              { const f32x4 a = *(const f32x4*)(cb + c0), b = *(const f32x4*)(cb + c0 + 4);
#pragma unroll
                for (int e = 0; e < 4; ++e) { wgt[4][e] = a[e]; wgt[4][4 + e] = b[e]; } }
#pragma unroll
              for (int t = 0; t < 4; ++t) {
#pragma unroll
                  for (int e = 0; e < 8; ++e) { const float a = wgt[4][e] + x[t][e] * wgt[0][e] + x[t + 1][e] * wgt[1][e] + x[t + 2][e] * wgt[2][e] + x[t + 3][e] * wgt[3][e]; xc[t][e] = pg8::silu_fast(a); }
                  *(bf16x8*)(XC + (size_t)(r0 + t) * MI + c0) = pack8(xc[t]); } }
#pragma unroll
            for (int g = 0; g < 8; ++g) { const LAS float* gq = Gt + g * 4096 + c0; const LAS float* gm = gq + 2048;
                const f32x4 q0 = *(const LAS f32x4*)gq, q1 = *(const LAS f32x4*)(gq + 4), m0 = *(const LAS f32x4*)gm, m1 = *(const LAS f32x4*)(gm + 4);
#pragma unroll
                for (int t = 0; t < 4; ++t) { float a = ga[t][g];
#pragma unroll
                    for (int e = 0; e < 4; ++e) a += xc[t][e] * q0[e] + xc[t][4 + e] * q1[e] + x[3 + t][e] * m0[e] + x[3 + t][4 + e] * m1[e];
                    ga[t][g] = a; }
                asm volatile("" ::: "memory"); }
        }
#pragma unroll
        for (int t = 0; t < 4; ++t)
#pragma unroll
            for (int g = 0; g < 8; ++g) ga[t][g] = wsum(ga[t][g]);
        if (lane < 32) { const int t = lane >> 3, g = lane & 7; float v = 0.f;
#pragma unroll
            for (int tt = 0; tt < 4; ++tt)
#pragma unroll
                for (int gg = 0; gg < 8; ++gg) v = (tt == t && gg == g) ? ga[tt][gg] : v;
            if (r0 + t < NROWS) GA[(size_t)(r0 + t) * 8 + g] = v + P.in[I_MBG][j * 8 + g]; }
    }
    __syncthreads();
}
__device__ __forceinline__ float scan_add(float v, int lane) {
#pragma unroll
    for (int o = 1; o < 64; o <<= 1) { const float t = __shfl_up(v, o); if (lane >= o) v += t; }
    return v; }
__device__ __forceinline__ float scan_max(float v, int lane) {
#pragma unroll
    for (int o = 1; o < 64; o <<= 1) { const float t = __shfl_up(v, o); if (lane >= o) v = fmaxf(v, t); }
    return v; }
constexpr int SC_MAXC = (NCH + 7) / 8;
__device__ __forceinline__ void scal_wg(const Params& P, int j, LAS unsigned char* lds, int team, int tid) {
    const float* GA = WSP(float, W_GATES); float* SA = WSP(float, W_SA); float* SCJ = WSP(float, W_SCJ); float* SWI = WSP(float, W_SWI); float* SEM = WSP(float, W_SEM); float* SWK = WSP(float, W_SWK); float* DEC = WSP(float, W_DEC);
    const int wave = tid >> 6, lane = tid & 63;
    LAS float* xg = (LAS float*)lds; LAS float* xp = xg + 64; LAS float* xm = xp + 64;
    if (team < BATCH * 4) { const int b = team >> 2, h = team & 3;
        float bl[SC_MAXC][4], cj[SC_MAXC][4], pex[SC_MAXC];
#pragma unroll
        for (int k = 0; k < SC_MAXC; ++k) { const int c = wave + 8 * k;
            if (c < NCH) { const int row0 = c == 0 ? ROW_META + b * NMETA : b * SEQ + (c - 1) * LCH; const int nper = c == 0 ? 1 : 4; const bool act = c == 0 ? lane < NMETA : true; const int tb = lane * nper;
                float ip[4]; float run = 0.f, pmx = -3.0e38f;
#pragma unroll
                for (int u = 0; u < 4; ++u) { if (u < nper && act) { const int r = row0 + tb + u; ip[u] = GA[(size_t)r * 8 + h]; run += logsigf(GA[(size_t)r * 8 + 4 + h]); } else ip[u] = 0.f; bl[k][u] = run; }
                const float incl = scan_add(run, lane), excl = incl - run;
#pragma unroll
                for (int u = 0; u < 4; ++u) { bl[k][u] += excl; cj[k][u] = (u < nper && act) ? ip[u] - bl[k][u] : -3.0e38f; pmx = fmaxf(pmx, cj[k][u]); }
                const float pin = scan_max(pmx, lane); float pe = __shfl_up(pin, 1); if (lane == 0) pe = -3.0e38f; pex[k] = pe;
                if (lane == 63) { xg[c] = incl; xp[c] = pin; } } }
        __syncthreads();
        if (tid == 0) { float m = 0.f; for (int c = 0; c < NCH; ++c) { xm[c] = m; const float g = xg[c], mn = g + fmaxf(m, xp[c]); DEC[(size_t)team * NCH + c] = __expf(g + m - mn); m = mn; }
            P.out[O_PM + (size_t)j * BATCH * 4 + team] = m; }
        __syncthreads();
#pragma unroll
        for (int k = 0; k < SC_MAXC; ++k) { const int c = wave + 8 * k;
            if (c < NCH) { const int row0 = c == 0 ? ROW_META + b * NMETA : b * SEQ + (c - 1) * LCH; const int nper = c == 0 ? 1 : 4; const bool act = c == 0 ? lane < NMETA : true; const int tb = lane * nper;
                const float m_prev = xm[c], g = xg[c], m_new = g + fmaxf(m_prev, xp[c]); float pr = pex[k];
#pragma unroll
                for (int u = 0; u < 4; ++u) if (u < nper && act) { const int r = row0 + tb + u; pr = fmaxf(pr, cj[k][u]); const float mx = fmaxf(m_prev, pr), mt = bl[k][u] + mx;
                    SA[(size_t)r * 4 + h] = -mx; SCJ[(size_t)r * 4 + h] = cj[k][u]; SWI[(size_t)r * 4 + h] = __expf(m_prev - mx); SEM[(size_t)r * 4 + h] = __expf(-mt); SWK[(size_t)r * 4 + h] = __expf(g + cj[k][u] - m_new); } } }
    } else { for (int k = tid; k < DECB * 4; k += 512) { const int bs = k >> 2, h = k & 3; float m = P.in[I_SM][(size_t)j * DECB * 4 + k]; float dec;
            scal_chunk(GA, h, ROW_SAMP + bs * TS, TS, m, SA, SCJ, SWI, SEM, SWK, dec); DEC[(size_t)BATCH * 4 * NCH + k] = dec; P.out[O_SMM + (size_t)j * DECB * 4 + k] = m; } }
    __syncthreads();
}
__device__ __forceinline__ void hnorm_fast(const Params& P, int j, int r_lo, int gw, int ngw, int lane) {
    const bf16* H = WSP(bf16, W_H); const bf16* OS = WSP(bf16, W_OS); const bf16* XC = WSP(bf16, W_XC); const bf16* ZS = WSP(bf16, W_ZS); bf16* A2 = WSP(bf16, W_A2);
    const float* hn = P.in[I_MHN] + (size_t)j * 2048 + 32 * lane; const float* sk = P.in[I_MSKIP] + (size_t)j * 2048 + 32 * lane;
    bf16x8 hv_[4], os_[4], xc_[4], zs_[4];
    int r = r_lo + gw;
    if (r < NROWS) { const size_t o = (size_t)r * MI + 32 * lane;
#pragma unroll
        for (int q = 0; q < 4; ++q) { hv_[q] = *(const bf16x8*)(H + o + 8 * q); os_[q] = *(const bf16x8*)(OS + o + 8 * q); xc_[q] = *(const bf16x8*)(XC + o + 8 * q); zs_[q] = *(const bf16x8*)(ZS + o + 8 * q); } }
    for (; r < MPAD; r += ngw) { const size_t o = (size_t)r * MI + 32 * lane;
        if (r >= NROWS) {
#pragma unroll
            for (int q = 0; q < 4; ++q) *(u32x4*)(A2 + o + 8 * q) = (u32x4){0u, 0u, 0u, 0u};
            continue; }
        bf16x8 hc[4], oc[4], xcur[4], zc[4];
#pragma unroll
        for (int q = 0; q < 4; ++q) { hc[q] = hv_[q]; oc[q] = os_[q]; xcur[q] = xc_[q]; zc[q] = zs_[q]; }
        const int rn = r + ngw;
        if (rn < NROWS) { const size_t on = (size_t)rn * MI + 32 * lane;
#pragma unroll
            for (int q = 0; q < 4; ++q) { hv_[q] = *(const bf16x8*)(H + on + 8 * q); os_[q] = *(const bf16x8*)(OS + on + 8 * q); xc_[q] = *(const bf16x8*)(XC + on + 8 * q); zs_[q] = *(const bf16x8*)(ZS + on + 8 * q); } }
        float hv[4][8]; float s = 0.f;
#pragma unroll
        for (int q = 0; q < 4; ++q) { unpack8(hc[q], hv[q]);
#pragma unroll
            for (int e = 0; e < 8; ++e) s += hv[q][e]; }
        s += __shfl_xor(s, 1); s += __shfl_xor(s, 2); s += __shfl_xor(s, 4); s += __shfl_xor(s, 8);
        const float mu = s * (1.f / 512.f); float qq = 0.f;
#pragma unroll
        for (int q = 0; q < 4; ++q)
#pragma unroll
            for (int e = 0; e < 8; ++e) { const float dl = hv[q][e] - mu; qq += dl * dl; }
        qq += __shfl_xor(qq, 1); qq += __shfl_xor(qq, 2); qq += __shfl_xor(qq, 4); qq += __shfl_xor(qq, 8);
        const float rs = 1.f / sqrtf(qq * (1.f / 512.f) + EPS);
#pragma unroll
        for (int q = 0; q < 4; ++q) { float os[8], xc[8], zs[8], res[8];
            unpack8(oc[q], os); unpack8(xcur[q], xc); unpack8(zc[q], zs);
            const f32x4 n0 = *(const f32x4*)(hn + 8 * q), n1 = *(const f32x4*)(hn + 8 * q + 4), k0 = *(const f32x4*)(sk + 8 * q), k1 = *(const f32x4*)(sk + 8 * q + 4);
#pragma unroll
            for (int e = 0; e < 8; ++e) { const float nwe = e < 4 ? n0[e & 3] : n1[e & 3], kwe = e < 4 ? k0[e & 3] : k1[e & 3]; res[e] = (os[e] * ((hv[q][e] - mu) * rs * nwe) + kwe * xc[e]) * zs[e]; }
            *(bf16x8*)(A2 + o + 8 * q) = pack8(res); }
    }
}
__device__ __forceinline__ void hnorm_block(const Params& P, int j, int tt, int h, int wave, int lane) {
    const bf16* H = WSP(bf16, W_H); const bf16* OS = WSP(bf16, W_OS); const bf16* XC = WSP(bf16, W_XC); const bf16* ZS = WSP(bf16, W_ZS); bf16* A2 = WSP(bf16, W_A2);
    const int sub = lane & 15, rq = lane >> 4; const int col = h * 512 + 32 * sub;
    const float* hn = P.in[I_MHN] + (size_t)j * 2048 + col; const float* sk = P.in[I_MSKIP] + (size_t)j * 2048 + col;
    bf16x8 hv_[4], os_[4], xc_[4], zs_[4];
    { const size_t o = (size_t)(tt * 256 + wave * 4 + rq) * MI + col;
#pragma unroll
      for (int q = 0; q < 4; ++q) { hv_[q] = *(const bf16x8*)(H + o + 8 * q); os_[q] = *(const bf16x8*)(OS + o + 8 * q); xc_[q] = *(const bf16x8*)(XC + o + 8 * q); zs_[q] = *(const bf16x8*)(ZS + o + 8 * q); } }
#pragma unroll 1
    for (int it = 0; it < 8; ++it) { const size_t o = (size_t)(tt * 256 + it * 32 + wave * 4 + rq) * MI + col;
        bf16x8 hc[4], oc[4], xcur[4], zc[4];
#pragma unroll
        for (int q = 0; q < 4; ++q) { hc[q] = hv_[q]; oc[q] = os_[q]; xcur[q] = xc_[q]; zc[q] = zs_[q]; }
        if (it < 7) { const size_t on = o + (size_t)32 * MI;
#pragma unroll
            for (int q = 0; q < 4; ++q) { hv_[q] = *(const bf16x8*)(H + on + 8 * q); os_[q] = *(const bf16x8*)(OS + on + 8 * q); xc_[q] = *(const bf16x8*)(XC + on + 8 * q); zs_[q] = *(const bf16x8*)(ZS + on + 8 * q); } }
        float hv[4][8]; float s = 0.f;
#pragma unroll
        for (int q = 0; q < 4; ++q) { unpack8(hc[q], hv[q]);
#pragma unroll
            for (int e8 = 0; e8 < 8; ++e8) s += hv[q][e8]; }
        s += __shfl_xor(s, 1); s += __shfl_xor(s, 2); s += __shfl_xor(s, 4); s += __shfl_xor(s, 8);
        const float mu = s * (1.f / 512.f); float qq = 0.f;
#pragma unroll
        for (int q = 0; q < 4; ++q)
#pragma unroll
            for (int e8 = 0; e8 < 8; ++e8) { const float dl = hv[q][e8] - mu; qq += dl * dl; }
        qq += __shfl_xor(qq, 1); qq += __shfl_xor(qq, 2); qq += __shfl_xor(qq, 4); qq += __shfl_xor(qq, 8);
        const float rs = 1.f / sqrtf(qq * (1.f / 512.f) + EPS);
#pragma unroll
        for (int q = 0; q < 4; ++q) { float os[8], xc[8], zs[8], res[8];
            unpack8(oc[q], os); unpack8(xcur[q], xc); unpack8(zc[q], zs);
            const f32x4 n0 = *(const f32x4*)(hn + 8 * q), n1 = *(const f32x4*)(hn + 8 * q + 4), k0 = *(const f32x4*)(sk + 8 * q), k1 = *(const f32x4*)(sk + 8 * q + 4);
#pragma unroll
            for (int e8 = 0; e8 < 8; ++e8) { const float nwe = e8 < 4 ? n0[e8 & 3] : n1[e8 & 3], kwe = e8 < 4 ? k0[e8 & 3] : k1[e8 & 3]; res[e8] = (os[e8] * ((hv[q][e8] - mu) * rs * nwe) + kwe * xc[e8]) * zs[e8]; }
            *(bf16x8*)(A2 + o + 8 * q) = pack8(res); }
    }
}
template <class ColMap>
__device__ __forceinline__ void transpose_item(const float* W, int K, int N, bf16* WT, int ldt, ColMap cmap, float scale, LAS float* scr, int item, int lane) {
    const int nblk = N / 32, kb = item / nblk, nb = item % nblk, k0 = 64 * kb, n0 = 32 * nb;
    float tv[32];
#pragma unroll
    for (int i = 0; i < 32; ++i) tv[i] = W[(size_t)(k0 + 2 * i + (lane >> 5)) * N + cmap(n0 + (lane & 31))];
#pragma unroll
    for (int i = 0; i < 32; ++i) scr[(2 * i + (lane >> 5)) * 33 + (lane & 31)] = tv[i];
    asm volatile("s_waitcnt lgkmcnt(0)" ::: "memory");
    const int c = lane & 7;
#pragma unroll
    for (int jj = 0; jj < 4; ++jj) { const int n = (lane >> 3) + 8 * jj; const LAS float* s = scr + (8 * c) * 33 + n;
        u32x4 o; o[0] = pg8::cvt_pk_bf16(s[0 * 33] * scale, s[1 * 33] * scale); o[1] = pg8::cvt_pk_bf16(s[2 * 33] * scale, s[3 * 33] * scale); o[2] = pg8::cvt_pk_bf16(s[4 * 33] * scale, s[5 * 33] * scale); o[3] = pg8::cvt_pk_bf16(s[6 * 33] * scale, s[7 * 33] * scale);
        *(u32x4*)(WT + (size_t)(n0 + n) * ldt + k0 + 8 * c) = o; }
    asm volatile("s_waitcnt lgkmcnt(0)" ::: "memory");
}
struct MapId { __device__ __forceinline__ int operator()(int n) const { return n; } };
struct MapSwa { __device__ __forceinline__ int operator()(int n) const { return swa_pos2orig(n); } };
__device__ __forceinline__ void convert_set(const Params& P, LAS unsigned char* lds, int set, int iw, int nw, int wave, int lane) {
    const float* wq_ = lp(P.in[I_MWQ]); const float* wk_ = lp(P.in[I_MWK]); const float* wv_ = lp(P.in[I_MWV]);
    LAS float* scr = (LAS float*)(lds + wave * 16384);
    constexpr int I_SW = (D / 64) * (SWA_N / 32), I_SO = (D / 64) * (D / 32), I_MW = (D / 64) * (ML_N / 32), I_QK = (512 / 64) * (512 / 32), I_MO = (MI / 64) * (D / 32);
    constexpr int N_SWA = I_SW + I_SO, N_ML = I_MW + 12 * I_QK + I_MO;
    const int total = set == 0 ? N_SWA : set == 1 ? N_ML : N_SWA + N_ML;
    for (int it = iw; it < total; it += nw) { int r = it; int j = set == 0 ? 0 : set == 1 ? 0 : 1; bool swa = set == 0;
        if (set == 2) { if (r < N_SWA) swa = true; else r -= N_SWA; }
        if (swa) {
            if (r < I_SW) { transpose_item(P.in[I_SWIN] + (size_t)j * D * SWA_N, D, SWA_N, WSP(bf16, W_SWIN) + (size_t)j * SWA_N * D, D, MapSwa(), 1.f, scr, r, lane); continue; } r -= I_SW;
            transpose_item(P.in[I_SWOUT] + (size_t)j * D * D, D, D, WSP(bf16, W_SWOUT) + (size_t)j * D * D, D, MapId(), 1.f, scr, r, lane); continue; }
        if (r < I_MW) { transpose_item(P.in[I_MWIN] + (size_t)j * D * ML_N, D, ML_N, WSP(bf16, W_MWIN) + (size_t)j * ML_N * D, D, MapId(), 1.f, scr, r, lane); continue; } r -= I_MW;
        if (r < 12 * I_QK) { const int w = r / (4 * I_QK), h = (r / I_QK) % 4, q = r % I_QK;
            transpose_item((w == 0 ? wq_ : w == 1 ? wk_ : wv_) + ((size_t)j * 4 + h) * 512 * 512, 512, 512, WSP(bf16, W_MWQ) + (size_t)(j * 3 + w) * 4 * 512 * 512 + h * 512, 2048, MapId(), w == 1 ? 0.044194173824159216f : 1.f, scr, q, lane); continue; } r -= 12 * I_QK;
        transpose_item(P.in[I_MWOUT] + (size_t)j * MI * D, MI, D, WSP(bf16, W_MWOUT) + (size_t)j * D * MI, MI, MapId(), 1.f, scr, r, lane);
    }
}
__device__ __forceinline__ void prologue_fast(const Params& P, LAS unsigned char* lds, int gw, int ngw, int wave, int lane, long gt, long gs) {
    const float* wq_ = lp(P.in[I_MWQ]); const float* wk_ = lp(P.in[I_MWK]); const float* wv_ = lp(P.in[I_MWV]);
    convert_set(P, lds, 0, gw, ngw, wave, lane);
    { float* bt = WSP(float, W_BIAS); const float* rb = P.in[I_RELB]; for (long i = gt; i < 16 * 132; i += gs) { const int h = (int)(i / 132), dd = (int)(i % 132); bt[i] = rb[rel_bucket(dd > 128 ? 128 : dd) * 16 + h]; } }
}
__device__ __forceinline__ void gmat_items(const Params& P, int j, int it0, int n, int wave, int lane) {
    const float* wq_ = lp(P.in[I_MWQ]); const float* wk_ = lp(P.in[I_MWK]); const float* wv_ = lp(P.in[I_MWV]);
    float* G = WSP(float, W_G);
    for (int it = it0 + wave; it < it0 + n; it += 8) { const int d = it & 511, h = (it >> 9) & 3, kg = (it >> 11) & 1;
        float a[8];
#pragma unroll
        for (int g = 0; g < 8; ++g) a[g] = 0.f;
        for (int part = 0; part < (kg == 0 ? 2 : 1); ++part) { const int w = kg == 0 ? part : 2; const float sc = w == 1 ? 0.044194173824159216f : 1.f;
            const float* wr = (w == 0 ? wq_ : w == 1 ? wk_ : wv_) + (((size_t)j * 4 + h) * 512 + d) * 512 + 8 * lane; const float* wg = P.in[I_MWG] + (size_t)j * 6144 * 8 + (size_t)(w * 2048 + h * 512 + 8 * lane) * 8;
            const f32x4 x0 = *(const f32x4*)wr * sc, x1 = *(const f32x4*)(wr + 4) * sc;
#pragma unroll
            for (int e8 = 0; e8 < 8; ++e8) { const float x = e8 < 4 ? x0[e8 & 3] : x1[e8 & 3]; const f32x4 g0 = *(const f32x4*)(wg + e8 * 8), g1 = *(const f32x4*)(wg + e8 * 8 + 4);
#pragma unroll
                for (int g = 0; g < 4; ++g) { a[g] += x * g0[g]; a[4 + g] += x * g1[g]; } } }
#pragma unroll
        for (int g = 0; g < 8; ++g) a[g] = wsum(a[g]);
        if (lane < 8) { float v = 0.f;
#pragma unroll
            for (int g = 0; g < 8; ++g) v = lane == g ? a[g] : v;
            G[(size_t)j * 4096 * 8 + (size_t)(kg * 2048 + h * 512 + d) * 8 + lane] = v; } }
}
__device__ __forceinline__ int wq_pull(unsigned* ctr, LAS unsigned* slot, int tid);
__device__ __forceinline__ void gmat_deferred(const Params& P, int j, unsigned* ctr, LAS unsigned* slot, int tid) {
    for (;;) { const int c = wq_pull(ctr, slot, tid); if (c >= 256) break; gmat_items(P, j, c * 16, 16, tid >> 6, tid & 63); }
}
__device__ __forceinline__ void cache_part(const Params& P, int part, long gt, long gs) {
    bf16* KC = WSP(bf16, W_KC); bf16* VTC = WSP(bf16, W_VTC);
    const float* cmk = lp(P.in[I_CMK]); const float* ck = lp(P.in[I_CK]); const float* cmv = lp(P.in[I_CMV]); const float* cv = lp(P.in[I_CV]);
    if (part < 2) { const long jb0 = (long)part * DECB;
        for (long i = gt; i < (long)DECB * KCN * 32; i += gs) { const int c8 = (int)(i % 32) * 8, key = (int)((i / 32) % KCN); const long jb = jb0 + i / (32 * KCN);
            float f[8];
#pragma unroll
            for (int e = 0; e < 8; ++e) f[e] = 0.f;
            const float* src = key < 16 ? cmk + ((size_t)jb * 16 + key) * 256 + c8 : key < 144 ? ck + ((size_t)jb * 128 + key - 16) * 256 + c8 : nullptr;
            if (src) { const f32x4 a = *(const f32x4*)src, b = *(const f32x4*)(src + 4);
#pragma unroll
                for (int e = 0; e < 4; ++e) { f[e] = a[e]; f[4 + e] = b[e]; } }
            *(bf16x8*)(KC + ((size_t)jb * KCN + key) * 256 + c8) = pack8(f); }
        for (long i = gt; i < (long)DECB * 256 * (KCN / 8); i += gs) { const int c = (int)(i % 256), k8 = (int)((i / 256) % (KCN / 8)) * 8; const long jb = jb0 + i / (256 * (KCN / 8));
            float f[8];
#pragma unroll
            for (int e = 0; e < 8; ++e) { const int key = k8 + e; f[e] = key < 16 ? cmv[((size_t)jb * 16 + key) * 256 + c] : key < 144 ? cv[((size_t)jb * 128 + key - 16) * 256 + c] : 0.f; }
            *(bf16x8*)(VTC + ((size_t)jb * 256 + c) * KCN + k8) = pack8(f); }
    } else { const float* src = part == 2 ? ck : cv; float* dst = P.out + (part == 2 ? O_SK : O_SV);
        for (long i = gt; i < 2L * DECB * 124 * 64; i += gs) { const int c4 = (int)(i % 64) * 4, key = (int)((i / 64) % 124); const long jb = i / (64 * 124);
            *(f32x4*)(dst + ((size_t)jb * 128 + key) * 256 + c4) = *(const f32x4*)(src + ((size_t)jb * 128 + key + 4) * 256 + c4); } }
}
__device__ __forceinline__ int wq_pull(unsigned* ctr, LAS unsigned* slot, int tid);
__device__ __forceinline__ void cache_deferred(const Params& P, int part, unsigned* ctr, LAS unsigned* slot, int tid) {
    constexpr int NCHUNK = 256;
    for (;;) { const int c = wq_pull(ctr, slot, tid); if (c >= NCHUNK) break; cache_part(P, part, (long)c * 512 + tid, (long)NCHUNK * 512); }
}
__device__ __forceinline__ void sample_item(const Params& P, int j, LAS unsigned char* lds, int it, int tid) {
    const int bs = it >> 2, h = it & 3, row0 = ROW_SAMP + bs * TS, wave = tid >> 6, lane = tid & 63;
    LAS float* qk = (LAS float*)lds;
    LAS float* red = (LAS float*)(lds + 16384);
    LAS float* sc = (LAS float*)(lds + 16384 + 32768);
    LAS float* vs = (LAS float*)(lds + 16384 + 32768 + 1024);
    const bf16* Q = WSP(bf16, W_MQ); const bf16* K = WSP(bf16, W_MK); const bf16* VT = WSP(bf16, W_MVT); bf16* H = WSP(bf16, W_H);
    const size_t so = (((size_t)j * DECB + bs) * 4 + h) * 512 * 512, no = (((size_t)j * DECB + bs) * 4 + h) * 512;
    const float* cin = P.in[I_SC] + so; float* cout = P.out + O_SCC + so; const float* nin = P.in[I_SN] + no;
    const int e4 = (tid & 127) * 4, dq = tid >> 7;
    const float* cp = cin + (size_t)(dq * 128) * 512 + e4; float* op = cout + (size_t)(dq * 128) * 512 + e4;
    f32x4 ca[8], cb[8], cc[8];
#define SI_LOAD(blk, r0) do { _Pragma("unroll") for (int u = 0; u < 8; ++u) blk[u] = __builtin_nontemporal_load((const f32x4*)(cp + (size_t)((r0) + u) * 512)); __builtin_amdgcn_sched_barrier(0); } while (0)
    SI_LOAD(ca, 0); SI_LOAD(cb, 8);
    { const int d = tid;
#pragma unroll
      for (int t = 0; t < 4; ++t) { qk[d * 8 + t] = bf2f(Q[(size_t)(row0 + t) * MI + h * 512 + d]); qk[d * 8 + 4 + t] = bf2f(K[(size_t)(row0 + t) * MI + h * 512 + d]); vs[t * 512 + d] = bf2f(VT[vtb_idx(row0 + t, h, d)]); } }
    __syncthreads();
    for (int idx = wave; idx < 14; idx += 8) { int t, jj; float a = 0.f;
        if (idx < 10) { t = idx < 1 ? 0 : idx < 3 ? 1 : idx < 6 ? 2 : 3; jj = idx - (t * (t + 1)) / 2;
            for (int d = lane; d < 512; d += 64) a += qk[d * 8 + t] * qk[d * 8 + 4 + jj];
            a = wsum(a); if (lane == 0) sc[t * 4 + jj] = a; }
        else { t = idx - 10; for (int d = lane; d < 512; d += 64) a += qk[d * 8 + t] * nin[d]; a = wsum(a); if (lane == 0) sc[16 + t] = a; } }
    __syncthreads();
    if (tid < 4) { const int t = tid, r = row0 + t; const float sa = WSP(float, W_SA)[(size_t)r * 4 + h], wi = WSP(float, W_SWI)[(size_t)r * 4 + h]; float s = 0.f;
        for (int jj = 0; jj < 4; ++jj) { float p = 0.f; if (jj <= t) p = sc[t * 4 + jj] * __expf(sa + WSP(float, W_SCJ)[(size_t)(row0 + jj) * 4 + h]); sc[32 + t * 4 + jj] = p; s += p; }
        const float den = s + wi * sc[16 + t]; sc[48 + t] = fmaxf(fabsf(den), WSP(float, W_SEM)[(size_t)r * 4 + h]); sc[52 + t] = wi; sc[56 + t] = WSP(float, W_SWK)[(size_t)r * 4 + h];
        if (t == 0) sc[60] = WSP(float, W_DEC)[(size_t)BATCH * 4 * NCH + it]; }
    __syncthreads();
    const float dec = sc[60];
    f32x4 wv[4], acc[4];
#pragma unroll
    for (int t = 0; t < 4; ++t) { wv[t] = *(const LAS f32x4*)(vs + t * 512 + e4) * sc[56 + t]; acc[t] = (f32x4){0.f, 0.f, 0.f, 0.f}; }
    const LAS float* qp = qk + (dq * 128) * 8;
#define SI_PROC(blk, r0) do { _Pragma("unroll") for (int u = 0; u < 8; ++u) { const f32x4 qv = *(const LAS f32x4*)(qp + ((r0) + u) * 8), kv = *(const LAS f32x4*)(qp + ((r0) + u) * 8 + 4); \
        f32x4 o = blk[u] * dec; _Pragma("unroll") for (int t = 0; t < 4; ++t) { acc[t] += blk[u] * qv[t]; o += wv[t] * kv[t]; } \
        __builtin_nontemporal_store(o, (f32x4*)(op + (size_t)((r0) + u) * 512)); __builtin_amdgcn_sched_barrier(0); } } while (0)
#pragma unroll 1
    for (int d0 = 0; d0 < 120; d0 += 24) {
        SI_LOAD(cc, d0 + 16); SI_PROC(ca, d0);
        SI_LOAD(ca, d0 + 24); SI_PROC(cb, d0 + 8);
        SI_LOAD(cb, (d0 + 32 < 128 ? d0 + 32 : 120)); SI_PROC(cc, d0 + 16); }
    SI_PROC(ca, 120);
#undef SI_LOAD
#undef SI_PROC
#pragma unroll
    for (int t = 0; t < 4; ++t) *(LAS f32x4*)(red + (dq * 4 + t) * 512 + e4) = acc[t];
    __syncthreads();
    { const int e = tid;
#pragma unroll
      for (int t = 0; t < 4; ++t) { float a = (red[(0 * 4 + t) * 512 + e] + red[(1 * 4 + t) * 512 + e]) + (red[(2 * 4 + t) * 512 + e] + red[(3 * 4 + t) * 512 + e]); a *= sc[52 + t];
#pragma unroll
          for (int jj = 0; jj < 4; ++jj) a += sc[32 + t * 4 + jj] * vs[jj * 512 + e];
          H[(size_t)(row0 + t) * MI + h * 512 + e] = f2bf(a / sc[48 + t]); }
      float n = dec * nin[e];
#pragma unroll
      for (int t = 0; t < 4; ++t) n += sc[56 + t] * qk[e * 8 + 4 + t];
      P.out[O_SNN + no + e] = n; }
    __syncthreads();
}
__device__ __forceinline__ int wq_pull(unsigned* ctr, LAS unsigned* slot, int tid) {
    if (tid == 0) *slot = __hip_atomic_fetch_add(ctr, 1u, __ATOMIC_RELAXED, __HIP_MEMORY_SCOPE_AGENT);
    __syncthreads(); const int v = (int)*slot; __syncthreads(); return v;
}
__device__ __forceinline__ void meta_scores(const Params& P, int wv, int nwv, int lane) {
    const bf16* Q = WSP(bf16, W_MQ); const bf16* K = WSP(bf16, W_MK); const float* SA = WSP(float, W_SA); const float* SCJ = WSP(float, W_SCJ); float* PSM = WSP(float, W_PSM); float* DEN = WSP(float, W_DEN);
    for (int i = wv; i < BATCH * 4 * NMETA; i += nwv) { const int it = i >> 4, t = i & 15, b = it >> 2, h = it & 3, row0 = ROW_META + b * NMETA, r = row0 + t;
        float qv[8]; unpack8(*(const bf16x8*)(Q + (size_t)r * MI + h * 512 + 8 * lane), qv); float s = 0.f;
        for (int jj = 0; jj < NMETA; ++jj) { float v = 0.f;
            if (jj <= t) { float kv[8]; unpack8(*(const bf16x8*)(K + (size_t)(row0 + jj) * MI + h * 512 + 8 * lane), kv); float a = 0.f;
#pragma unroll
                for (int e8 = 0; e8 < 8; ++e8) a += qv[e8] * kv[e8];
                v = wsum(a) * __expf(SA[(size_t)r * 4 + h] + SCJ[(size_t)(row0 + jj) * 4 + h]); }
            if (lane == 0) PSM[(size_t)it * 256 + t * 16 + jj] = v; s += v; }
        if (lane == 0) DEN[(size_t)r * 4 + h] = s; }
}
}
constexpr int LDS_MISC_OFF = 131072, LDS_BYTES = 147456;
constexpr int CW_BAR = 4096, CW_QUEUE = 16384;
#ifndef QA_ITEMS
#define QA_ITEMS (DECB * 4)
#endif
__global__ void __launch_bounds__(512, 2) mega(Params P) {
    extern __shared__ __attribute__((aligned(16))) unsigned char lds[];
    LAS unsigned char* ldsb = (LAS unsigned char*)lds;
    LAS unsigned* misc = (LAS unsigned*)(ldsb + LDS_MISC_OFF);
    if (threadIdx.x < 64) misc[threadIdx.x] = 0u;
    __syncthreads();
    XcdBarrier bar = xcd_barrier_post((unsigned*)(P.ws + W_CTL) + CW_BAR, (volatile LAS unsigned*)(misc + 8));
    const long gt = (long)blockIdx.x * 512 + threadIdx.x, gs = (long)gridDim.x * 512;
    const int G = (int)gridDim.x, cwg = (int)blockIdx.x;
#define LAUNDER() Params Pl = P; { unsigned char* w_ = Pl.ws; float* o_ = Pl.out; asm volatile("" : "+s"(w_), "+s"(o_)); Pl.ws = w_; Pl.out = o_; } long gtl = gt; asm volatile("" : "+v"(gtl))
#define RUNNB(ph, a0, a1) do { LAUNDER(); dispatch<ph>(Pl, a0, a1, gtl, gs); } while (0)
#define RUN(ph, a0, a1) do { RUNNB(ph, a0, a1); xcd_barrier(bar); } while (0)
#define BAR() xcd_barrier(bar)
#ifndef PR_A
#define PR_A 1
#endif
#ifndef PR_A2
#define PR_A2 PR_A
#endif
#ifndef PR_A3
#define PR_A3 PR_A
#endif
#ifndef PR_A3_KMODE
#define PR_A3_KMODE 0
#endif
#ifndef PR_F
#define PR_F 0
#endif
#ifndef PR_B
#define PR_B 1
#endif
#ifndef PR_C
#define PR_C 1
#endif
#ifndef PR_D
#define PR_D 1
#endif
#ifndef PR_D1
#define PR_D1 PR_D
#endif
#ifndef PR_D2
#define PR_D2 PR_D
#endif
#ifndef PR_D3
#define PR_D3 PR_D
#endif
#ifndef PR_D4
#define PR_D4 PR_D
#endif
#ifndef PR_D5
#define PR_D5 PR_D
#endif
#ifndef PR_E
#define PR_E 1
#endif
#define REP(n) for (int rp_ = 0; rp_ < (n); ++rp_)
#define WV_ARGS (int)(gtl >> 6), G * 8, (int)(gtl & 63)
    REP(PR_E) {
    { LAUNDER(); el::prologue_fast(Pl, ldsb, (int)(gtl >> 6), G * 8, (int)((gtl >> 6) & 7), (int)(gtl & 63), gtl, gs); el::cache_part(Pl, 0, gtl, gs); }
    BAR(); }
    for (int layer = 0; layer < 4; ++layer) {
        const int j = layer >> 1;
        REP(PR_D1) { { LAUNDER(); el::norm_fast(Pl, layer, WV_ARGS); }
        BAR(); }
        if ((layer & 1) == 0) {
            REP(PR_A) { { LAUNDER(); pg8::PlainOrder S; S.init(WSP2(Pl, bf16, W_XN), D, WSP2(Pl, bf16, W_SWIN) + (size_t)j * SWA_N * D, D, MPAD, SWA_N, D, G, cwg);
              pg8::EpiSwaIn E{Pl, j}; pg8::gemm_phase(ldsb, D, D, S, E);
              constexpr int NU = (MPAD / 256) * (SWA_N / 256); const int first_idle = NU % G;
              if (layer == 2) el::cache_deferred(Pl, 2, (unsigned*)(Pl.ws + W_CTL) + CW_QUEUE + (20 + rp_) * 64, misc + 16, (int)(gtl & 511));
              if (layer == 0 && cwg >= first_idle) el::convert_set(Pl, ldsb, 1, (cwg - first_idle) * 8 + (int)((gtl >> 6) & 7), (G - first_idle) * 8, (int)((gtl >> 6) & 7), (int)(gtl & 63)); }
            BAR(); }
            REP(PR_B) { RUNNB(PH_SWAOUT, j, 0);
            { LAUNDER(); at::att_phase(Pl, j, ldsb, (int)(gtl >> 6), G * 8, (int)(gtl & 511)); }
            BAR(); }
            for (int rp_ = PR_F; rp_ >= 0; --rp_) { { LAUNDER(); pg8::SplitTailOrder S; S.init(WSP2(Pl, bf16, W_OG), D, WSP2(Pl, bf16, W_SWOUT) + (size_t)j * D * D, D, D, G, cwg);
              pg8::EpiResid E{Pl.in[I_XP], WSP2(Pl, bf16, W_X16), WSP2(Pl, float, W_X), Pl.out, layer == 0 ? 0 : 1, rp_ ? (long)(512u << 20) / 4 : 0L}; pg8::gemm_phase(ldsb, D, D, S, E); }
            { LAUNDER(); el::gmat_deferred(Pl, j, (unsigned*)(Pl.ws + W_CTL) + CW_QUEUE + (28 + j * 2 + rp_) * 64, misc + 16, (int)(gtl & 511)); }
            BAR(); }
        } else {
            REP(PR_A2) { { LAUNDER(); pg8::PlainOrder S; S.init(WSP2(Pl, bf16, W_XN), D, WSP2(Pl, bf16, W_MWIN) + (size_t)j * ML_N * D, D, MPAD, ML_N, D, G, cwg);
              pg8::EpiMlIn E{Pl, j}; pg8::gemm_phase(ldsb, D, D, S, E);
              constexpr int NU = (MPAD / 256) * (ML_N / 256); const int first_idle = NU % G;
              if (layer == 3) el::cache_deferred(Pl, 3, (unsigned*)(Pl.ws + W_CTL) + CW_QUEUE + (24 + rp_) * 64, misc + 16, (int)(gtl & 511));
              if (layer == 1 && cwg >= first_idle) el::convert_set(Pl, ldsb, 2, (cwg - first_idle) * 8 + (int)((gtl >> 6) & 7), (G - first_idle) * 8, (int)((gtl >> 6) & 7), (int)(gtl & 63)); }
            BAR(); }
            REP(PR_D2) { { LAUNDER(); el::convgates_fast(Pl, j, ldsb, WV_ARGS, (int)(gtl & 511)); }
            BAR(); }
            constexpr int NSCG = BATCH * 4 + 1;
            REP(PR_A3) { if (cwg >= G - NSCG) { LAUNDER(); el::scal_wg(Pl, j, ldsb, cwg - (G - NSCG), (int)(gtl & 511)); }
            else
            { LAUNDER(); pg8::M3Order S{(const char*)WSP2(Pl, bf16, W_XC), (const char*)WSP2(Pl, bf16, W_XM), (const char*)(WSP2(Pl, bf16, W_MWQ) + (size_t)j * 3 * 4 * 512 * 512), MPAD / 256, G - NSCG, cwg, rp_ == 0 ? 0 : PR_A3_KMODE};
              pg8::EpiM3 E{Pl}; pg8::gemm_phase(ldsb, MI, MI, S, E); }
            if (layer == 1) { LAUNDER(); el::cache_deferred(Pl, 1, (unsigned*)(Pl.ws + W_CTL) + CW_QUEUE + (16 + rp_) * 64, misc + 16, (int)(gtl & 511)); }
            BAR(); }
            constexpr int NSAMP_A = QA_ITEMS;
            constexpr int NSTW = BATCH * 4 * 16;
            REP(PR_C) { if (cwg < NSTW) {
                { LAUNDER(); st::state_scan(Pl, j, ldsb, cwg, (int)threadIdx.x); }
                { LAUNDER(); pg8::POrder S{(const char*)WSP2(Pl, bf16, W_MQ), (const char*)WSP2(Pl, bf16, W_MK), (NP / 256) * 4, NSTW, cwg};
                  pg8::EpiP E{Pl}; pg8::gemm_phase(ldsb, MI, MI, S, E); } }
            else { LAUNDER(); el::meta_scores(Pl, (int)(gtl >> 6) - NSTW * 8, (G - NSTW) * 8, (int)(gtl & 63)); }
            { LAUNDER(); unsigned* ctr = (unsigned*)(Pl.ws + W_CTL) + CW_QUEUE + (j * 2 + rp_ * 4) * 64; for (;;) { const int it = el::wq_pull(ctr, misc + 16, (int)(gtl & 511)); if (it >= NSAMP_A) break; el::sample_item(Pl, j, ldsb, it, (int)(gtl & 511)); } }
            BAR(); }
            REP(PR_D3) { { LAUNDER(); ph_den_fast(Pl, (int)(gtl >> 6), G * 8, (int)(gtl & 63)); }
            RUNNB(PH_SMALLM, j, 1);
            { LAUNDER(); unsigned* ctr = (unsigned*)(Pl.ws + W_CTL) + CW_QUEUE + (j * 2 + 1 + rp_ * 4) * 64; for (;;) { const int it = NSAMP_A + el::wq_pull(ctr, misc + 16, (int)(gtl & 511)); if (it >= DECB * 4) break; el::sample_item(Pl, j, ldsb, it, (int)(gtl & 511)); } }
            BAR(); }
            REP(PR_D4) {
            { LAUNDER(); el::hnorm_fast(Pl, j, NP, WV_ARGS); }
            { LAUNDER(); pg8::NumOrder S{(const char*)WSP2(Pl, bf16, W_MQ), (const char*)WSP2(Pl, bf16, W_P), (const char*)WSP2(Pl, bf16, W_CT), (const char*)WSP2(Pl, bf16, W_MVT), (NP / 256) * 4, G, cwg};
              pg8::EpiNum E{Pl}; pg8::gemm_phase(ldsb, MI, MI, S, E);
              asm volatile("s_waitcnt vmcnt(0)" ::: "memory"); __syncthreads(); __builtin_amdgcn_fence(__ATOMIC_ACQUIRE, "agent"); asm volatile("s_waitcnt vmcnt(0)" ::: "memory");
              for (int k = 0;; ++k) { const int id = S.job(k); if (id < 0) break; el::hnorm_block(Pl, j, id >> 2, id & 3, (int)((gtl >> 6) & 7), (int)(gtl & 63)); } }
            BAR(); }
            for (int rp_ = PR_F; rp_ >= 0; --rp_) { { LAUNDER(); pg8::SplitTailOrder S; S.init(WSP2(Pl, bf16, W_A2), MI, WSP2(Pl, bf16, W_MWOUT) + (size_t)j * D * MI, MI, MI, G, cwg);
              pg8::EpiResid E{Pl.in[I_XP], WSP2(Pl, bf16, W_X16), WSP2(Pl, float, W_X), Pl.out, layer == 3 ? 2 : 1, rp_ ? (long)(512u << 20) / 4 : 0L}; pg8::gemm_phase(ldsb, MI, MI, S, E); }
            BAR(); }
        }
    }
    { LAUNDER(); const float* X = WSP2(Pl, float, W_X) + (size_t)ROW_SAMP * D; float* ys = Pl.out + O_YS; for (long i = gtl; i < (long)NS * D / 4; i += gs) *(pg8::f32x4*)(ys + 4 * i) = *(const pg8::f32x4*)(X + 4 * i); }
}
extern "C" void kernel_launch(void* const* d_in, const int* in_sizes, int n_in, void* d_out, int out_size, void* d_ws, size_t ws_size, hipStream_t stream) {
    Params P; memset(&P, 0, sizeof(P));
    for (int i = 0; i < N_IN; ++i) P.in[i] = (const float*)d_in[i];
    P.out = (float*)d_out; P.ws = (unsigned char*)d_ws;
    if (ws_size < W_END) { fprintf(stderr, "ws too small: %zu < %zu\n", ws_size, (size_t)W_END); return; }
    static int grid = 0;
    if (!grid) {
        int dev = 0, cus = 0, per_cu = 0;
        (void)hipGetDevice(&dev);
        (void)hipDeviceGetAttribute(&cus, hipDeviceAttributeMultiprocessorCount, dev);
        (void)hipFuncSetAttribute((const void*)mega, hipFuncAttributeMaxDynamicSharedMemorySize, LDS_BYTES);
        (void)hipOccupancyMaxActiveBlocksPerMultiprocessor(&per_cu, mega, 512, LDS_BYTES);
        if (per_cu < 1) { fprintf(stderr, "mega: occupancy query says 0 blocks per CU\n"); per_cu = 1; }
        grid = cus;
    }
    (void)hipMemsetAsync(P.ws + W_CTL, 0, 1u << 20, stream);
    mega<<<grid, 512, LDS_BYTES, stream>>>(P);
}
```

```cpp
#include <hip/hip_runtime.h>
#include <cstdio>
#include <cstring>
#include <cmath>
#define HD __device__ static
#define UNROLL _Pragma("unroll")
#ifndef SEQ
#define SEQ 8192
#endif
#ifndef BATCH
#define BATCH 2
#endif
#ifndef DECB
#define DECB 128
#endif
typedef unsigned short bf16;
constexpr int D = 1024, NMETA = 16, TS = 4, PAST = 8192;
constexpr int NP = BATCH * SEQ, NM = BATCH * NMETA, NS = DECB * TS;
constexpr int ROW_META = NP, ROW_SAMP = NP + NM, NROWS = NP + NM + NS, MPAD = (NROWS + 255) / 256 * 256;
constexpr int SWA_N = 2560, MI = 2048, MH = 4, MD = 512, ML_N = 6144;
constexpr int LCH = 256, NCH = SEQ / LCH + 1;
constexpr int KCN = 160;
constexpr float EPS = 1e-6f;

enum { I_XP = 0, I_XS, I_CK, I_CV, I_CMK, I_CMV, I_SC, I_SN, I_SM, I_SCONV, I_META, I_RELB, I_NORMW, I_SWIN, I_SQN, I_SKN, I_SSINK, I_SWOUT,
       I_MWIN, I_MCW, I_MCB, I_MWQ, I_MWK, I_MWV, I_MWG, I_MBG, I_MHN, I_MSKIP, I_MWOUT, N_IN };
constexpr size_t O_YP = 0, O_YS = O_YP + (size_t)NP * D, O_PK = O_YS + (size_t)NS * D, O_PV = O_PK + (size_t)2 * BATCH * 128 * 256,
    O_PMK = O_PV + (size_t)2 * BATCH * 128 * 256, O_PMV = O_PMK + (size_t)2 * BATCH * 16 * 256, O_PC = O_PMV + (size_t)2 * BATCH * 16 * 256,
    O_PN = O_PC + (size_t)2 * BATCH * 4 * 512 * 512, O_PM = O_PN + (size_t)2 * BATCH * 4 * 512, O_PCONV = O_PM + (size_t)2 * BATCH * 4,
    O_SK = O_PCONV + (size_t)2 * BATCH * 3 * 2048, O_SV = O_SK + (size_t)2 * DECB * 128 * 256, O_SCC = O_SV + (size_t)2 * DECB * 128 * 256,
    O_SNN = O_SCC + (size_t)2 * DECB * 4 * 512 * 512, O_SMM = O_SNN + (size_t)2 * DECB * 4 * 512, O_SCONV = O_SMM + (size_t)2 * DECB * 4,
    O_END = O_SCONV + (size_t)2 * DECB * 3 * 2048;
constexpr size_t al(size_t x) { return (x + 255) / 256 * 256; }
constexpr size_t W_CTL = 0;
constexpr size_t W_X = 1u << 20;
constexpr size_t W_XN = W_X + al((size_t)MPAD * D * 4);
constexpr size_t W_SWIN = W_XN + al((size_t)MPAD * D * 2);
constexpr size_t W_SWOUT = W_SWIN + al((size_t)2 * SWA_N * D * 2);
constexpr size_t W_MWIN = W_SWOUT + al((size_t)2 * D * D * 2);
constexpr size_t W_MWQ = W_MWIN + al((size_t)2 * ML_N * D * 2);
constexpr size_t W_MWOUT = W_MWQ + al((size_t)2 * 3 * 4 * 512 * 512 * 2);
constexpr size_t W_G = W_MWOUT + al((size_t)2 * D * MI * 2);
constexpr size_t W_BIAS = W_G + al((size_t)2 * 4096 * 8 * 4);
constexpr size_t W_Q = W_BIAS + al(16 * 132 * 4);
constexpr size_t W_K = W_Q + al((size_t)MPAD * D * 2);
constexpr size_t W_VT = W_K + al((size_t)MPAD * 256 * 2);
constexpr size_t W_GS = W_VT + al((size_t)MPAD * 256 * 2);
constexpr size_t W_OG = W_GS + al((size_t)MPAD * D * 2);
constexpr size_t W_KC = W_OG + al((size_t)MPAD * D * 2);
constexpr size_t W_VTC = W_KC + al((size_t)2 * DECB * KCN * 256 * 2);
constexpr size_t W_XM = W_VTC + al((size_t)2 * DECB * KCN * 256 * 2);
constexpr size_t W_ZS = W_XM + al((size_t)MPAD * MI * 2);
constexpr size_t W_OS = W_ZS + al((size_t)MPAD * MI * 2);
constexpr size_t W_XC = W_OS + al((size_t)MPAD * MI * 2);
constexpr size_t W_GATES = W_XC + al((size_t)MPAD * MI * 2);
constexpr size_t W_MQ = W_GATES + al((size_t)MPAD * 8 * 4);
constexpr size_t W_MK = W_MQ + al((size_t)MPAD * MI * 2);
constexpr size_t W_MKT = W_MK + al((size_t)MPAD * MI * 2);
constexpr size_t W_MVT = W_MKT + al((size_t)MPAD * MI * 2);
constexpr size_t W_SA = W_MVT + al((size_t)(MPAD / 256) * 512 * 2048 * 2);
constexpr size_t W_SCJ = W_SA + al((size_t)MPAD * 4 * 4);
constexpr size_t W_SWI = W_SCJ + al((size_t)MPAD * 4 * 4);
constexpr size_t W_SEM = W_SWI + al((size_t)MPAD * 4 * 4);
constexpr size_t W_SWK = W_SEM + al((size_t)MPAD * 4 * 4);
constexpr size_t W_DEC = W_SWK + al((size_t)MPAD * 4 * 4);
constexpr size_t W_P = W_DEC + al((size_t)(BATCH * 4 * NCH + DECB * 4) * 4);
constexpr size_t W_DENI = W_P + al((size_t)NP * 2048 * 2);
constexpr size_t W_DEN = W_DENI + al((size_t)NP * 16 * 4);
constexpr size_t W_CT = W_DEN + al((size_t)MPAD * 4 * 4);
constexpr size_t W_CST = W_CT + al((size_t)BATCH * 4 * (NCH - 1) * 512 * 512 * 2);
constexpr size_t W_NST = W_CST + al((size_t)BATCH * 4 * 512 * 512 * 4);
constexpr size_t W_NRUN = W_NST + al((size_t)BATCH * 4 * NCH * 512 * 4);
constexpr size_t W_PSM = W_NRUN + al((size_t)BATCH * 4 * 512 * 4);
constexpr size_t W_H = W_PSM + al((size_t)(BATCH + DECB) * 4 * 256 * 4);
constexpr size_t W_A2 = W_H + al((size_t)MPAD * MI * 2);
constexpr size_t W_TMP = W_A2 + al((size_t)MPAD * MI * 2);
constexpr size_t W_END = W_TMP + al((size_t)MPAD * ML_N * 4);
constexpr size_t W_X16 = W_TMP;

struct Params {
    const float* in[N_IN];
    float* out;
    unsigned char* ws;
};
#define WSP(T, off) ((T*)(P.ws + (off)))

HD inline float bf2f(bf16 v) { unsigned u = (unsigned)v << 16; float f; __builtin_memcpy(&f, &u, 4); return f; }
HD inline bf16 f2bf(float f) { unsigned u; __builtin_memcpy(&u, &f, 4); u += 0x7fffu + ((u >> 16) & 1u); return (bf16)(u >> 16); }
HD inline float siluf(float x) { return x / (1.f + expf(-x)); }
HD inline float sigmf(float x) { return 1.f / (1.f + expf(-x)); }
HD inline float logsigf(float x) { return x >= 0.f ? -log1pf(expf(-x)) : x - log1pf(expf(x)); }

HD inline int swa_pos2orig(int n) { const int t = n & ~255, l = n & 255; return t + (((l >> 5) & 3) << 6) + ((l >> 7) << 5) + (l & 31); }
HD inline int swa_orig2pos(int o) { const int t = o & ~255, l = o & 255; return t + (((l >> 5) & 1) << 7) + ((l >> 6) << 5) + (l & 31); }

HD inline size_t vtb_idx(int row, int h, int e) { return ((size_t)(row >> 8) * 512 + e) * 2048 + h * 512 + (row & 255); }
HD inline size_t ctb_idx(int c, int b, int h, int e, int d) { return (((size_t)(c - 1) * BATCH + b) * 512 + e) * 2048 + h * 512 + d; }
HD inline int rel_bucket(int n) {
    if (n < 16) return n;
    int v = 16 + (int)(logf((float)n / 16.f) / 2.0794415416798357f * 16.f);
    return v > 31 ? 31 : v;
}

HD inline int prev_row(int r) {
    if (r < NP) { const int t = r % SEQ; return t > 0 ? r - 1 : ROW_META + (r / SEQ) * NMETA + (NMETA - 1); }
    if (r < ROW_SAMP) { const int i = (r - ROW_META) % NMETA; return i > 0 ? r - 1 : -1; }
    return ((r - ROW_SAMP) % TS) > 0 ? r - 1 : -2;
}

enum { PH_WCONV = 0, PH_GMAT, PH_INITX, PH_CACHE, PH_NORM, PH_S1E, PH_ATT, PH_RESID, PH_M1E, PH_CONV, PH_GATES, PH_SCAL, PH_PMAT, PH_STATE, PH_DEN, PH_NUM,
       PH_SMALLS, PH_SMALLM, PH_HNORM, PH_SWAOUT, PH_FINAL };

HD inline void ph_wconv(const Params& P, long gt, long gs) {
    for (int j = 0; j < 2; ++j) {
        { bf16* dst = WSP(bf16, W_SWIN) + (size_t)j * SWA_N * D; const float* src = P.in[I_SWIN] + (size_t)j * D * SWA_N;
          for (long i = gt; i < (long)SWA_N * D; i += gs) { const int n = (int)(i / D), k = (int)(i % D); dst[i] = f2bf(src[(size_t)k * SWA_N + swa_pos2orig(n)]); } }
        { bf16* dst = WSP(bf16, W_SWOUT) + (size_t)j * D * D; const float* src = P.in[I_SWOUT] + (size_t)j * D * D;
          for (long i = gt; i < (long)D * D; i += gs) { const int n = (int)(i / D), k = (int)(i % D); dst[i] = f2bf(src[(size_t)k * D + n]); } }
        { bf16* dst = WSP(bf16, W_MWIN) + (size_t)j * ML_N * D; const float* src = P.in[I_MWIN] + (size_t)j * D * ML_N;
          for (long i = gt; i < (long)ML_N * D; i += gs) { const int n = (int)(i / D), k = (int)(i % D); dst[i] = f2bf(src[(size_t)k * ML_N + n]); } }
        for (int w = 0; w < 3; ++w) { bf16* dst = WSP(bf16, W_MWQ) + (size_t)(j * 3 + w) * 4 * 512 * 512; const float* src = P.in[I_MWQ + w] + (size_t)j * 4 * 512 * 512;
          const float sc = (w == 1) ? 0.044194173824159216f : 1.f;
          for (long i = gt; i < (long)4 * 512 * 512; i += gs) { const int e = (int)(i >> 11), h = (int)((i >> 9) & 3), d = (int)(i & 511); dst[i] = f2bf(src[((size_t)h * 512 + d) * 512 + e] * sc); } }
        { bf16* dst = WSP(bf16, W_MWOUT) + (size_t)j * D * MI; const float* src = P.in[I_MWOUT] + (size_t)j * MI * D;
          for (long i = gt; i < (long)D * MI; i += gs) { const int n = (int)(i / MI), k = (int)(i % MI); dst[i] = f2bf(src[(size_t)k * D + n]); } }
    }
    { float* bt = WSP(float, W_BIAS); const float* rb = P.in[I_RELB];
      for (long i = gt; i < 16 * 132; i += gs) { const int h = (int)(i / 132), dd = (int)(i % 132); bt[i] = rb[rel_bucket(dd > 128 ? 128 : dd) * 16 + h]; } }
}
HD inline void ph_gmat(const Params& P, long gt, long gs) {
    float* G = WSP(float, W_G);
    for (long i = gt; i < 2L * 4096 * 8; i += gs) {
        const int j = (int)(i / (4096 * 8)), c = (int)((i / 8) % 4096), g = (int)(i % 8);
        const float* wg = P.in[I_MWG] + (size_t)j * 6144 * 8;
        float acc = 0.f;
        if (c < 2048) { const int h = c >> 9, d = c & 511;
            const float* wq = P.in[I_MWQ] + ((size_t)(j * 4 + h) * 512 + d) * 512; const float* wk = P.in[I_MWK] + ((size_t)(j * 4 + h) * 512 + d) * 512;
            float a = 0.f, b = 0.f;
            for (int e = 0; e < 512; ++e) { a += wq[e] * wg[(size_t)(h * 512 + e) * 8 + g]; b += wk[e] * wg[(size_t)(2048 + h * 512 + e) * 8 + g]; }
            acc = a + b * 0.044194173824159216f;
        } else { const int cc = c - 2048, h = cc >> 9, d = cc & 511;
            const float* wv = P.in[I_MWV] + ((size_t)(j * 4 + h) * 512 + d) * 512;
            for (int e = 0; e < 512; ++e) acc += wv[e] * wg[(size_t)(4096 + h * 512 + e) * 8 + g];
        }
        G[i] = acc;
    }
}
HD inline void ph_initx(const Params& P, long gt, long gs) {
    float* X = WSP(float, W_X);
    for (long i = gt; i < (long)MPAD * D; i += gs) { const int r = (int)(i / D), c = (int)(i % D); float v = 0.f;
        if (r < NP) v = P.in[I_XP][i]; else if (r < ROW_SAMP) v = P.in[I_META][(size_t)((r - ROW_META) % NMETA) * D + c]; else if (r < NROWS) v = P.in[I_XS][(size_t)(r - ROW_SAMP) * D + c];
        X[i] = v; }
}
HD inline void ph_cache(const Params& P, long gt, long gs) {
    bf16* KC = WSP(bf16, W_KC); bf16* VTC = WSP(bf16, W_VTC);
    for (long i = gt; i < 2L * DECB * KCN * 256; i += gs) {
        const int c = (int)(i % 256), key = (int)((i / 256) % KCN); const long jb = i / (256 * KCN);
        float kv = 0.f, vv = 0.f;
        if (key < 16) { kv = P.in[I_CMK][((size_t)jb * 16 + key) * 256 + c]; vv = P.in[I_CMV][((size_t)jb * 16 + key) * 256 + c]; }
        else if (key < 144) { kv = P.in[I_CK][((size_t)jb * 128 + key - 16) * 256 + c]; vv = P.in[I_CV][((size_t)jb * 128 + key - 16) * 256 + c]; }
        { KC[i] = f2bf(kv); VTC[((size_t)jb * 256 + c) * KCN + key] = f2bf(vv); }
    }
    for (long i = gt; i < 2L * DECB * 124 * 256; i += gs) { const int c = (int)(i % 256), key = (int)((i / 256) % 124); const long jb = i / (256 * 124);
        P.out[O_SK + ((size_t)jb * 128 + key) * 256 + c] = P.in[I_CK][((size_t)jb * 128 + key + 4) * 256 + c];
        P.out[O_SV + ((size_t)jb * 128 + key) * 256 + c] = P.in[I_CV][((size_t)jb * 128 + key + 4) * 256 + c]; }
}
HD inline void ph_norm(const Params& P, int layer, long gt, long gs) {
    const float* X = WSP(float, W_X); bf16* XN = WSP(bf16, W_XN); const float* w = P.in[I_NORMW] + (size_t)layer * D;
    for (long r = gt; r < MPAD; r += gs) {
        const float* x = X + (size_t)r * D; bf16* o = XN + (size_t)r * D;
        if (r >= NROWS) { for (int c = 0; c < D; ++c) o[c] = 0; continue; }
        float s = 0.f; for (int c = 0; c < D; ++c) s += x[c] * x[c];
        const float rs = 1.f / sqrtf(s / D + EPS);
        for (int c = 0; c < D; ++c) o[c] = f2bf(x[c] * rs * w[c]);
    }
}
HD inline void swa_store_kv(const Params& P, int j, int r, int kvh, int d, float val, bool isv) {
    if (!isv) WSP(bf16, W_K)[(size_t)r * 256 + kvh * 64 + d] = f2bf(val); else WSP(bf16, W_VT)[(size_t)(kvh * 64 + d) * MPAD + r] = f2bf(val);
}
HD inline void ph_swaout(const Params& P, int j, long gt, long gs) {
    const bf16* K = WSP(bf16, W_K); const bf16* VT = WSP(bf16, W_VT);
    constexpr int NOR = BATCH * 128 + NM + NS;
    for (long i = gt; i < (long)NOR * 256; i += gs) { const int c = (int)(i % 256); int q = (int)(i / 256); int r; size_t ok, ov;
        if (q < BATCH * 128) { const int b = q / 128, tt = q % 128; r = b * SEQ + SEQ - 128 + tt; ok = O_PK + (((size_t)j * BATCH + b) * 128 + tt) * 256 + c; ov = ok - O_PK + O_PV; }
        else if (q < BATCH * 128 + NM) { q -= BATCH * 128; r = ROW_META + q; ok = O_PMK + ((size_t)j * NM + q) * 256 + c; ov = ok - O_PMK + O_PMV; }
        else { q -= BATCH * 128 + NM; r = ROW_SAMP + q; const int bs = q / TS, t = q % TS; ok = O_SK + (((size_t)j * DECB + bs) * 128 + 124 + t) * 256 + c; ov = ok - O_SK + O_SV; }
        P.out[ok] = bf2f(K[(size_t)r * 256 + c]); P.out[ov] = bf2f(VT[(size_t)c * MPAD + r]); }
}
HD inline void ph_s1e(const Params& P, int j, long gt, long gs) {
    const float* T = WSP(float, W_TMP);
    for (long i = gt; i < (long)MPAD * 40; i += gs) {
        const int r = (int)(i / 40), g = (int)(i % 40);
        float x[64];
        UNROLL for (int d = 0; d < 64; ++d) x[d] = T[(size_t)r * SWA_N + swa_orig2pos(g * 64 + d)];
        if (g < 20) {
            float s = 0.f; UNROLL for (int d = 0; d < 64; ++d) s += x[d] * x[d];
            const float rs = 1.f / sqrtf(s / 64.f + EPS);
            if (g < 16) { const float* qn = P.in[I_SQN] + j * 64; bf16* Q = WSP(bf16, W_Q) + (size_t)r * D + g * 64;
                UNROLL for (int d = 0; d < 64; ++d) Q[d] = f2bf(x[d] * rs * qn[d] * 0.125f); }
            else { const float* kn = P.in[I_SKN] + j * 64; UNROLL for (int d = 0; d < 64; ++d) swa_store_kv(P, j, r, g - 16, d, x[d] * rs * kn[d], false); }
        } else if (g < 24) { UNROLL for (int d = 0; d < 64; ++d) swa_store_kv(P, j, r, g - 20, d, x[d], true); }
        else { bf16* GS = WSP(bf16, W_GS) + (size_t)r * D + (g - 24) * 64; UNROLL for (int d = 0; d < 64; ++d) GS[d] = f2bf(siluf(x[d])); }
    }
}
HD inline void att_key(const bf16* kp, const bf16* vp, long vstride, const bf16* q, float bias, float& m, float& l, float* o) {
    float s = 0.f; UNROLL for (int d = 0; d < 64; ++d) s += bf2f(q[d]) * bf2f(kp[d]);
    s += bias;
    if (s > m) { const float c = expf(m - s); l *= c; UNROLL for (int d = 0; d < 64; ++d) o[d] *= c; m = s; }
    const float p = expf(s - m); l += p;
    UNROLL for (int d = 0; d < 64; ++d) o[d] += p * bf2f(vp[(size_t)d * vstride]);
}
HD inline void ph_att(const Params& P, int j, long gt, long gs) {
    const bf16* Q = WSP(bf16, W_Q); const bf16* K = WSP(bf16, W_K); const bf16* VT = WSP(bf16, W_VT); const float* BT = WSP(float, W_BIAS);
    const bf16* GS = WSP(bf16, W_GS); bf16* OG = WSP(bf16, W_OG);
    for (long i = gt; i < (long)NROWS * 16; i += gs) {
        const int r = (int)(i / 16), h = (int)(i % 16), kvh = h >> 2;
        float o[64]; UNROLL for (int d = 0; d < 64; ++d) o[d] = 0.f; const bf16* q = Q + (size_t)r * D + h * 64;
        float m = P.in[I_SSINK][j * 16 + h], l = 1.f; const float* bt = BT + h * 132;
        if (r < ROW_SAMP) {
            int b, pos; if (r < NP) { b = r / SEQ; pos = r % SEQ + 16; } else { b = (r - ROW_META) / NMETA; pos = (r - ROW_META) % NMETA; }
            for (int mi = 0; mi < 16 && mi <= pos; ++mi) { const int kr = ROW_META + b * NMETA + mi; const int dist = pos - mi;
                att_key(K + (size_t)kr * 256 + kvh * 64, VT + (size_t)(kvh * 64) * MPAD + kr, MPAD, q, bt[dist > 128 ? 128 : dist], m, l, o); }
            if (r < NP) { const int t = pos - 16; for (int t2 = (t > 128 ? t - 128 : 0); t2 <= t; ++t2) { const int kr = b * SEQ + t2;
                att_key(K + (size_t)kr * 256 + kvh * 64, VT + (size_t)(kvh * 64) * MPAD + kr, MPAD, q, bt[t - t2], m, l, o); } }
        } else {
            const int bs = (r - ROW_SAMP) / TS, t = (r - ROW_SAMP) % TS;
            const bf16* kc = WSP(bf16, W_KC) + ((size_t)j * DECB + bs) * KCN * 256 + kvh * 64; const bf16* vc = WSP(bf16, W_VTC) + (((size_t)j * DECB + bs) * 256 + kvh * 64) * KCN;
            for (int key = 0; key < 148; ++key) {
                int dist; if (key < 16) dist = PAST + t - key; else if (key < 144) { dist = 128 + t - (key - 16); if (dist > 128) continue; } else { dist = t - (key - 144); if (dist < 0) continue; }
                if (key < 144) att_key(kc + (size_t)key * 256, vc + key, KCN, q, bt[dist > 128 ? 128 : dist], m, l, o);
                else { const int kr = ROW_SAMP + bs * TS + (key - 144); att_key(K + (size_t)kr * 256 + kvh * 64, VT + (size_t)(kvh * 64) * MPAD + kr, MPAD, q, bt[dist], m, l, o); } }
        }
        const float inv = 1.f / l;
        UNROLL for (int d = 0; d < 64; ++d) OG[(size_t)r * D + h * 64 + d] = f2bf(o[d] * inv * bf2f(GS[(size_t)r * D + h * 64 + d]));
    }
}
HD inline void ph_resid(const Params& P, int last, long gt, long gs) {
    float* X = WSP(float, W_X); const float* T = WSP(float, W_TMP);
    for (long i = gt; i < (long)NROWS * D; i += gs) { const float v = X[i] + T[i]; X[i] = v;
        if (last) { const int r = (int)(i / D); if (r < NP) P.out[O_YP + i] = v; else if (r >= ROW_SAMP) P.out[O_YS + (i - (size_t)ROW_SAMP * D)] = v; } }
}
HD inline void ph_m1e(const Params& P, int j, long gt, long gs) {
    const float* T = WSP(float, W_TMP); bf16* XM = WSP(bf16, W_XM); bf16* ZS = WSP(bf16, W_ZS); bf16* OS = WSP(bf16, W_OS);
    for (long i = gt; i < (long)MPAD * ML_N; i += gs) { const int r = (int)(i / ML_N), c = (int)(i % ML_N); const float v = T[i];
        if (c < 2048) { XM[(size_t)r * MI + c] = f2bf(v);
            if (r < NP) { const int b = r / SEQ, t = r % SEQ; if (t >= SEQ - 3) P.out[O_PCONV + (((size_t)j * BATCH + b) * 3 + (t - (SEQ - 3))) * 2048 + c] = v; }
            else if (r >= ROW_SAMP && r < NROWS) { const int bs = (r - ROW_SAMP) / TS, t = (r - ROW_SAMP) % TS; if (t >= 1) P.out[O_SCONV + (((size_t)j * DECB + bs) * 3 + (t - 1)) * 2048 + c] = v; } }
        else if (c < 4096) ZS[(size_t)r * MI + c - 2048] = f2bf(siluf(v));
        else OS[(size_t)r * MI + c - 4096] = f2bf(sigmf(v)); }
}
HD inline float conv_in(const Params& P, int j, int r, int back, int c) {
    int rr = r;
    for (int s = 0; s < back; ++s) { const int p = prev_row(rr);
        if (p == -1) return 0.f;
        if (p == -2) { const int bs = (r - ROW_SAMP) / TS; const int remaining = back - s;
            return P.in[I_SCONV][(((size_t)j * DECB + bs) * 3 + (3 - remaining)) * 2048 + c]; }
        rr = p; }
    return bf2f(WSP(bf16, W_XM)[(size_t)rr * MI + c]);
}
HD inline void ph_conv(const Params& P, int j, long gt, long gs) {
    bf16* XC = WSP(bf16, W_XC); const float* cw = P.in[I_MCW] + (size_t)j * 4 * 2048; const float* cb = P.in[I_MCB] + (size_t)j * 2048;
    for (long i = gt; i < (long)MPAD * MI; i += gs) { const int r = (int)(i / MI), c = (int)(i % MI);
        if (r >= NROWS) { XC[i] = 0; continue; }
        float a = cb[c];
        for (int w = 0; w < 4; ++w) a += conv_in(P, j, r, 3 - w, c) * cw[w * 2048 + c];
        XC[i] = f2bf(siluf(a)); }
}
HD inline void ph_gates(const Params& P, int j, long gt, long gs) {
    const bf16* XC = WSP(bf16, W_XC); const bf16* XM = WSP(bf16, W_XM); const float* G = WSP(float, W_G) + (size_t)j * 4096 * 8; float* GA = WSP(float, W_GATES);
    for (long i = gt; i < (long)NROWS * 8; i += gs) { const int r = (int)(i / 8), g = (int)(i % 8);
        float a = P.in[I_MBG][j * 8 + g];
        for (int c = 0; c < 2048; ++c) a += bf2f(XC[(size_t)r * MI + c]) * G[(size_t)c * 8 + g] + bf2f(XM[(size_t)r * MI + c]) * G[(size_t)(2048 + c) * 8 + g];
        GA[i] = a; }
}
HD inline void scal_chunk(const float* GA, int h, int row0, int L, float& m, float* SA, float* SCJ, float* SWI, float* SEM, float* SWK, float& decay) {
    float b = 0.f, pm = -3.0e38f; const float m_prev = m; float mt = m_prev;
    for (int t = 0; t < L; ++t) { const int r = row0 + t; const float ip = GA[(size_t)r * 8 + h], lf = logsigf(GA[(size_t)r * 8 + 4 + h]);
        b += lf; const float cj = ip - b; pm = cj > pm ? cj : pm; const float mx = m_prev > pm ? m_prev : pm;
        mt = b + mx; SA[r * 4 + h] = -mx; SCJ[r * 4 + h] = cj; SWI[r * 4 + h] = expf(m_prev - mx); SEM[r * 4 + h] = expf(-mt); }
    const float g = b, m_new = mt;
    for (int t = 0; t < L; ++t) { const int r = row0 + t; SWK[r * 4 + h] = expf(g + SCJ[r * 4 + h] - m_new); }
    decay = expf(g + m_prev - m_new); m = m_new;
}
HD inline void ph_scal(const Params& P, int j, long gt, long gs) {
    const float* GA = WSP(float, W_GATES); float* SA = WSP(float, W_SA); float* SCJ = WSP(float, W_SCJ); float* SWI = WSP(float, W_SWI); float* SEM = WSP(float, W_SEM); float* SWK = WSP(float, W_SWK);
    float* DEC = WSP(float, W_DEC);
    for (long i = gt; i < (long)(BATCH + DECB) * 4; i += gs) {
        if (i < BATCH * 4) { const int b = (int)(i / 4), h = (int)(i % 4); float m = 0.f;
            for (int c = 0; c < NCH; ++c) { float dec; const int row0 = c == 0 ? ROW_META + b * NMETA : b * SEQ + (c - 1) * LCH;
                scal_chunk(GA, h, row0, c == 0 ? NMETA : LCH, m, SA, SCJ, SWI, SEM, SWK, dec); DEC[(size_t)i * NCH + c] = dec; }
            P.out[O_PM + (size_t)j * BATCH * 4 + i] = m;
        } else { const long k = i - BATCH * 4; const int bs = (int)(k / 4), h = (int)(k % 4); float m = P.in[I_SM][(size_t)j * DECB * 4 + k]; float dec;
            scal_chunk(GA, h, ROW_SAMP + bs * TS, TS, m, SA, SCJ, SWI, SEM, SWK, dec); DEC[(size_t)BATCH * 4 * NCH + k] = dec;
            P.out[O_SMM + (size_t)j * DECB * 4 + k] = m; }
    }
}
HD inline void ph_pmat(const Params& P, long gt, long gs) {
    const bf16* Q = WSP(bf16, W_MQ); const bf16* K = WSP(bf16, W_MK); const float* SA = WSP(float, W_SA); const float* SCJ = WSP(float, W_SCJ); bf16* PM = WSP(bf16, W_P);
    for (long i = gt; i < (long)NP * 4 * 64; i += gs) { const int j4 = (int)(i % 64) * 4, h = (int)((i / 64) % 4), r = (int)(i / 256);
        const int tt = r % LCH, r0 = r - tt; const bf16* q = Q + (size_t)r * MI + h * 512;
        for (int jj = j4; jj < j4 + 4; ++jj) { float v = 0.f;
            if (jj <= tt) { const bf16* k = K + (size_t)(r0 + jj) * MI + h * 512; float s = 0.f; for (int d = 0; d < 512; ++d) s += bf2f(q[d]) * bf2f(k[d]);
                v = s * expf(SA[r * 4 + h] + SCJ[(r0 + jj) * 4 + h]); }
            PM[(size_t)r * 2048 + h * 512 + jj] = f2bf(v); } }
}
HD inline void ph_state(const Params& P, int j, int c, long gt, long gs) {
    const bf16* KT = WSP(bf16, W_MKT); const bf16* VT = WSP(bf16, W_MVT); const float* SWK = WSP(float, W_SWK); const float* DEC = WSP(float, W_DEC);
    float* CST = WSP(float, W_CST); bf16* CT = WSP(bf16, W_CT); float* NST = WSP(float, W_NST); float* NRUN = WSP(float, W_NRUN);
    const int L = c == 0 ? NMETA : LCH;
    for (long i = gt; i < (long)BATCH * 4 * 512 * 128; i += gs) { const int d4 = (int)(i % 128) * 4, e = (int)((i / 128) % 512), bh = (int)(i / (128 * 512)); const int b = bh / 4, h = bh % 4;
        const int row0 = c == 0 ? ROW_META + b * NMETA : b * SEQ + (c - 1) * LCH; const float dec = DEC[(size_t)bh * NCH + c];
        float acc[4] = {0.f, 0.f, 0.f, 0.f};
        const bf16* vt = VT + vtb_idx(row0, h, e);
        for (int t = 0; t < L; ++t) { const float wv = SWK[(row0 + t) * 4 + h] * bf2f(vt[t]);
            UNROLL for (int u = 0; u < 4; ++u) acc[u] += wv * bf2f(KT[(size_t)(h * 512 + d4 + u) * MPAD + row0 + t]); }
        UNROLL for (int u = 0; u < 4; ++u) { const size_t si = ((size_t)bh * 512 + e) * 512 + d4 + u; const float old = c == 0 ? 0.f : CST[si];
            if (c >= 1) CT[ctb_idx(c, b, h, e, d4 + u)] = f2bf(old);
            const float nv = dec * old + acc[u]; CST[si] = nv;
            if (c == NCH - 1) P.out[O_PC + (((size_t)j * BATCH * 4 + bh) * 512 + d4 + u) * 512 + e] = nv; }
        if (e == 0) UNROLL for (int u = 0; u < 4; ++u) { const int d = d4 + u; float a = 0.f;
            for (int t = 0; t < L; ++t) a += SWK[(row0 + t) * 4 + h] * bf2f(KT[(size_t)(h * 512 + d) * MPAD + row0 + t]);
            const float old = c == 0 ? 0.f : NRUN[bh * 512 + d]; NST[((size_t)bh * NCH + c) * 512 + d] = old; const float nv = dec * old + a; NRUN[bh * 512 + d] = nv;
            if (c == NCH - 1) P.out[O_PN + ((size_t)j * BATCH * 4 + bh) * 512 + d] = nv; }
    }
}
HD inline void ph_den(const Params& P, long gt, long gs) {
    const bf16* Q = WSP(bf16, W_MQ); const bf16* PM = WSP(bf16, W_P); const float* NST = WSP(float, W_NST); const float* SWI = WSP(float, W_SWI); float* DEN = WSP(float, W_DEN);
    for (long i = gt; i < (long)NP * 4; i += gs) { const int r = (int)(i / 4), h = (int)(i % 4), b = r / SEQ, c = (r % SEQ) / LCH + 1, bh = b * 4 + h;
        float s = 0.f; for (int jj = 0; jj < 256; ++jj) s += bf2f(PM[(size_t)r * 2048 + h * 512 + jj]);
        float qn = 0.f; const float* n = NST + ((size_t)bh * NCH + c) * 512; for (int d = 0; d < 512; ++d) qn += bf2f(Q[(size_t)r * MI + h * 512 + d]) * n[d];
        DEN[r * 4 + h] = s + SWI[r * 4 + h] * qn; }
}
HD inline void ph_num(const Params& P, long gt, long gs) {
    const bf16* Q = WSP(bf16, W_MQ); const bf16* PM = WSP(bf16, W_P); const bf16* CT = WSP(bf16, W_CT); const bf16* VT = WSP(bf16, W_MVT);
    const float* SWI = WSP(float, W_SWI); const float* SEM = WSP(float, W_SEM); const float* DEN = WSP(float, W_DEN); bf16* H = WSP(bf16, W_H);
    for (long i = gt; i < (long)NP * 4 * 128; i += gs) { const int e4 = (int)(i % 128) * 4, h = (int)((i / 128) % 4), r = (int)(i / 512); const int b = r / SEQ, tt = r % LCH, r0 = r - tt, c = (r % SEQ) / LCH + 1, bh = b * 4 + h;
        const bf16* q = Q + (size_t)r * MI + h * 512; const bf16* p = PM + (size_t)r * 2048 + h * 512;
        const float wi = SWI[r * 4 + h]; const float den = DEN[r * 4 + h]; const float dd = fmaxf(fabsf(den), SEM[r * 4 + h]);
        UNROLL for (int u = 0; u < 4; ++u) { const int e = e4 + u; const bf16* ct = CT + ctb_idx(c, b, h, e, 0);
            float a = 0.f; for (int d = 0; d < 512; ++d) a += bf2f(q[d]) * bf2f(ct[d]);
            a *= wi; const bf16* vt = VT + vtb_idx(r0, h, e);
            for (int jj = 0; jj <= tt; ++jj) a += bf2f(p[jj]) * bf2f(vt[jj]);
            H[(size_t)r * MI + h * 512 + e] = f2bf(a / dd); } }
}
HD inline void small_item(long it, int& h, int& row0, int& L, bool& samp, int& idx) {
    if (it < BATCH * 4) { idx = (int)(it / 4); h = (int)(it % 4); row0 = ROW_META + idx * NMETA; L = NMETA; samp = false; }
    else { const long k = it - BATCH * 4; idx = (int)(k / 4); h = (int)(k % 4); row0 = ROW_SAMP + idx * TS; L = TS; samp = true; }
}
HD inline void ph_smalls(const Params& P, int j, int only_meta, long gt, long gs) {
    const bf16* Q = WSP(bf16, W_MQ); const bf16* K = WSP(bf16, W_MK); const float* SA = WSP(float, W_SA); const float* SCJ = WSP(float, W_SCJ); const float* SWI = WSP(float, W_SWI);
    float* PSM = WSP(float, W_PSM); float* DEN = WSP(float, W_DEN);
    for (long i = gt; i < (long)(only_meta ? BATCH : BATCH + DECB) * 4 * 16; i += gs) { const long it = i / 16; const int t = (int)(i % 16); int h, row0, L, idx; bool samp; small_item(it, h, row0, L, samp, idx);
        if (t >= L) continue; const int r = row0 + t; const bf16* q = Q + (size_t)r * MI + h * 512; float s = 0.f;
        for (int jj = 0; jj < 16; ++jj) { float v = 0.f;
            if (jj <= t) { const bf16* k = K + (size_t)(row0 + jj) * MI + h * 512; float a = 0.f; for (int d = 0; d < 512; ++d) a += bf2f(q[d]) * bf2f(k[d]); v = a * expf(SA[r * 4 + h] + SCJ[(row0 + jj) * 4 + h]); }
            PSM[(size_t)it * 256 + t * 16 + jj] = v; s += v; }
        float qn = 0.f;
        if (samp) { const float* n = P.in[I_SN] + (((size_t)j * DECB + idx) * 4 + h) * 512; for (int d = 0; d < 512; ++d) qn += bf2f(q[d]) * n[d]; }
        DEN[r * 4 + h] = s + SWI[r * 4 + h] * qn; }
}
HD inline void ph_smallm(const Params& P, int j, int only_meta, long gt, long gs) {
    const bf16* Q = WSP(bf16, W_MQ); const bf16* K = WSP(bf16, W_MK); const bf16* VT = WSP(bf16, W_MVT); const float* PSM = WSP(float, W_PSM);
    const float* SWI = WSP(float, W_SWI); const float* SEM = WSP(float, W_SEM); const float* SWK = WSP(float, W_SWK); const float* DEN = WSP(float, W_DEN); const float* DEC = WSP(float, W_DEC); bf16* H = WSP(bf16, W_H);
    for (long i = gt; i < (long)(only_meta ? BATCH : BATCH + DECB) * 4 * 512; i += gs) { const long it = i / 512; const int x = (int)(i % 512); int h, row0, L, idx; bool samp; small_item(it, h, row0, L, samp, idx);
        float v[16];
        UNROLL for (int t = 0; t < 16; ++t) v[t] = t < L ? bf2f(VT[vtb_idx(row0 + t, h, x)]) : 0.f;
        float acc0 = 0.f, acc1 = 0.f, acc2 = 0.f, acc3 = 0.f;
        if (samp) { const size_t so = (((size_t)j * DECB + idx) * 4 + h) * 512 * 512; const float* cin = P.in[I_SC] + so; float* cout = P.out + O_SCC + so; const float dec = DEC[(size_t)BATCH * 4 * NCH + (it - BATCH * 4)];
            const float wv0 = SWK[(row0 + 0) * 4 + h] * v[0], wv1 = SWK[(row0 + 1) * 4 + h] * v[1], wv2 = SWK[(row0 + 2) * 4 + h] * v[2], wv3 = SWK[(row0 + 3) * 4 + h] * v[3];
            const bf16* q0 = Q + (size_t)row0 * MI + h * 512; const bf16* k0 = K + (size_t)row0 * MI + h * 512;
            for (int d = 0; d < 512; ++d) { const float ci = cin[(size_t)d * 512 + x]; float a = dec * ci;
                acc0 += bf2f(q0[d]) * ci; acc1 += bf2f(q0[MI + d]) * ci; acc2 += bf2f(q0[2 * MI + d]) * ci; acc3 += bf2f(q0[3 * MI + d]) * ci;
                a += wv0 * bf2f(k0[d]) + wv1 * bf2f(k0[MI + d]) + wv2 * bf2f(k0[2 * MI + d]) + wv3 * bf2f(k0[3 * MI + d]);
                cout[(size_t)d * 512 + x] = a; }
            const size_t no = (((size_t)j * DECB + idx) * 4 + h) * 512 + x; float a = dec * P.in[I_SN][no];
            for (int t = 0; t < 4; ++t) a += SWK[(row0 + t) * 4 + h] * bf2f(K[(size_t)(row0 + t) * MI + h * 512 + x]);
            P.out[O_SNN + no] = a; }
        UNROLL for (int t = 0; t < 16; ++t) { if (t < L) { const int r = row0 + t; const float ac = t == 0 ? acc0 : t == 1 ? acc1 : t == 2 ? acc2 : t == 3 ? acc3 : 0.f; float a = SWI[r * 4 + h] * ac;
            UNROLL for (int jj = 0; jj < 16; ++jj) if (jj <= t) a += PSM[(size_t)it * 256 + t * 16 + jj] * v[jj];
            H[(size_t)r * MI + h * 512 + x] = f2bf(a / fmaxf(fabsf(DEN[r * 4 + h]), SEM[r * 4 + h])); } } }
}
HD inline void ph_hnorm(const Params& P, int j, long gt, long gs) {
    const bf16* H = WSP(bf16, W_H); const bf16* OS = WSP(bf16, W_OS); const bf16* XC = WSP(bf16, W_XC); const bf16* ZS = WSP(bf16, W_ZS); bf16* A2 = WSP(bf16, W_A2);
    const float* hn = P.in[I_MHN] + (size_t)j * 2048; const float* sk = P.in[I_MSKIP] + (size_t)j * 2048;
    for (long i = gt; i < (long)MPAD * 4; i += gs) { const int r = (int)(i / 4), h = (int)(i % 4); const size_t o = (size_t)r * MI + h * 512;
        if (r >= NROWS) { for (int e = 0; e < 512; ++e) A2[o + e] = 0; continue; }
        float s = 0.f; for (int e = 0; e < 512; ++e) s += bf2f(H[o + e]); const float mu = s / 512.f;
        float q = 0.f; for (int e = 0; e < 512; ++e) { const float dlt = bf2f(H[o + e]) - mu; q += dlt * dlt; } const float rs = 1.f / sqrtf(q / 512.f + EPS);
        for (int e = 0; e < 512; ++e) { const int c = h * 512 + e; const float y = (bf2f(H[o + e]) - mu) * rs * hn[c];
            A2[o + e] = f2bf((bf2f(OS[o + e]) * y + sk[c] * bf2f(XC[o + e])) * bf2f(ZS[o + e])); } }
}

template <int PH> HD inline void dispatch(const Params& P, int a0, int a1, long gt, long gs) {
    if constexpr (PH == PH_WCONV) ph_wconv(P, gt, gs);
    else if constexpr (PH == PH_GMAT) ph_gmat(P, gt, gs);
    else if constexpr (PH == PH_INITX) ph_initx(P, gt, gs);
    else if constexpr (PH == PH_CACHE) ph_cache(P, gt, gs);
    else if constexpr (PH == PH_NORM) ph_norm(P, a0, gt, gs);
    else if constexpr (PH == PH_S1E) ph_s1e(P, a0, gt, gs);
    else if constexpr (PH == PH_ATT) ph_att(P, a0, gt, gs);
    else if constexpr (PH == PH_RESID) ph_resid(P, a0, gt, gs);
    else if constexpr (PH == PH_M1E) ph_m1e(P, a0, gt, gs);
    else if constexpr (PH == PH_CONV) ph_conv(P, a0, gt, gs);
    else if constexpr (PH == PH_GATES) ph_gates(P, a0, gt, gs);
    else if constexpr (PH == PH_SCAL) ph_scal(P, a0, gt, gs);
    else if constexpr (PH == PH_PMAT) ph_pmat(P, gt, gs);
    else if constexpr (PH == PH_STATE) ph_state(P, a0, a1, gt, gs);
    else if constexpr (PH == PH_DEN) ph_den(P, gt, gs);
    else if constexpr (PH == PH_NUM) ph_num(P, gt, gs);
    else if constexpr (PH == PH_SMALLS) ph_smalls(P, a0, a1, gt, gs);
    else if constexpr (PH == PH_SMALLM) ph_smallm(P, a0, a1, gt, gs);
    else if constexpr (PH == PH_HNORM) ph_hnorm(P, a0, gt, gs);
    else if constexpr (PH == PH_SWAOUT) ph_swaout(P, a0, gt, gs);
}
struct GemmDesc { const bf16* A; const bf16* B; void* C; long lda, ldb, ldc; int M, N, K, mode; };
HD inline void ph_gemm(const GemmDesc& g, long gt, long gs) {
    const int nm = g.M / 4, nn = g.N / 4;
    for (long i = gt; i < (long)nm * nn; i += gs) { const int m0 = (int)(i / nn) * 4, n0 = (int)(i % nn) * 4;
        float acc[4][4]; UNROLL for (int a = 0; a < 4; ++a) UNROLL for (int b = 0; b < 4; ++b) acc[a][b] = 0.f;
        for (int k = 0; k < g.K; k += 8) {
            float av[4][8], bv[4][8];
            UNROLL for (int a = 0; a < 4; ++a) UNROLL for (int kk = 0; kk < 8; ++kk) av[a][kk] = bf2f(g.A[(size_t)(m0 + a) * g.lda + k + kk]);
            UNROLL for (int b = 0; b < 4; ++b) UNROLL for (int kk = 0; kk < 8; ++kk) bv[b][kk] = bf2f(g.B[(size_t)(n0 + b) * g.ldb + k + kk]);
            UNROLL for (int a = 0; a < 4; ++a) UNROLL for (int b = 0; b < 4; ++b) UNROLL for (int kk = 0; kk < 8; ++kk) acc[a][b] += av[a][kk] * bv[b][kk];
        }
        UNROLL for (int a = 0; a < 4; ++a) UNROLL for (int b = 0; b < 4; ++b) { const float v = acc[a][b];
            if (g.mode == 0) ((float*)g.C)[(size_t)(m0 + a) * g.ldc + n0 + b] = v;
            else if (g.mode == 1) ((bf16*)g.C)[(size_t)(m0 + a) * g.ldc + n0 + b] = f2bf(v);
            else ((bf16*)g.C)[(size_t)(n0 + b) * g.ldc + m0 + a] = f2bf(v); }
    }
}
#define LAS __attribute__((address_space(3)))
#define XB_TMO      128
#define XB_XCNT(j)  (256  + 64 * (j))
#define XB_XSUB(j)  (1280 + 64 * (j))
#define XB_XGEN(j)  (2304 + 64 * (j))
#define XB_TOP      3328
#define XB_TOPGEN   3392
#define XCD_BAR_WORDS 3456
#define XB_SPIN_CAP (1u << 24)

__device__ __forceinline__ unsigned xb_ld(unsigned* p)              { return __hip_atomic_load(p, __ATOMIC_RELAXED, __HIP_MEMORY_SCOPE_AGENT); }
__device__ __forceinline__ unsigned xb_add(unsigned* p, unsigned v) { return __hip_atomic_fetch_add(p, v, __ATOMIC_RELAXED, __HIP_MEMORY_SCOPE_AGENT); }
__device__ __forceinline__ unsigned xb_xcc_id() { return (unsigned)__builtin_amdgcn_s_getreg((3 << 11) | 20) & 0xFu; }
#define XB_SPIN(cond, bar) do { unsigned _sp = 0; while (cond) { __builtin_amdgcn_s_sleep(1); \
    if ((++_sp & 255u) == 0u) { if (xb_ld(&(bar)[XB_TMO])) break; if (_sp > XB_SPIN_CAP) { atomicAdd(&(bar)[XB_TMO], 1u); break; } } } } while (0)

struct XcdBarrier {
    unsigned* bar; unsigned x;
    volatile LAS unsigned* st;
};

__device__ __forceinline__ XcdBarrier xcd_barrier_post(unsigned* bar, volatile LAS unsigned* st) {
    XcdBarrier b; b.bar = bar; b.x = xb_xcc_id(); b.st = st;
    if (threadIdx.x == 0) (void)xb_add(&bar[XB_XCNT(b.x)], 1u);
    return b;
}
__device__ __forceinline__ void xcd_barrier_complete(unsigned* bar, unsigned x, unsigned& nloc, unsigned& nx) {
    const unsigned G = gridDim.x * gridDim.y * gridDim.z;
    unsigned sum, cnt, mine, sp = 0u;
    for (;;) {
        sum = 0u; cnt = 0u; mine = 0u;
#pragma unroll
        for (unsigned j = 0; j < 16; ++j) { const unsigned c = xb_ld(&bar[XB_XCNT(j)]); sum += c; cnt += (c > 0u) ? 1u : 0u; mine = (j == x) ? c : mine; }
        if (sum == G) break;
        __builtin_amdgcn_s_sleep(1);
        if ((++sp & 255u) == 0u) { if (xb_ld(&bar[XB_TMO])) break; if (sp > XB_SPIN_CAP) { atomicAdd(&bar[XB_TMO], 1u); break; } }
    }
    nloc = mine > 0u ? mine : 1u; nx = cnt > 0u ? cnt : 1u;
}

__device__ __forceinline__ void xcd_barrier(const XcdBarrier& b) {
    asm volatile("s_waitcnt vmcnt(0)" ::: "memory");
    __syncthreads();
    if (threadIdx.x == 0) {
        unsigned* bar = b.bar;
        __builtin_amdgcn_s_waitcnt(0);
        unsigned nloc = b.st[0], nx = b.st[1];
        if (nloc == 0u) { xcd_barrier_complete(bar, b.x, nloc, nx); b.st[0] = nloc; b.st[1] = nx; }
        const unsigned old = xb_add(&bar[XB_XSUB(b.x)], 1u);
        const unsigned gen = old / nloc;
        if (old + 1u == (gen + 1u) * nloc) {
            __builtin_amdgcn_fence(__ATOMIC_RELEASE, "agent");
            asm volatile("s_waitcnt vmcnt(0)" ::: "memory");
            const unsigned og = xb_add(&bar[XB_TOP], 1u);
            const unsigned tg = og / nx;
            if (og + 1u == (tg + 1u) * nx) xb_add(&bar[XB_TOPGEN], 1u);
            else XB_SPIN(xb_ld(&bar[XB_TOPGEN]) == tg, bar);
            __builtin_amdgcn_fence(__ATOMIC_ACQUIRE, "agent");
            xb_add(&bar[XB_XGEN(b.x)], 1u);
            asm volatile("s_waitcnt vmcnt(0)" ::: "memory");
        } else {
            XB_SPIN(xb_ld(&bar[XB_XGEN(b.x)]) == gen, bar);
            __builtin_amdgcn_fence(__ATOMIC_ACQUIRE, "agent");
            asm volatile("s_waitcnt vmcnt(0)" ::: "memory");
        }
    }
    __syncthreads();
}

#define WSP2(PP, T, off) ((T*)((PP).ws + (off)))
namespace pg8 {
typedef short bf16x8 __attribute__((ext_vector_type(8)));
typedef float f32x4 __attribute__((ext_vector_type(4)));
typedef unsigned u32x2 __attribute__((ext_vector_type(2)));
constexpr int BM = 256, BK = 64, HALF = 128, HTB = HALF * BK * 2, STAGE_BYTES = 8 * HTB;
__device__ __forceinline__ int lds_byte(int r, int c) { const int st = (r >> 4) * 2 + (c >> 5), rr = r & 15, cc = c & 31, ob = rr * 64 + cc * 2; return st * 1024 + (ob ^ (((ob >> 9) & 1) << 5)); }
__device__ __forceinline__ void stage_rc(int b, int& R, int& C) { const int st = b / 1024, sb = b % 1024, swz = sb ^ (((sb >> 9) & 1) << 5); R = (st >> 1) * 16 + swz / 64; C = (st & 1) * 32 + (swz % 64) / 2; }
__device__ __forceinline__ unsigned cvt_pk_bf16(float lo, float hi) {
    typedef __bf16 b2_t __attribute__((ext_vector_type(2))); typedef float f2_t __attribute__((ext_vector_type(2)));
    const f2_t v = {lo, hi}; const b2_t r = __builtin_convertvector(v, b2_t); return __builtin_bit_cast(unsigned, r); }
__device__ __forceinline__ int perm32(int rho) { const int n = rho >> 4, i = rho & 15; return 8 * (i >> 2) + 4 * n + (i & 3); }
struct Unit { const char* A; const char* B; int pm, pn, aux, nt; };
template <class Epi, class Sched>
__device__ __forceinline__ void gemm_phase(LAS unsigned char* lds, const int lda, const int ldb, const Sched& S, const Epi& E) {
    int tid = threadIdx.x; asm volatile("" : "+v"(tid));
    const int wid = __builtin_amdgcn_readfirstlane(tid >> 6), lane = tid & 63, wr = wid >> 2, wc = wid & 3, fr = lane & 15, fq = lane >> 4;
    unsigned voffA[2], voffB[2];
#pragma unroll
    for (int i = 0; i < 2; ++i) { int R, C; stage_rc(tid * 16 + i * 8192, R, C); const int Rb = Epi::PERM ? ((R & ~31) + perm32(R & 31)) : R;
        voffA[i] = (unsigned)(R * lda + C) * 2u; voffB[i] = (unsigned)(Rb * ldb + C) * 2u; }
    const size_t kstep = (size_t)(BK * 2);
    const size_t hstepA = (size_t)HALF * lda * 2, hstepB = (size_t)HALF * ldb * 2;
    const unsigned ldsw = (unsigned)wid * 1024u;
    const int aoff = lds_byte(wr * 64 + fr, fq * 8), boff = lds_byte(wc * 32 + fr, fq * 8);
#define PG8_SA(b, h) (((b) * 2 + (h)) * HTB)
#define PG8_SB(b, h) ((4 + (b) * 2 + (h)) * HTB)
#define PG8_STAGE(bufoff, gbase, voff) do { _Pragma("unroll") for (int _i = 0; _i < 2; ++_i) \
        __builtin_amdgcn_global_load_lds((const unsigned*)((const char*)(gbase) + (voff)[_i]), (LAS unsigned*)(lds + (bufoff) + ldsw + _i * 8192), 16, 0, 0); } while (0)
#define PG8_LDA(dst, b, h) do { _Pragma("unroll") for (int m = 0; m < 4; ++m) _Pragma("unroll") for (int k = 0; k < 2; ++k) dst[m][k] = *(const LAS bf16x8*)(lds + PG8_SA(b, h) + aoff + m * 2048 + k * 1024); } while (0)
#define PG8_LDB(dst, b, h) do { _Pragma("unroll") for (int n = 0; n < 2; ++n) _Pragma("unroll") for (int k = 0; k < 2; ++k) dst[n][k] = *(const LAS bf16x8*)(lds + PG8_SB(b, h) + boff + n * 2048 + k * 1024); } while (0)
#define PG8_MMA(ai, bj, At, Bt) do { __builtin_amdgcn_s_setprio(1); _Pragma("unroll") for (int m = 0; m < 4; ++m) _Pragma("unroll") for (int n = 0; n < 2; ++n) _Pragma("unroll") for (int k = 0; k < 2; ++k) \
        acc[ai][bj][m][n] = __builtin_amdgcn_mfma_f32_16x16x32_bf16(Bt[n][k], At[m][k], acc[ai][bj][m][n], 0, 0, 0); __builtin_amdgcn_s_setprio(0); } while (0)
#define PG8_WAIT_V(n) asm volatile("s_waitcnt vmcnt(" #n ")" ::: "memory")
#define PG8_WAIT_L(n) asm volatile("s_waitcnt lgkmcnt(" #n ")" ::: "memory")
#define PG8_BAR __builtin_amdgcn_s_barrier()
#define PG8_SCHED __builtin_amdgcn_sched_barrier(0)
    Unit cur, nxt; int ui = 0;
    if (!S.next(0, cur)) return;
    f32x4 acc[2][2][4][2];
#pragma unroll
    for (int a = 0; a < 2; ++a)
#pragma unroll
        for (int b = 0; b < 2; ++b)
#pragma unroll
            for (int m = 0; m < 4; ++m)
#pragma unroll
                for (int n = 0; n < 2; ++n) acc[a][b][m][n] = (f32x4){0.f, 0.f, 0.f, 0.f};
    bf16x8 At[4][2], B0[2][2], B1[2][2];
    const char* cA = cur.A; const char* cB = cur.B;
    PG8_STAGE(PG8_SB(0, 0), cB, voffB); PG8_STAGE(PG8_SB(0, 1), cB + hstepB, voffB); PG8_STAGE(PG8_SA(0, 0), cA, voffA); PG8_STAGE(PG8_SA(0, 1), cA + hstepA, voffA);
    if (wr == 1) PG8_BAR;
    PG8_WAIT_V(2); PG8_BAR;
    PG8_STAGE(PG8_SB(1, 0), cB + kstep, voffB); PG8_STAGE(PG8_SA(1, 0), cA + kstep, voffA); PG8_STAGE(PG8_SB(1, 1), cB + hstepB + kstep, voffB);
    PG8_WAIT_V(6); PG8_BAR;
    for (;;) {
        const bool has_next = S.next(ui + 1, nxt);
        const char* nA = has_next ? nxt.A : cA; const char* nB = has_next ? nxt.B : cB; const int nt = cur.nt;
        for (int t = 0; t < nt; t += 2) {
            const bool last = (t == nt - 2);
            const char* a1 = cA + (size_t)(t + 1) * kstep;
            const char* a2 = last ? nA : cA + (size_t)(t + 2) * kstep; const char* b2 = last ? nB : cB + (size_t)(t + 2) * kstep;
            const char* a3 = a2 + kstep; const char* b3 = b2 + kstep;
            PG8_LDB(B0, 0, 0); PG8_LDB(B1, 0, 1); PG8_SCHED; PG8_LDA(At, 0, 0); PG8_STAGE(PG8_SA(1, 1), a1 + hstepA, voffA);
            PG8_WAIT_V(8); PG8_WAIT_L(0); PG8_BAR; PG8_MMA(0, 0, At, B0); PG8_MMA(0, 1, At, B1); PG8_BAR; PG8_SCHED;
            PG8_LDA(At, 0, 1); PG8_STAGE(PG8_SB(0, 0), b2, voffB); PG8_STAGE(PG8_SB(0, 1), b2 + hstepB, voffB); PG8_STAGE(PG8_SA(0, 0), a2, voffA);
            PG8_WAIT_V(8); PG8_WAIT_L(0); PG8_BAR; PG8_MMA(1, 0, At, B0); PG8_MMA(1, 1, At, B1); PG8_BAR; PG8_SCHED;
            PG8_LDB(B0, 1, 0); PG8_LDB(B1, 1, 1); PG8_SCHED; PG8_LDA(At, 1, 0); PG8_STAGE(PG8_SA(0, 1), a2 + hstepA, voffA);
            PG8_WAIT_V(8); PG8_WAIT_L(0); PG8_BAR; PG8_MMA(0, 0, At, B0); PG8_MMA(0, 1, At, B1); PG8_BAR; PG8_SCHED;
            PG8_LDA(At, 1, 1); PG8_STAGE(PG8_SB(1, 0), b3, voffB); PG8_STAGE(PG8_SB(1, 1), b3 + hstepB, voffB); PG8_STAGE(PG8_SA(1, 0), a3, voffA);
            PG8_WAIT_V(8); PG8_WAIT_L(0); PG8_BAR; PG8_MMA(1, 0, At, B0); PG8_MMA(1, 1, At, B1); PG8_BAR; PG8_SCHED;
        }
        if (wr == 0) PG8_BAR;
        const bool keep = E(acc, cur, wr, wc, fr, fq);
        if (!has_next) break;
        if (!keep) {
#pragma unroll
        for (int a = 0; a < 2; ++a)
#pragma unroll
            for (int b = 0; b < 2; ++b)
#pragma unroll
                for (int m = 0; m < 4; ++m)
#pragma unroll
                    for (int n = 0; n < 2; ++n) acc[a][b][m][n] = (f32x4){0.f, 0.f, 0.f, 0.f};
        }
        cur = nxt; cA = nA; cB = nB; ++ui;
        if (wr == 1) PG8_BAR;
    }
    PG8_WAIT_V(0);
    PG8_BAR;
#undef PG8_SA
#undef PG8_SB
#undef PG8_STAGE
#undef PG8_LDA
#undef PG8_LDB
#undef PG8_MMA
#undef PG8_WAIT_V
#undef PG8_WAIT_L
#undef PG8_BAR
#undef PG8_SCHED
}
struct PlainOrder {
    const char* A; const char* B; size_t tstepA, tstepB; int nM, nN, nwg, G, c, nt;
    __device__ __forceinline__ void init(const bf16* A_, int lda, const bf16* B_, int ldb, int M, int N, int K, int G_, int c_) { nt = K / BK;
        A = (const char*)A_; B = (const char*)B_; tstepA = (size_t)BM * lda * 2; tstepB = (size_t)BM * ldb * 2; nM = M / BM; nN = N / BM; nwg = nM * nN; G = G_; c = c_; }
    __device__ __forceinline__ bool next(int i, Unit& u) const {
        const long L = (long)i * G + c; if (L >= nwg) return false;
        int wgid = (int)L; { const int q = nwg / 8, r = nwg % 8, xcd = wgid % 8, off = wgid / 8; wgid = (xcd < r ? xcd * (q + 1) : r * (q + 1) + (xcd - r) * q) + off; }
        const int nig = 8 * nN, gid = wgid / nig, fm = gid * 8, gsz = (nM - fm) < 8 ? (nM - fm) : 8;
        u.pm = fm + ((wgid % nig) % gsz); u.pn = (wgid % nig) / gsz; u.aux = 0; u.nt = nt;
        u.A = A + (size_t)u.pm * tstepA; u.B = B + (size_t)u.pn * tstepB; return true;
    }
};
struct SplitTailOrder {
    const char* A; const char* B; size_t tstepA, tstepB; int K, nmain, G, c, nM;
    __device__ __forceinline__ void init(const bf16* A_, int lda, const bf16* B_, int ldb, int K_, int G_, int c_) {
        A = (const char*)A_; B = (const char*)B_; tstepA = (size_t)BM * lda * 2; tstepB = (size_t)BM * ldb * 2; K = K_; nM = NP / BM; nmain = nM * 4; G = G_; c = c_; }
    __device__ __forceinline__ bool next(int i, Unit& u) const {
        const long L = (long)i * G + c;
        if (L < nmain) { int wgid = (int)L; { const int q = nmain / 8, r = nmain % 8, xcd = wgid % 8, off = wgid / 8; wgid = (xcd < r ? xcd * (q + 1) : r * (q + 1) + (xcd - r) * q) + off; }
            const int nig = 8 * 4, gid = wgid / nig, fm = gid * 8, gsz = (nM - fm) < 8 ? (nM - fm) : 8;
            u.pm = fm + ((wgid % nig) % gsz); u.pn = (wgid % nig) / gsz; u.aux = 0; u.nt = K / BK; u.A = A + (size_t)u.pm * tstepA; u.B = B + (size_t)u.pn * tstepB; return true; }
        const int s = (int)(L - nmain); if (s >= (MPAD / BM - nM) * 16) return false;
        const int kq = s & 3; u.pn = (s >> 2) & 3; u.pm = nM + (s >> 4); u.aux = 1; u.nt = K / BK / 4;
        u.A = A + (size_t)u.pm * tstepA + (size_t)kq * (K / 4) * 2; u.B = B + (size_t)u.pn * tstepB + (size_t)kq * (K / 4) * 2; return true;
    }
};
}
namespace pg8 {
__device__ __forceinline__ u32x2 pk4(f32x4 v) { u32x2 w; w.x = cvt_pk_bf16(v[0], v[1]); w.y = cvt_pk_bf16(v[2], v[3]); return w; }
typedef unsigned u32x4e __attribute__((ext_vector_type(4)));
__device__ __forceinline__ u32x4e pk8(f32x4 a, f32x4 b) { u32x4e w; w[0] = cvt_pk_bf16(a[0], a[1]); w[1] = cvt_pk_bf16(a[2], a[3]); w[2] = cvt_pk_bf16(b[0], b[1]); w[3] = cvt_pk_bf16(b[2], b[3]); return w; }
__device__ __forceinline__ float silu_fast(float x) { return x * __builtin_amdgcn_rcpf(1.f + __expf(-x)); }
__device__ __forceinline__ float sigm_fast(float x) { return __builtin_amdgcn_rcpf(1.f + __expf(-x)); }

struct EpiResid {
    static constexpr bool PERM = false;
    const float* xin; bf16* X16; float* X32; float* out; int mode; long dummy_off;
    __device__ __forceinline__ bool operator()(f32x4 (&acc)[2][2][4][2], const Unit& u, int wr, int wc, int fr_, int fq_) const {
        int fr = fr_, fq = fq_; asm volatile("" : "+v"(fr), "+v"(fq));
        const int row0 = u.pm * BM + wr * 64 + fr, col0 = u.pn * BM + wc * 32 + 4 * fq;
        if (u.aux == 1) {
#pragma unroll
            for (int ai = 0; ai < 2; ++ai)
#pragma unroll
                for (int m = 0; m < 4; ++m) { const int row = row0 + ai * HALF + m * 16;
                    if (row < NROWS) { float* ap = X32 + (size_t)row * D + col0 + dummy_off;
#pragma unroll
                        for (int bj = 0; bj < 2; ++bj)
#pragma unroll
                            for (int n = 0; n < 2; ++n)
#pragma unroll
                                for (int e = 0; e < 4; ++e) __hip_atomic_fetch_add(ap + bj * HALF + n * 16 + e, acc[ai][bj][m][n][e], __ATOMIC_RELAXED, __HIP_MEMORY_SCOPE_AGENT); } }
            return false;
        }
#pragma unroll
        for (int ai = 0; ai < 2; ++ai) { f32x4 xv[4][2][2];
#pragma unroll
            for (int m = 0; m < 4; ++m) { const size_t o = (size_t)(row0 + ai * HALF + m * 16) * D + col0;
#pragma unroll
                for (int bj = 0; bj < 2; ++bj)
#pragma unroll
                    for (int n = 0; n < 2; ++n) {
                        if (mode == 0) xv[m][bj][n] = *(const f32x4*)(xin + o + bj * HALF + n * 16);
                        else { const u32x2 t = *(const u32x2*)(X16 + o + bj * HALF + n * 16); xv[m][bj][n] = (f32x4){__uint_as_float(t.x << 16), __uint_as_float(t.x & 0xffff0000u), __uint_as_float(t.y << 16), __uint_as_float(t.y & 0xffff0000u)}; } } }
#pragma unroll
            for (int m = 0; m < 4; ++m) { const size_t o = (size_t)(row0 + ai * HALF + m * 16) * D + col0;
#pragma unroll
                for (int bj = 0; bj < 2; ++bj)
#pragma unroll
                    for (int n = 0; n < 2; ++n) { const f32x4 v = xv[m][bj][n] + acc[ai][bj][m][n];
                        if (dummy_off) *(u32x2*)(X16 + (size_t)NP * D + o + bj * HALF + n * 16) = pk4(v);
                        else if (mode == 2) *(f32x4*)(out + O_YP + o + bj * HALF + n * 16) = v;
                        else *(u32x2*)(X16 + o + bj * HALF + n * 16) = pk4(v); } }
            asm volatile("" ::: "memory"); }
        return false;
    }
};
struct EpiSwaIn {
    static constexpr bool PERM = false;
    Params P; int j;
    __device__ __forceinline__ static float rownorm(const f32x4 (&acc)[2][2][4][2], int ai, int m) {
        float ss = 0.f;
#pragma unroll
        for (int bj = 0; bj < 2; ++bj)
#pragma unroll
            for (int n = 0; n < 2; ++n) { const f32x4 x = acc[ai][bj][m][n]; ss += (x[0] * x[0] + x[1] * x[1]) + (x[2] * x[2] + x[3] * x[3]); }
        ss += __shfl_xor(ss, 16); ss += __shfl_xor(ss, 32);
        return 1.f / sqrtf(ss * (1.f / 64.f) + EPS);
    }
    __device__ __forceinline__ bool operator()(f32x4 (&acc)[2][2][4][2], const Unit& u, int wr, int wc, int fr_, int fq_) const {
        int fr = fr_, fq = fq_; asm volatile("" : "+v"(fr), "+v"(fq));
        const int row0 = u.pm * BM + wr * 64 + fr, pn = u.pn;
        if (pn < 4) { const float* qn = P.in[I_SQN] + j * 64 + 4 * fq; bf16* Q = WSP(bf16, W_Q) + (size_t)row0 * D + (pn * 4 + wc) * 64 + 4 * fq;
            const f32x4 w00 = *(const f32x4*)(qn), w01 = *(const f32x4*)(qn + 16), w10 = *(const f32x4*)(qn + 32), w11 = *(const f32x4*)(qn + 48);
#pragma unroll
            for (int ai = 0; ai < 2; ++ai)
#pragma unroll
                for (int m = 0; m < 4; ++m) { const float rs = rownorm(acc, ai, m) * 0.18033688011112042f  ; bf16* qp = Q + (size_t)(ai * HALF + m * 16) * D;
                    *(u32x2*)(qp) = pk4(acc[ai][0][m][0] * w00 * rs); *(u32x2*)(qp + 16) = pk4(acc[ai][0][m][1] * w01 * rs);
                    *(u32x2*)(qp + 32) = pk4(acc[ai][1][m][0] * w10 * rs); *(u32x2*)(qp + 48) = pk4(acc[ai][1][m][1] * w11 * rs); }
        } else if (pn == 4) { const float* kn = P.in[I_SKN] + j * 64 + 4 * fq; bf16* K = WSP(bf16, W_K) + (size_t)row0 * 256 + wc * 64 + 4 * fq;
            const f32x4 w00 = *(const f32x4*)(kn), w01 = *(const f32x4*)(kn + 16), w10 = *(const f32x4*)(kn + 32), w11 = *(const f32x4*)(kn + 48);
#pragma unroll
            for (int ai = 0; ai < 2; ++ai)
#pragma unroll
                for (int m = 0; m < 4; ++m) { const float rs = rownorm(acc, ai, m); bf16* kp = K + (size_t)(ai * HALF + m * 16) * 256;
                    *(u32x2*)(kp) = pk4(acc[ai][0][m][0] * w00 * rs); *(u32x2*)(kp + 16) = pk4(acc[ai][0][m][1] * w01 * rs);
                    *(u32x2*)(kp + 32) = pk4(acc[ai][1][m][0] * w10 * rs); *(u32x2*)(kp + 48) = pk4(acc[ai][1][m][1] * w11 * rs); }
        } else if (pn == 5) { bf16* VT = WSP(bf16, W_VT) + (size_t)(wc * 64 + 4 * fq) * MPAD + row0;
#pragma unroll
            for (int ai = 0; ai < 2; ++ai)
#pragma unroll
                for (int m = 0; m < 4; ++m) {
#pragma unroll
                    for (int bj = 0; bj < 2; ++bj)
#pragma unroll
                        for (int n = 0; n < 2; ++n) { const f32x4 v = acc[ai][bj][m][n]; const int dd = 32 * bj + 16 * n;
#pragma unroll
                            for (int e = 0; e < 4; ++e) VT[(size_t)(dd + e) * MPAD + ai * HALF + m * 16] = f2bf(v[e]); } }
        } else { bf16* GS = WSP(bf16, W_GS) + (size_t)row0 * D + (pn - 6) * 256 + wc * 64 + 4 * fq;
#pragma unroll
            for (int ai = 0; ai < 2; ++ai)
#pragma unroll
                for (int m = 0; m < 4; ++m) { bf16* gp = GS + (size_t)(ai * HALF + m * 16) * D;
#pragma unroll
                    for (int bj = 0; bj < 2; ++bj)
#pragma unroll
                        for (int n = 0; n < 2; ++n) { const f32x4 x = acc[ai][bj][m][n]; f32x4 v; v[0] = silu_fast(x[0]); v[1] = silu_fast(x[1]); v[2] = silu_fast(x[2]); v[3] = silu_fast(x[3]); *(u32x2*)(gp + 32 * bj + 16 * n) = pk4(v); } }
        }
        return false;
    }
};
struct EpiMlIn {
    static constexpr bool PERM = true;
    Params P; int j;
    __device__ __forceinline__ bool operator()(f32x4 (&acc)[2][2][4][2], const Unit& u, int wr, int wc, int fr_, int fq_) const {
        int fr = fr_, fq = fq_; asm volatile("" : "+v"(fr), "+v"(fq));
        const int row0 = u.pm * BM + wr * 64 + fr, pn = u.pn, kind = pn >> 3, col0 = (pn & 7) * BM + wc * 32 + 8 * fq;
        bf16* dst = kind == 0 ? WSP(bf16, W_XM) : kind == 1 ? WSP(bf16, W_ZS) : WSP(bf16, W_OS);
#pragma unroll
        for (int ai = 0; ai < 2; ++ai)
#pragma unroll
            for (int m = 0; m < 4; ++m) { const int row = row0 + ai * HALF + m * 16; bf16* dp = dst + (size_t)row * MI + col0;
                float* op = nullptr;
                if (kind == 0) { if (row < NP) { const int b = row / SEQ, t = row % SEQ; if (t >= SEQ - 3) op = P.out + O_PCONV + (((size_t)j * BATCH + b) * 3 + (t - (SEQ - 3))) * 2048 + col0; }
                    else if (row >= ROW_SAMP && row < NROWS) { const int bs = (row - ROW_SAMP) / TS, t = (row - ROW_SAMP) % TS; if (t >= 1) op = P.out + O_SCONV + (((size_t)j * DECB + bs) * 3 + (t - 1)) * 2048 + col0; } }
#pragma unroll
                for (int bj = 0; bj < 2; ++bj) { const f32x4 x0 = acc[ai][bj][m][0], x1 = acc[ai][bj][m][1]; f32x4 v0 = x0, v1 = x1;
                    if (kind == 1) {
#pragma unroll
                        for (int e = 0; e < 4; ++e) { v0[e] = silu_fast(x0[e]); v1[e] = silu_fast(x1[e]); } }
                    if (kind == 2) {
#pragma unroll
                        for (int e = 0; e < 4; ++e) { v0[e] = sigm_fast(x0[e]); v1[e] = sigm_fast(x1[e]); } }
                    *(u32x4e*)(dp + bj * HALF) = pk8(v0, v1);
                    if (op) { *(f32x4*)(op + bj * HALF) = x0; *(f32x4*)(op + bj * HALF + 4) = x1; } } }
        return false;
    }
};
struct EpiM3 {
    static constexpr bool PERM = true;
    Params P;
    __device__ __forceinline__ bool operator()(f32x4 (&acc)[2][2][4][2], const Unit& u, int wr, int wc, int fr_, int fq_) const {
        int fr = fr_, fq = fq_; asm volatile("" : "+v"(fr), "+v"(fq));
        const int kind = u.aux >> 2, h = u.aux & 3;
        bf16* C; size_t ldc;
        if (kind == 0) { C = WSP(bf16, W_MQ) + h * 512; ldc = MI; } else if (kind == 1) { C = WSP(bf16, W_MK) + h * 512; ldc = MI; }
        else if (kind == 2) { C = WSP(bf16, W_MKT) + (size_t)h * 512 * MPAD; ldc = MPAD; } else { C = WSP(bf16, W_MVT) + (size_t)u.pn * 512 * 2048 + h * 512; ldc = 2048; }
        const int row0 = u.pm * BM + wr * 64 + fr, col0 = (kind == 3 ? 0 : u.pn * BM) + wc * 32 + 8 * fq;
#pragma unroll
        for (int ai = 0; ai < 2; ++ai)
#pragma unroll
            for (int m = 0; m < 4; ++m) { bf16* dp = C + (size_t)(row0 + ai * HALF + m * 16) * ldc + col0;
#pragma unroll
                for (int bj = 0; bj < 2; ++bj) *(u32x4e*)(dp + bj * HALF) = pk8(acc[ai][bj][m][0], acc[ai][bj][m][1]); }
        return false;
    }
};
struct M3Order {
    const char* XC; const char* XM; const char* W; int ntt, Gp, c, kmode;
    __device__ __forceinline__ bool next(int i, Unit& u) const {
        const int x = c & 7, r = c >> 3, nx = (Gp - x + 7) >> 3, id = i * nx + r;
        if (id >= ntt * 3) return false;
        const int tt = id / 3, kk = id - 3 * tt, kind = kk == 2 ? 3 : kk;
        const int h = x >> 1, half = x & 1;
        const char* act = (kind == 3 ? XM : XC) + ((size_t)tt * 256 * MI + h * 512) * 2;
        const char* w = W + ((size_t)(kind == 0 ? 0 : kind == 3 ? 2 : 1) * 512 * MI + (size_t)half * 256 * MI + h * 512) * 2;
        u.aux = kind * 4 + h; u.nt = 8;
        if (kind < 2) { u.A = act; u.B = w; u.pm = tt; u.pn = half; } else { u.A = w; u.B = act; u.pm = half; u.pn = tt; }
        return true;
    }
};
struct EpiP {
    static constexpr bool PERM = true;
    Params P;
    __device__ __forceinline__ bool operator()(f32x4 (&acc)[2][2][4][2], const Unit& u, int wr, int wc, int fr_, int fq_) const {
        int fr = fr_, fq = fq_; asm volatile("" : "+v"(fr), "+v"(fq));
        const int h = u.aux, r0 = u.pm * BM; const float* SA = WSP(float, W_SA); const float* SCJ = WSP(float, W_SCJ); bf16* PB = WSP(bf16, W_P); float* DENI = WSP(float, W_DENI);
        float cj[2][2][4];
#pragma unroll
        for (int bj = 0; bj < 2; ++bj)
#pragma unroll
            for (int n = 0; n < 2; ++n)
#pragma unroll
                for (int e = 0; e < 4; ++e) cj[bj][n][e] = SCJ[(size_t)(r0 + bj * HALF + wc * 32 + 8 * fq + 4 * n + e) * 4 + h];
#pragma unroll
        for (int ai = 0; ai < 2; ++ai)
#pragma unroll
            for (int m = 0; m < 4; ++m) { const int tl = ai * HALF + wr * 64 + m * 16 + fr; const float at = SA[(size_t)(r0 + tl) * 4 + h]; float s = 0.f;
                bf16* pp = PB + (size_t)(r0 + tl) * 2048 + h * 512 + wc * 32 + 8 * fq;
#pragma unroll
                for (int bj = 0; bj < 2; ++bj) { f32x4 v[2];
#pragma unroll
                    for (int n = 0; n < 2; ++n) { const int j0 = bj * HALF + wc * 32 + 8 * fq + 4 * n;
#pragma unroll
                        for (int e = 0; e < 4; ++e) { v[n][e] = (j0 + e <= tl) ? acc[ai][bj][m][n][e] * __expf(at + cj[bj][n][e]) : 0.f; s += v[n][e]; } }
                    *(u32x4e*)(pp + bj * HALF) = pk8(v[0], v[1]); }
                s += __shfl_xor(s, 16); s += __shfl_xor(s, 32);
                if (fq == 0) DENI[((size_t)(r0 + tl) * 4 + h) * 4 + wc] = s; }
        return false;
    }
};
struct POrder {
    const char* Q; const char* K; int nwg, G, c;
    __device__ __forceinline__ bool next(int i, Unit& u) const {
        const long L = (long)i * G + c; if (L >= nwg) return false;
        const int tt = (int)L >> 2, h = (int)L & 3; const size_t off = ((size_t)tt * 256 * MI + h * 512) * 2;
        u.A = Q + off; u.B = K + off; u.pm = tt; u.pn = 0; u.aux = h; u.nt = 8; return true;
    }
};
struct EpiNum {
    static constexpr bool PERM = true;
    Params P;
    __device__ __forceinline__ bool operator()(f32x4 (&acc)[2][2][4][2], const Unit& u, int wr, int wc, int fr_, int fq_) const {
        int fr = fr_, fq = fq_; asm volatile("" : "+v"(fr), "+v"(fq));
        const int h = u.aux >> 1, seg = u.aux & 1, row0 = u.pm * BM + wr * 64 + fr;
        if (seg == 0) { const float* SWI = WSP(float, W_SWI);
#pragma unroll
            for (int ai = 0; ai < 2; ++ai)
#pragma unroll
                for (int m = 0; m < 4; ++m) { const float wi = SWI[(size_t)(row0 + ai * HALF + m * 16) * 4 + h];
#pragma unroll
                    for (int bj = 0; bj < 2; ++bj)
#pragma unroll
                        for (int n = 0; n < 2; ++n) acc[ai][bj][m][n] *= wi; }
            return true;
        }
        const float* DEN = WSP(float, W_DEN); const float* SEM = WSP(float, W_SEM); bf16* H = WSP(bf16, W_H) + h * 512 + u.pn * BM + wc * 32 + 8 * fq;
#pragma unroll
        for (int ai = 0; ai < 2; ++ai)
#pragma unroll
            for (int m = 0; m < 4; ++m) { const size_t row = row0 + ai * HALF + m * 16; const float inv = 1.f / fmaxf(fabsf(DEN[row * 4 + h]), SEM[row * 4 + h]); bf16* hp = H + row * MI;
#pragma unroll
                for (int bj = 0; bj < 2; ++bj) *(u32x4e*)(hp + bj * HALF) = pk8(acc[ai][bj][m][0] * inv, acc[ai][bj][m][1] * inv); }
        return false;
    }
};
struct NumOrder {
    const char* Q; const char* PB; const char* CT; const char* VT; int njob, G, c;
    __device__ __forceinline__ int job(int k) const { const long L = (long)k * G + c; if (L >= njob) return -1; int id = (int)L; { const int q = njob / 8, r = njob % 8, xcd = id % 8, off = id / 8; id = (xcd < r ? xcd * (q + 1) : r * (q + 1) + (xcd - r) * q) + off; } return id; }
    __device__ __forceinline__ bool next(int i, Unit& u) const {
        const int id = job(i >> 2); if (id < 0) return false;
        const int tt = id >> 2, h = id & 3, half = (i >> 1) & 1, seg = i & 1;
        const int b = tt / (SEQ / 256), c1 = tt % (SEQ / 256) + 1;
        u.pm = tt; u.pn = half; u.aux = h * 2 + seg;
        if (seg == 0) { u.A = Q + ((size_t)tt * 256 * MI + h * 512) * 2; u.B = CT + ctb_idx(c1, b, h, half * 256, 0) * 2; u.nt = 8; }
        else { u.A = PB + ((size_t)tt * 256 * 2048 + h * 512) * 2; u.B = VT + (((size_t)tt * 512 + half * 256) * 2048 + h * 512) * 2; u.nt = 4; }
        return true;
    }
};
}
__device__ __forceinline__ void ph_den_fast(const Params& P, int gw, int ngw, int lane) {
    const bf16* Q = WSP(bf16, W_MQ); const float* NST = WSP(float, W_NST); const float* SWI = WSP(float, W_SWI); const float* DENI = WSP(float, W_DENI); float* DEN = WSP(float, W_DEN);
    const int h = lane >> 4, sub = lane & 15;
    for (int r = gw; r < NP; r += ngw) { const int b = r / SEQ, c = (r % SEQ) / LCH + 1;
        const bf16* q = Q + (size_t)r * MI + h * 512 + sub * 32; const float* n = NST + ((size_t)(b * 4 + h) * NCH + c) * 512 + sub * 32; float a = 0.f;
#pragma unroll
        for (int k = 0; k < 32; k += 8) { const pg8::bf16x8 qv = *(const pg8::bf16x8*)(q + k);
#pragma unroll
            for (int e = 0; e < 8; ++e) a += bf2f((bf16)qv[e]) * n[k + e]; }
        a += __shfl_xor(a, 1); a += __shfl_xor(a, 2); a += __shfl_xor(a, 4); a += __shfl_xor(a, 8);
        if (sub == 0) { const float* dp = DENI + ((size_t)r * 4 + h) * 4; DEN[(size_t)r * 4 + h] = (dp[0] + dp[1]) + (dp[2] + dp[3]) + SWI[(size_t)r * 4 + h] * a; } }
}

namespace st {
typedef short bf16x8 __attribute__((ext_vector_type(8)));
typedef float f32x16 __attribute__((ext_vector_type(16)));
typedef float f32x4 __attribute__((ext_vector_type(4)));
typedef unsigned u32x2 __attribute__((ext_vector_type(2)));
typedef unsigned u32x4 __attribute__((ext_vector_type(4)));
__device__ __forceinline__ bf16x8 scale8(bf16x8 v, const LAS float* w) {
    const f32x4 w0 = *(const LAS f32x4*)w, w1 = *(const LAS f32x4*)(w + 4);
    const u32x4 u = __builtin_bit_cast(u32x4, v); u32x4 r;
    r[0] = pg8::cvt_pk_bf16(__uint_as_float(u[0] << 16) * w0[0], __uint_as_float(u[0] & 0xffff0000u) * w0[1]);
    r[1] = pg8::cvt_pk_bf16(__uint_as_float(u[1] << 16) * w0[2], __uint_as_float(u[1] & 0xffff0000u) * w0[3]);
    r[2] = pg8::cvt_pk_bf16(__uint_as_float(u[2] << 16) * w1[0], __uint_as_float(u[2] & 0xffff0000u) * w1[1]);
    r[3] = pg8::cvt_pk_bf16(__uint_as_float(u[3] << 16) * w1[2], __uint_as_float(u[3] & 0xffff0000u) * w1[3]);
    return __builtin_bit_cast(bf16x8, r);
}
constexpr int ST_STAGE = 65536, ST_WK_OFF = 131072 + 1024;
__device__ __forceinline__ unsigned kkey(unsigned row) { return ((row & 3u) << 2) | ((row >> 2) & 3u); }
__device__ __forceinline__ void st_issue(LAS unsigned char* lds, int buf, const char* kbase, const char* vbase, int wave, int lane) {
    const int rsub = lane >> 4, q = lane & 15;
#pragma unroll
    for (int i = 0; i < 4; ++i) { const int row = wave * 16 + i * 4 + rsub;
        __builtin_amdgcn_global_load_lds((const unsigned*)(kbase + (size_t)row * 4096 + 16 * (q ^ kkey(row))), (LAS unsigned*)(lds + buf * ST_STAGE + (wave * 16 + i * 4) * 256), 16, 0, 0);
        __builtin_amdgcn_global_load_lds((const unsigned*)(vbase + (size_t)row * 4096 + 16 * (q ^ (row & 15))), (LAS unsigned*)(lds + buf * ST_STAGE + 32768 + (wave * 16 + i * 4) * 256), 16, 0, 0); }
}
typedef unsigned short u16x4 __attribute__((ext_vector_type(4)));
__device__ __forceinline__ void state_scan(const Params& P, int j, LAS unsigned char* lds, int w, int tid_) {
    int tid = tid_; asm volatile("" : "+v"(tid));
    const int bh = w >> 4, b = bh >> 2, h = bh & 3, dg = (w >> 2) & 3, eg = w & 3;
    const int wave = __builtin_amdgcn_readfirstlane(tid >> 6), lane = tid & 63, l32 = lane & 31, lh = lane >> 5;
    const int dt = wave >> 1, et = (wave & 1) * 2;
    const int dbase = dg * 128 + dt * 32, ebase = eg * 128 + et * 32;
    const bool do_n = (eg == 0) && ((wave & 1) == 0);
    const bf16* MK = WSP(bf16, W_MK); const bf16* VT = WSP(bf16, W_MVT); const float* SWK = WSP(float, W_SWK); const float* DEC = WSP(float, W_DEC);
    bf16* CT = WSP(bf16, W_CT); float* NST = WSP(float, W_NST);
    LAS float* wk = (LAS float*)(lds + ST_WK_OFF);
    f32x16 acc0, acc1, accn;
#pragma unroll
    for (int i = 0; i < 16; ++i) { acc0[i] = 0.f; acc1[i] = 0.f; accn[i] = 0.f; }
    u32x4 onesu; onesu[0] = onesu[1] = onesu[2] = onesu[3] = 0x3f803f80u; const bf16x8 ones = __builtin_bit_cast(bf16x8, onesu);
    {   const int row0 = ROW_META + b * NMETA;
        if (tid < NMETA) wk[tid] = SWK[(size_t)(row0 + tid) * 4 + h];
        __syncthreads();
        if (do_n && l32 == 0) {
#pragma unroll
            for (int i = 0; i < 16; ++i) NST[((size_t)bh * NCH + 0) * 512 + dbase + 8 * (i >> 2) + 4 * lh + (i & 3)] = 0.f; }
        u32x4 au;
#pragma unroll
        for (int i = 0; i < 4; ++i) { const unsigned lo = MK[(size_t)(row0 + 8 * lh + 2 * i) * MI + h * 512 + dbase + l32], hi = MK[(size_t)(row0 + 8 * lh + 2 * i + 1) * MI + h * 512 + dbase + l32]; au[i] = lo | (hi << 16); }
        const bf16x8 a = scale8(__builtin_bit_cast(bf16x8, au), wk + 8 * lh);
        const bf16* v0 = VT + vtb_idx(row0, h, ebase + l32) + 8 * lh;
        const bf16x8 b0 = *(const bf16x8*)v0, b1 = *(const bf16x8*)(v0 + (size_t)32 * 2048);
        acc0 = __builtin_amdgcn_mfma_f32_32x32x16_bf16(a, b0, acc0, 0, 0, 0); acc1 = __builtin_amdgcn_mfma_f32_32x32x16_bf16(a, b1, acc1, 0, 0, 0);
        if (do_n) accn = __builtin_amdgcn_mfma_f32_32x32x16_bf16(a, ones, accn, 0, 0, 0);
    }
    const int row1 = b * SEQ;
    const char* kcol = (const char*)(MK + h * 512 + dg * 128);
    st_issue(lds, 0, kcol + (size_t)row1 * 4096, (const char*)(VT + vtb_idx(row1, h, eg * 128)), wave, lane);
    unsigned tra[2];
    { const unsigned hh = lane >> 5, blk = (lane >> 4) & 1, q = (lane & 15) >> 2, p = lane & 3;
#pragma unroll
      for (unsigned t = 0; t < 2; ++t) { const unsigned row = 8 * hh + 4 * t + q, ch = 4 * dt + 2 * blk + (p >> 1); tra[t] = 256u * row + 16u * (ch ^ kkey(row)) + 8u * (p & 1); } }
    for (int sidx = 0; sidx < 2 * (NCH - 1); ++sidx) {
        const int c = 1 + (sidx >> 1), half = sidx & 1, row0 = row1 + (c - 1) * LCH, buf = sidx & 1;
        LAS float* wkc = wk + (c & 1) * 256;
        float dec = 1.f;
        if (half == 0) { if (tid < LCH) wkc[tid] = SWK[(size_t)(row0 + tid) * 4 + h]; dec = DEC[(size_t)bh * NCH + c]; }
        asm volatile("s_waitcnt vmcnt(0)" ::: "memory");
        __syncthreads();
        if (sidx + 1 < 2 * (NCH - 1)) { const int tok = row1 + (sidx + 1) * 128;
            st_issue(lds, buf ^ 1, kcol + (size_t)tok * 4096, (const char*)(VT + vtb_idx(tok, h, eg * 128)), wave, lane); }
        if (half == 0) {
#pragma unroll
            for (int g = 0; g < 4; ++g) { u32x2 p0, p1;
                p0.x = pg8::cvt_pk_bf16(acc0[4 * g], acc0[4 * g + 1]); p0.y = pg8::cvt_pk_bf16(acc0[4 * g + 2], acc0[4 * g + 3]);
                p1.x = pg8::cvt_pk_bf16(acc1[4 * g], acc1[4 * g + 1]); p1.y = pg8::cvt_pk_bf16(acc1[4 * g + 2], acc1[4 * g + 3]);
                *(u32x2*)(CT + ctb_idx(c, b, h, ebase + l32, dbase + 8 * g + 4 * lh)) = p0;
                *(u32x2*)(CT + ctb_idx(c, b, h, ebase + 32 + l32, dbase + 8 * g + 4 * lh)) = p1; }
            if (do_n && l32 == 0) {
#pragma unroll
                for (int i = 0; i < 16; ++i) NST[((size_t)bh * NCH + c) * 512 + dbase + 8 * (i >> 2) + 4 * lh + (i & 3)] = accn[i]; }
#pragma unroll
            for (int i = 0; i < 16; ++i) { acc0[i] *= dec; acc1[i] *= dec; accn[i] *= dec; }
        }
        u16x4 kt0[8], kt1[8];
        { const unsigned a0 = (unsigned)(buf * ST_STAGE) + tra[0], a1 = (unsigned)(buf * ST_STAGE) + tra[1];
          asm volatile(
            "ds_read_b64_tr_b16 %0, %16\n\tds_read_b64_tr_b16 %1, %17\n\tds_read_b64_tr_b16 %2, %16 offset:4096\n\tds_read_b64_tr_b16 %3, %17 offset:4096\n\t"
            "ds_read_b64_tr_b16 %4, %16 offset:8192\n\tds_read_b64_tr_b16 %5, %17 offset:8192\n\tds_read_b64_tr_b16 %6, %16 offset:12288\n\tds_read_b64_tr_b16 %7, %17 offset:12288\n\t"
            "ds_read_b64_tr_b16 %8, %16 offset:16384\n\tds_read_b64_tr_b16 %9, %17 offset:16384\n\tds_read_b64_tr_b16 %10, %16 offset:20480\n\tds_read_b64_tr_b16 %11, %17 offset:20480\n\t"
            "ds_read_b64_tr_b16 %12, %16 offset:24576\n\tds_read_b64_tr_b16 %13, %17 offset:24576\n\tds_read_b64_tr_b16 %14, %16 offset:28672\n\tds_read_b64_tr_b16 %15, %17 offset:28672\n\t"
            "s_waitcnt lgkmcnt(0)"
            : "=&v"(kt0[0]), "=&v"(kt1[0]), "=&v"(kt0[1]), "=&v"(kt1[1]), "=&v"(kt0[2]), "=&v"(kt1[2]), "=&v"(kt0[3]), "=&v"(kt1[3]),
              "=&v"(kt0[4]), "=&v"(kt1[4]), "=&v"(kt0[5]), "=&v"(kt1[5]), "=&v"(kt0[6]), "=&v"(kt1[6]), "=&v"(kt0[7]), "=&v"(kt1[7])
            : "v"(a0), "v"(a1) : "memory"); }
        const LAS unsigned char* v0 = lds + buf * ST_STAGE + 32768 + (et * 32 + l32) * 256; const LAS unsigned char* v1 = v0 + 32 * 256;
        const int sw = l32 & 15;
#pragma unroll
        for (int s = 0; s < 8; ++s) { const int slot = ((2 * s + lh) ^ sw) * 16;
            u32x4 au; { const u32x2 x0 = __builtin_bit_cast(u32x2, kt0[s]), x1 = __builtin_bit_cast(u32x2, kt1[s]); au[0] = x0.x; au[1] = x0.y; au[2] = x1.x; au[3] = x1.y; }
            const bf16x8 a = scale8(__builtin_bit_cast(bf16x8, au), wkc + half * 128 + s * 16 + 8 * lh);
            const bf16x8 b0 = *(const LAS bf16x8*)(v0 + slot), b1 = *(const LAS bf16x8*)(v1 + slot);
            acc0 = __builtin_amdgcn_mfma_f32_32x32x16_bf16(a, b0, acc0, 0, 0, 0);
            acc1 = __builtin_amdgcn_mfma_f32_32x32x16_bf16(a, b1, acc1, 0, 0, 0);
            if (do_n) accn = __builtin_amdgcn_mfma_f32_32x32x16_bf16(a, ones, accn, 0, 0, 0); }
    }
    float* oc = P.out + O_PC + ((size_t)j * BATCH * 4 + bh) * 512 * 512;
#pragma unroll
    for (int i = 0; i < 16; ++i) { const int d = dbase + 8 * (i >> 2) + 4 * lh + (i & 3); oc[(size_t)d * 512 + ebase + l32] = acc0[i]; oc[(size_t)d * 512 + ebase + 32 + l32] = acc1[i]; }
    if (do_n && l32 == 0) {
#pragma unroll
        for (int i = 0; i < 16; ++i) P.out[O_PN + ((size_t)j * BATCH * 4 + bh) * 512 + dbase + 8 * (i >> 2) + 4 * lh + (i & 3)] = accn[i]; }
    __syncthreads();
}
}
namespace at {
typedef short bf16x8 __attribute__((ext_vector_type(8)));
typedef float f32x16 __attribute__((ext_vector_type(16)));
typedef unsigned u32x2 __attribute__((ext_vector_type(2)));
typedef unsigned u32x4 __attribute__((ext_vector_type(4)));
constexpr int NI_P = (NP / 32) * 16, NI_M = BATCH * 16, NI_S = DECB * 4, NI = NI_P + NI_M + NI_S;
struct TileSrc { const bf16* k; const bf16* v; int vstride, kbase, thr, off, nval; };
__device__ __forceinline__ void att_phase(const Params& P, int j, LAS unsigned char* lds, int gw, int ngw, int tid_) {
    int tid = tid_; asm volatile("" : "+v"(tid));
    gw = __builtin_amdgcn_readfirstlane(gw);
    const int lane = tid & 63, l32 = lane & 31, lh = lane >> 5;
    LAS float* bt = (LAS float*)lds;
    LAS unsigned char* wl = lds + 16384 + ((tid >> 6) & 7) * 8192;
    { const float* BT = WSP(float, W_BIAS); for (int i = tid; i < 16 * 132; i += 512) bt[i] = BT[i] * 1.4426950408889634f; }
    __syncthreads();
    const bf16* Q = WSP(bf16, W_Q); const bf16* K = WSP(bf16, W_K); const bf16* VT = WSP(bf16, W_VT); const bf16* GS = WSP(bf16, W_GS); bf16* OG = WSP(bf16, W_OG);
    const bf16* KC = WSP(bf16, W_KC) + (size_t)j * DECB * KCN * 256; const bf16* VTC = WSP(bf16, W_VTC) + (size_t)j * DECB * 256 * KCN;
    const float* sinks = P.in[I_SSINK] + j * 16;
    for (int item = gw; item < NI; item += ngw) {
        int kind, b = 0, t0 = 0, bs = 0, h0, nq, pmask, hshift, qrow0, qpos0, ti0 = 0, ti1;
        if (item < NI_P) { kind = 0; const int qb = item >> 4; h0 = item & 15; qrow0 = qb * 32; b = qrow0 / SEQ; t0 = qrow0 % SEQ; nq = 32; pmask = 31; hshift = 5; qpos0 = 16 + t0; ti1 = 6; }
        else if (item < NI_P + NI_M) { kind = 1; const int i2 = item - NI_P; b = i2 >> 4; h0 = i2 & 15; qrow0 = ROW_META + b * NMETA; nq = 16; pmask = 15; hshift = 5; qpos0 = 0; ti1 = 1; }
        else { kind = 2; const int i3 = item - NI_P - NI_M; bs = i3 >> 2; h0 = (i3 & 3) * 4; qrow0 = ROW_SAMP + bs * TS; nq = 16; pmask = 3; hshift = 2; qpos0 = PAST; ti1 = 6; }
        const int kvh = h0 >> 2;
        const int cq = l32 < nq ? l32 : (l32 & (nq - 1));
        const int qrow = qrow0 + (cq & pmask), qhead = h0 + (cq >> hshift), qpos = qpos0 + (cq & pmask);
        auto tile_src = [&](int ti) -> TileSrc { TileSrc s;
            if (kind == 2) { if (ti < 5) { s.k = KC + ((size_t)bs * KCN + 32 * ti) * 256 + kvh * 64; s.v = VTC + ((size_t)bs * 256 + kvh * 64) * KCN + 32 * ti; s.vstride = KCN; s.kbase = 32 * ti; s.thr = 16; s.off = PAST - 128 - 16; s.nval = 144; }
                             else { s.k = K + (size_t)qrow0 * 256 + kvh * 64; s.v = VT + (size_t)(kvh * 64) * MPAD + qrow0; s.vstride = MPAD; s.kbase = PAST; s.thr = 0x7fffffff; s.off = 0; s.nval = PAST + TS; } }
            else if (ti == 0) { const int r = ROW_META + b * NMETA; s.k = K + (size_t)r * 256 + kvh * 64; s.v = VT + (size_t)(kvh * 64) * MPAD + r; s.vstride = MPAD; s.kbase = 0; s.thr = 0x7fffffff; s.off = 0; s.nval = 16; }
            else { const int tk0 = t0 - 128 + 32 * (ti - 1), r = b * SEQ + tk0; s.k = K + (size_t)r * 256 + kvh * 64; s.v = VT + (size_t)(kvh * 64) * MPAD + r; s.vstride = MPAD; s.kbase = 16 + tk0; s.thr = 0x7fffffff; s.off = 0; s.nval = 0x7fffffff; }
            return s; };
        auto next_ti = [&](int ti) -> int { int n = ti + 1; if (kind == 0 && ti == 0 && t0 < 128) n = 1 + (128 - t0) / 32; return n; };
        bf16x8 qf[4];
        { const bf16* qp = Q + (size_t)qrow * D + qhead * 64 + 8 * lh;
#pragma unroll
          for (int s = 0; s < 4; ++s) qf[s] = *(const bf16x8*)(qp + 16 * s); }
        const LAS float* bth = bt + qhead * 132;
        float m = sinks[qhead] * 1.4426950408889634f, l = 1.f;
        f32x16 o0, o1;
#pragma unroll
        for (int i = 0; i < 16; ++i) { o0[i] = 0.f; o1[i] = 0.f; }
        bf16x8 kr[4], vr[4];
        int ti = ti0; TileSrc cur = tile_src(ti);
        auto load_tile = [&](const TileSrc& s) {
            const bf16* kp = s.k + (size_t)(lane >> 3) * 256 + 8 * (lane & 7);
#pragma unroll
            for (int q = 0; q < 4; ++q) kr[q] = *(const bf16x8*)(kp + (size_t)q * 8 * 256);
            const bf16* vp = s.v + (size_t)(lane >> 2) * s.vstride + 8 * (lane & 3);
#pragma unroll
            for (int q = 0; q < 4; ++q) vr[q] = *(const bf16x8*)(vp + (size_t)q * 16 * s.vstride); };
        load_tile(cur);
        while (ti < ti1) {
#pragma unroll
            for (int q = 0; q < 4; ++q) { const int row = 8 * q + (lane >> 3); *(LAS bf16x8*)(wl + row * 128 + 16 * ((lane & 7) ^ ((row >> 1) & 7))) = kr[q]; }
#pragma unroll
            for (int q = 0; q < 4; ++q) { const int row = 16 * q + (lane >> 2); *(LAS bf16x8*)(wl + 4096 + row * 64 + 16 * ((lane & 3) ^ ((row >> 2) & 3))) = vr[q]; }
            const TileSrc me = cur;
            const int tn = next_ti(ti);
            if (tn < ti1) { cur = tile_src(tn); load_tile(cur); }
            bf16x8 kf[4];
#pragma unroll
            for (int s = 0; s < 4; ++s) kf[s] = *(const LAS bf16x8*)(wl + l32 * 128 + 16 * ((2 * s + lh) ^ ((l32 >> 1) & 7)));
            f32x16 sT;
#pragma unroll
            for (int i = 0; i < 16; ++i) sT[i] = 0.f;
#pragma unroll
            for (int s = 0; s < 4; ++s) sT = __builtin_amdgcn_mfma_f32_32x32x16_bf16(kf[s], qf[s], sT, 0, 0, 0);
            bf16x8 va[2][2];
#pragma unroll
            for (int dt = 0; dt < 2; ++dt)
#pragma unroll
                for (int s = 0; s < 2; ++s) { const int row = dt * 32 + l32, key = (row >> 2) & 3; const LAS unsigned char* rp = wl + 4096 + row * 64 + 8 * lh;
                    const u32x2 p0 = *(const LAS u32x2*)(rp + 16 * ((2 * s) ^ key)), p1 = *(const LAS u32x2*)(rp + 16 * ((2 * s + 1) ^ key));
                    u32x4 t; t[0] = p0.x; t[1] = p0.y; t[2] = p1.x; t[3] = p1.y; va[dt][s] = __builtin_bit_cast(bf16x8, t); }
            float mx = m;
            if (kind == 0 && ti >= 2 && ti <= 4) {
                const LAS float* bq = bth + (qpos - me.kbase - 31);
#pragma unroll
                for (int i = 0; i < 16; ++i) { const int kk = 8 * (i >> 2) + 4 * lh + (i & 3); const float sv = sT[i] + bq[31 - kk]; sT[i] = sv; mx = fmaxf(mx, sv); }
            } else {
#pragma unroll
                for (int i = 0; i < 16; ++i) { const int kk = 8 * (i >> 2) + 4 * lh + (i & 3), kg = me.kbase + kk, pos = kg + (kg >= me.thr ? me.off : 0), dist = qpos - pos;
                    const bool vis = (kg < me.nval) && (dist >= 0) && (dist <= 128 || pos < 16);
                    const int di = dist < 0 ? 0 : (dist > 128 ? 128 : dist);
                    const float sv = vis ? sT[i] + bth[di] : -3.0e38f; sT[i] = sv; mx = fmaxf(mx, sv); }
            }
            mx = fmaxf(mx, __shfl_xor(mx, 32));
            float ps = 0.f;
#pragma unroll
            for (int i = 0; i < 16; ++i) { const float p = __builtin_amdgcn_exp2f(sT[i] - mx); sT[i] = p; ps += p; }
            ps += __shfl_xor(ps, 32);
            if (__any(mx > m)) {
                const float corr = __builtin_amdgcn_exp2f(m - mx); m = mx; l *= corr;
#pragma unroll
                for (int i = 0; i < 16; ++i) { o0[i] *= corr; o1[i] *= corr; } }
            l += ps;
#pragma unroll
            for (int s = 0; s < 2; ++s) { u32x4 pk;
#pragma unroll
                for (int q = 0; q < 4; ++q) pk[q] = pg8::cvt_pk_bf16(sT[8 * s + 2 * q], sT[8 * s + 2 * q + 1]);
                const bf16x8 pb = __builtin_bit_cast(bf16x8, pk);
                o0 = __builtin_amdgcn_mfma_f32_32x32x16_bf16(va[0][s], pb, o0, 0, 0, 0);
                o1 = __builtin_amdgcn_mfma_f32_32x32x16_bf16(va[1][s], pb, o1, 0, 0, 0); }
            ti = tn;
        }
        if (l32 < nq) { const float inv = 1.f / l; const size_t ob = (size_t)qrow * D + qhead * 64 + 4 * lh;
#pragma unroll
            for (int g = 0; g < 4; ++g) {
                { const u32x2 gv = *(const u32x2*)(GS + ob + 8 * g); u32x2 w;
                  w.x = pg8::cvt_pk_bf16(o0[4 * g] * inv * __uint_as_float(gv.x << 16), o0[4 * g + 1] * inv * __uint_as_float(gv.x & 0xffff0000u));
                  w.y = pg8::cvt_pk_bf16(o0[4 * g + 2] * inv * __uint_as_float(gv.y << 16), o0[4 * g + 3] * inv * __uint_as_float(gv.y & 0xffff0000u)); *(u32x2*)(OG + ob + 8 * g) = w; }
                { const u32x2 gv = *(const u32x2*)(GS + ob + 32 + 8 * g); u32x2 w;
                  w.x = pg8::cvt_pk_bf16(o1[4 * g] * inv * __uint_as_float(gv.x << 16), o1[4 * g + 1] * inv * __uint_as_float(gv.x & 0xffff0000u));
                  w.y = pg8::cvt_pk_bf16(o1[4 * g + 2] * inv * __uint_as_float(gv.y << 16), o1[4 * g + 3] * inv * __uint_as_float(gv.y & 0xffff0000u)); *(u32x2*)(OG + ob + 32 + 8 * g) = w; } }
        }
    }
    __syncthreads();
}
}
namespace el {
__device__ __forceinline__ const float* lp(const float* p) { const float __attribute__((address_space(1)))* g = (const float __attribute__((address_space(1)))*)p; asm volatile("" : "+s"(g));
    return (const float*)g; }
typedef short bf16x8 __attribute__((ext_vector_type(8)));
typedef float f32x4 __attribute__((ext_vector_type(4)));
typedef unsigned u32x2 __attribute__((ext_vector_type(2)));
typedef unsigned u32x4 __attribute__((ext_vector_type(4)));
__device__ __forceinline__ float wsum(float v) {
#pragma unroll
    for (int o = 1; o < 64; o <<= 1) v += __shfl_xor(v, o);
    return v;
}
__device__ __forceinline__ void unpack8(bf16x8 v, float (&f)[8]) { const u32x4 u = __builtin_bit_cast(u32x4, v);
#pragma unroll
    for (int i = 0; i < 4; ++i) { f[2 * i] = __uint_as_float(u[i] << 16); f[2 * i + 1] = __uint_as_float(u[i] & 0xffff0000u); } }
__device__ __forceinline__ bf16x8 pack8(const float (&f)[8]) { u32x4 u;
#pragma unroll
    for (int i = 0; i < 4; ++i) u[i] = pg8::cvt_pk_bf16(f[2 * i], f[2 * i + 1]);
    return __builtin_bit_cast(bf16x8, u); }

__device__ __forceinline__ void norm_fast(const Params& P, int layer, int gw, int ngw, int lane) {
    float* X = WSP(float, W_X); const bf16* X16 = WSP(bf16, W_X16); bf16* XN = WSP(bf16, W_XN); const float* w = P.in[I_NORMW] + (size_t)layer * D;
    const float* xp_ = lp(P.in[I_XP]); const float* xm_ = lp(P.in[I_META]); const float* xs_ = lp(P.in[I_XS]);
    f32x4 wv[4];
#pragma unroll
    for (int k = 0; k < 4; ++k) wv[k] = *(const f32x4*)(w + 4 * lane + 256 * k);
    for (int r = gw; r < MPAD; r += ngw) {
        bf16* o = XN + (size_t)r * D + 4 * lane;
        if (r >= NROWS) {
#pragma unroll
            for (int k = 0; k < 4; ++k) *(u32x2*)(o + 256 * k) = (u32x2){0u, 0u};
            continue; }
        f32x4 v[4]; float s = 0.f;
        if (layer > 0 && r < NP) {
#pragma unroll
            for (int k = 0; k < 4; ++k) { const u32x2 t = *(const u32x2*)(X16 + (size_t)r * D + 4 * lane + 256 * k);
                v[k] = (f32x4){__uint_as_float(t.x << 16), __uint_as_float(t.x & 0xffff0000u), __uint_as_float(t.y << 16), __uint_as_float(t.y & 0xffff0000u)}; }
        } else { const float* src = X + (size_t)r * D;
            if (layer == 0) { if (r < NP) src = xp_ + (size_t)r * D; else if (r < ROW_SAMP) src = xm_ + (size_t)((r - ROW_META) % NMETA) * D; else src = xs_ + (size_t)(r - ROW_SAMP) * D; }
#pragma unroll
            for (int k = 0; k < 4; ++k) v[k] = *(const f32x4*)(src + 4 * lane + 256 * k); }
#pragma unroll
        for (int k = 0; k < 4; ++k) s += (v[k][0] * v[k][0] + v[k][1] * v[k][1]) + (v[k][2] * v[k][2] + v[k][3] * v[k][3]);
        const float rs = 1.f / sqrtf(wsum(s) * (1.f / D) + EPS);
#pragma unroll
        for (int k = 0; k < 4; ++k) { if (layer == 0 && r >= NP) *(f32x4*)(X + (size_t)r * D + 4 * lane + 256 * k) = v[k]; *(u32x2*)(o + 256 * k) = pg8::pk4(v[k] * wv[k] * rs); }
    }
}
__device__ __forceinline__ void convgates_fast(const Params& P, int j, LAS unsigned char* lds, int gw, int ngw, int lane, int tid) {
    const bf16* XM = WSP(bf16, W_XM); bf16* XC = WSP(bf16, W_XC); const float* G = WSP(float, W_G) + (size_t)j * 4096 * 8; float* GA = WSP(float, W_GATES);
    const float* cw = P.in[I_MCW] + (size_t)j * 4 * 2048; const float* cb = P.in[I_MCB] + (size_t)j * 2048;
    LAS float* Gt = (LAS float*)lds;
    for (int i = tid; i < 4096 * 2; i += 512) { const f32x4 v = *(const f32x4*)(G + (size_t)i * 4); const int c = i >> 1, g0 = (i & 1) * 4;
#pragma unroll
        for (int g = 0; g < 4; ++g) Gt[(g0 + g) * 4096 + c] = v[g]; }
    __syncthreads();
    for (int grp = gw; grp < MPAD / 4; grp += ngw) {
        const int r0 = grp * 4;
        if (r0 >= NROWS) { for (int t = 0; t < 4; ++t)
#pragma unroll
            for (int k = 0; k < 4; ++k) *(u32x4*)(XC + (size_t)(r0 + t) * MI + 8 * lane + 512 * k) = (u32x4){0u, 0u, 0u, 0u};
            continue; }
        int hmode, hrow = 0; const float* hs = nullptr;
        if (r0 < NP) { hmode = 1; const int t = r0 % SEQ; hrow = t > 0 ? r0 - 3 : ROW_META + (r0 / SEQ) * NMETA + NMETA - 3; }
        else if (r0 < ROW_SAMP) { const int i = (r0 - ROW_META) % NMETA; hmode = i > 0 ? 1 : 0; hrow = r0 - 3; }
        else { hmode = 2; hs = P.in[I_SCONV] + ((size_t)j * DECB + (r0 - ROW_SAMP) / TS) * 3 * 2048; }
        float ga[4][8];
#pragma unroll
        for (int t = 0; t < 4; ++t)
#pragma unroll
            for (int g = 0; g < 8; ++g) ga[t][g] = 0.f;
#pragma unroll 1
        for (int k = 0; k < 4; ++k) { const int c0 = 8 * lane + 512 * k;
            float x[7][8];
#pragma unroll
            for (int t = 0; t < 3; ++t) {
                if (hmode == 1) unpack8(*(const bf16x8*)(XM + (size_t)(hrow + t) * MI + c0), x[t]);
                else if (hmode == 2) { const f32x4 a = *(const f32x4*)(hs + (size_t)t * 2048 + c0), b = *(const f32x4*)(hs + (size_t)t * 2048 + c0 + 4);
#pragma unroll
                    for (int e = 0; e < 4; ++e) { x[t][e] = a[e]; x[t][4 + e] = b[e]; } }
                else {
#pragma unroll
                    for (int e = 0; e < 8; ++e) x[t][e] = 0.f; } }
#pragma unroll
            for (int t = 0; t < 4; ++t) unpack8(*(const bf16x8*)(XM + (size_t)(r0 + t) * MI + c0), x[3 + t]);
            float xc[4][8];
            { float wgt[5][8];
#pragma unroll
              for (int wv = 0; wv < 4; ++wv) { const f32x4 a = *(const f32x4*)(cw + (size_t)wv * 2048 + c0), b = *(const f32x4*)(cw + (size_t)wv * 2048 + c0 + 4);
#pragma unroll
                  for (int e = 0; e < 4; ++e) { wgt[wv][e] = a[e]; wgt[wv][4 + e] = b[e]; } }
              { const f32x4 a = *(const f32x4*)(cb + c0), b = *(const f32x4*)(cb + c0 + 4);
#pragma unroll
                for (int e = 0; e < 4; ++e) { wgt[4][e] = a[e]; wgt[4][4 + e] = b[e]; } }
#pragma unroll
              for (int t = 0; t < 4; ++t) {
#pragma unroll
                  for (int e = 0; e < 8; ++e) { const float a = wgt[4][e] + x[t][e] * wgt[0][e] + x[t + 1][e] * wgt[1][e] + x[t + 2][e] * wgt[2][e] + x[t + 3][e] * wgt[3][e]; xc[t][e] = pg8::silu_fast(a); }
                  *(bf16x8*)(XC + (size_t)(r0 + t) * MI + c0) = pack8(xc[t]); } }
#pragma unroll
            for (int g = 0; g < 8; ++g) { const LAS float* gq = Gt + g * 4096 + c0; const LAS float* gm = gq + 2048;
                const f32x4 q0 = *(const LAS f32x4*)gq, q1 = *(const LAS f32x4*)(gq + 4), m0 = *(const LAS f32x4*)gm, m1 = *(const LAS f32x4*)(gm + 4);
#pragma unroll
                for (int t = 0; t < 4; ++t) { float a = ga[t][g];
#pragma unroll
                    for (int e = 0; e < 4; ++e) a += xc[t][e] * q0[e] + xc[t][4 + e] * q1[e] + x[3 + t][e] * m0[e] + x[3 + t][4 + e] * m1[e];
                    ga[t][g] = a; }
                asm volatile("" ::: "memory"); }
        }
#pragma unroll
        for (int t = 0; t < 4; ++t)
#pragma unroll
            for (int g = 0; g < 8; ++g) ga[t][g] = wsum(ga[t][g]);
        if (lane < 32) { const int t = lane >> 3, g = lane & 7; float v = 0.f;
#pragma unroll
            for (int tt = 0; tt < 4; ++tt)
#pragma unroll
                for (int gg = 0; gg < 8; ++gg) v = (tt == t && gg == g) ? ga[tt][gg] : v;
            if (r0 + t < NROWS) GA[(size_t)(r0 + t) * 8 + g] = v + P.in[I_MBG][j * 8 + g]; }
    }
    __syncthreads();
}
__device__ __forceinline__ float scan_add(float v, int lane) {
#pragma unroll
    for (int o = 1; o < 64; o <<= 1) { const float t = __shfl_up(v, o); if (lane >= o) v += t; }
    return v; }
__device__ __forceinline__ float scan_max(float v, int lane) {
#pragma unroll
    for (int o = 1; o < 64; o <<= 1) { const float t = __shfl_up(v, o); if (lane >= o) v = fmaxf(v, t); }
    return v; }
constexpr int SC_MAXC = (NCH + 7) / 8;
__device__ __forceinline__ void scal_wg(const Params& P, int j, LAS unsigned char* lds, int team, int tid) {
    const float* GA = WSP(float, W_GATES); float* SA = WSP(float, W_SA); float* SCJ = WSP(float, W_SCJ); float* SWI = WSP(float, W_SWI); float* SEM = WSP(float, W_SEM); float* SWK = WSP(float, W_SWK); float* DEC = WSP(float, W_DEC);
    const int wave = tid >> 6, lane = tid & 63;
    LAS float* xg = (LAS float*)lds; LAS float* xp = xg + 64; LAS float* xm = xp + 64;
    if (team < BATCH * 4) { const int b = team >> 2, h = team & 3;
        float bl[SC_MAXC][4], cj[SC_MAXC][4], pex[SC_MAXC];
#pragma unroll
        for (int k = 0; k < SC_MAXC; ++k) { const int c = wave + 8 * k;
            if (c < NCH) { const int row0 = c == 0 ? ROW_META + b * NMETA : b * SEQ + (c - 1) * LCH; const int nper = c == 0 ? 1 : 4; const bool act = c == 0 ? lane < NMETA : true; const int tb = lane * nper;
                float ip[4]; float run = 0.f, pmx = -3.0e38f;
#pragma unroll
                for (int u = 0; u < 4; ++u) { if (u < nper && act) { const int r = row0 + tb + u; ip[u] = GA[(size_t)r * 8 + h]; run += logsigf(GA[(size_t)r * 8 + 4 + h]); } else ip[u] = 0.f; bl[k][u] = run; }
                const float incl = scan_add(run, lane), excl = incl - run;
#pragma unroll
                for (int u = 0; u < 4; ++u) { bl[k][u] += excl; cj[k][u] = (u < nper && act) ? ip[u] - bl[k][u] : -3.0e38f; pmx = fmaxf(pmx, cj[k][u]); }
                const float pin = scan_max(pmx, lane); float pe = __shfl_up(pin, 1); if (lane == 0) pe = -3.0e38f; pex[k] = pe;
                if (lane == 63) { xg[c] = incl; xp[c] = pin; } } }
        __syncthreads();
        if (tid == 0) { float m = 0.f; for (int c = 0; c < NCH; ++c) { xm[c] = m; const float g = xg[c], mn = g + fmaxf(m, xp[c]); DEC[(size_t)team * NCH + c] = __expf(g + m - mn); m = mn; }
            P.out[O_PM + (size_t)j * BATCH * 4 + team] = m; }
        __syncthreads();
#pragma unroll
        for (int k = 0; k < SC_MAXC; ++k) { const int c = wave + 8 * k;
            if (c < NCH) { const int row0 = c == 0 ? ROW_META + b * NMETA : b * SEQ + (c - 1) * LCH; const int nper = c == 0 ? 1 : 4; const bool act = c == 0 ? lane < NMETA : true; const int tb = lane * nper;
                const float m_prev = xm[c], g = xg[c], m_new = g + fmaxf(m_prev, xp[c]); float pr = pex[k];
#pragma unroll
                for (int u = 0; u < 4; ++u) if (u < nper && act) { const int r = row0 + tb + u; pr = fmaxf(pr, cj[k][u]); const float mx = fmaxf(m_prev, pr), mt = bl[k][u] + mx;
                    SA[(size_t)r * 4 + h] = -mx; SCJ[(size_t)r * 4 + h] = cj[k][u]; SWI[(size_t)r * 4 + h] = __expf(m_prev - mx); SEM[(size_t)r * 4 + h] = __expf(-mt); SWK[(size_t)r * 4 + h] = __expf(g + cj[k][u] - m_new); } } }
    } else { for (int k = tid; k < DECB * 4; k += 512) { const int bs = k >> 2, h = k & 3; float m = P.in[I_SM][(size_t)j * DECB * 4 + k]; float dec;
            scal_chunk(GA, h, ROW_SAMP + bs * TS, TS, m, SA, SCJ, SWI, SEM, SWK, dec); DEC[(size_t)BATCH * 4 * NCH + k] = dec; P.out[O_SMM + (size_t)j * DECB * 4 + k] = m; } }
    __syncthreads();
}
__device__ __forceinline__ void hnorm_fast(const Params& P, int j, int r_lo, int gw, int ngw, int lane) {
    const bf16* H = WSP(bf16, W_H); const bf16* OS = WSP(bf16, W_OS); const bf16* XC = WSP(bf16, W_XC); const bf16* ZS = WSP(bf16, W_ZS); bf16* A2 = WSP(bf16, W_A2);
    const float* hn = P.in[I_MHN] + (size_t)j * 2048 + 32 * lane; const float* sk = P.in[I_MSKIP] + (size_t)j * 2048 + 32 * lane;
    bf16x8 hv_[4], os_[4], xc_[4], zs_[4];
    int r = r_lo + gw;
    if (r < NROWS) { const size_t o = (size_t)r * MI + 32 * lane;
#pragma unroll
        for (int q = 0; q < 4; ++q) { hv_[q] = *(const bf16x8*)(H + o + 8 * q); os_[q] = *(const bf16x8*)(OS + o + 8 * q); xc_[q] = *(const bf16x8*)(XC + o + 8 * q); zs_[q] = *(const bf16x8*)(ZS + o + 8 * q); } }
    for (; r < MPAD; r += ngw) { const size_t o = (size_t)r * MI + 32 * lane;
        if (r >= NROWS) {
#pragma unroll
            for (int q = 0; q < 4; ++q) *(u32x4*)(A2 + o + 8 * q) = (u32x4){0u, 0u, 0u, 0u};
            continue; }
        bf16x8 hc[4], oc[4], xcur[4], zc[4];
#pragma unroll
        for (int q = 0; q < 4; ++q) { hc[q] = hv_[q]; oc[q] = os_[q]; xcur[q] = xc_[q]; zc[q] = zs_[q]; }
        const int rn = r + ngw;
        if (rn < NROWS) { const size_t on = (size_t)rn * MI + 32 * lane;
#pragma unroll
            for (int q = 0; q < 4; ++q) { hv_[q] = *(const bf16x8*)(H + on + 8 * q); os_[q] = *(const bf16x8*)(OS + on + 8 * q); xc_[q] = *(const bf16x8*)(XC + on + 8 * q); zs_[q] = *(const bf16x8*)(ZS + on + 8 * q); } }
        float hv[4][8]; float s = 0.f;
#pragma unroll
        for (int q = 0; q < 4; ++q) { unpack8(hc[q], hv[q]);
#pragma unroll
            for (int e = 0; e < 8; ++e) s += hv[q][e]; }
        s += __shfl_xor(s, 1); s += __shfl_xor(s, 2); s += __shfl_xor(s, 4); s += __shfl_xor(s, 8);
        const float mu = s * (1.f / 512.f); float qq = 0.f;
#pragma unroll
        for (int q = 0; q < 4; ++q)
#pragma unroll
            for (int e = 0; e < 8; ++e) { const float dl = hv[q][e] - mu; qq += dl * dl; }
        qq += __shfl_xor(qq, 1); qq += __shfl_xor(qq, 2); qq += __shfl_xor(qq, 4); qq += __shfl_xor(qq, 8);
        const float rs = 1.f / sqrtf(qq * (1.f / 512.f) + EPS);
#pragma unroll
        for (int q = 0; q < 4; ++q) { float os[8], xc[8], zs[8], res[8];
            unpack8(oc[q], os); unpack8(xcur[q], xc); unpack8(zc[q], zs);
            const f32x4 n0 = *(const f32x4*)(hn + 8 * q), n1 = *(const f32x4*)(hn + 8 * q + 4), k0 = *(const f32x4*)(sk + 8 * q), k1 = *(const f32x4*)(sk + 8 * q + 4);
#pragma unroll
            for (int e = 0; e < 8; ++e) { const float nwe = e < 4 ? n0[e & 3] : n1[e & 3], kwe = e < 4 ? k0[e & 3] : k1[e & 3]; res[e] = (os[e] * ((hv[q][e] - mu) * rs * nwe) + kwe * xc[e]) * zs[e]; }
            *(bf16x8*)(A2 + o + 8 * q) = pack8(res); }
    }
}
__device__ __forceinline__ void hnorm_block(const Params& P, int j, int tt, int h, int wave, int lane) {
    const bf16* H = WSP(bf16, W_H); const bf16* OS = WSP(bf16, W_OS); const bf16* XC = WSP(bf16, W_XC); const bf16* ZS = WSP(bf16, W_ZS); bf16* A2 = WSP(bf16, W_A2);
    const int sub = lane & 15, rq = lane >> 4; const int col = h * 512 + 32 * sub;
    const float* hn = P.in[I_MHN] + (size_t)j * 2048 + col; const float* sk = P.in[I_MSKIP] + (size_t)j * 2048 + col;
    bf16x8 hv_[4], os_[4], xc_[4], zs_[4];
    { const size_t o = (size_t)(tt * 256 + wave * 4 + rq) * MI + col;
#pragma unroll
      for (int q = 0; q < 4; ++q) { hv_[q] = *(const bf16x8*)(H + o + 8 * q); os_[q] = *(const bf16x8*)(OS + o + 8 * q); xc_[q] = *(const bf16x8*)(XC + o + 8 * q); zs_[q] = *(const bf16x8*)(ZS + o + 8 * q); } }
#pragma unroll 1
    for (int it = 0; it < 8; ++it) { const size_t o = (size_t)(tt * 256 + it * 32 + wave * 4 + rq) * MI + col;
        bf16x8 hc[4], oc[4], xcur[4], zc[4];
#pragma unroll
        for (int q = 0; q < 4; ++q) { hc[q] = hv_[q]; oc[q] = os_[q]; xcur[q] = xc_[q]; zc[q] = zs_[q]; }
        if (it < 7) { const size_t on = o + (size_t)32 * MI;
#pragma unroll
            for (int q = 0; q < 4; ++q) { hv_[q] = *(const bf16x8*)(H + on + 8 * q); os_[q] = *(const bf16x8*)(OS + on + 8 * q); xc_[q] = *(const bf16x8*)(XC + on + 8 * q); zs_[q] = *(const bf16x8*)(ZS + on + 8 * q); } }
        float hv[4][8]; float s = 0.f;
#pragma unroll
        for (int q = 0; q < 4; ++q) { unpack8(hc[q], hv[q]);
#pragma unroll
            for (int e8 = 0; e8 < 8; ++e8) s += hv[q][e8]; }
        s += __shfl_xor(s, 1); s += __shfl_xor(s, 2); s += __shfl_xor(s, 4); s += __shfl_xor(s, 8);
        const float mu = s * (1.f / 512.f); float qq = 0.f;
#pragma unroll
        for (int q = 0; q < 4; ++q)
#pragma unroll
            for (int e8 = 0; e8 < 8; ++e8) { const float dl = hv[q][e8] - mu; qq += dl * dl; }
        qq += __shfl_xor(qq, 1); qq += __shfl_xor(qq, 2); qq += __shfl_xor(qq, 4); qq += __shfl_xor(qq, 8);
        const float rs = 1.f / sqrtf(qq * (1.f / 512.f) + EPS);
#pragma unroll
        for (int q = 0; q < 4; ++q) { float os[8], xc[8], zs[8], res[8];
            unpack8(oc[q], os); unpack8(xcur[q], xc); unpack8(zc[q], zs);
            const f32x4 n0 = *(const f32x4*)(hn + 8 * q), n1 = *(const f32x4*)(hn + 8 * q + 4), k0 = *(const f32x4*)(sk + 8 * q), k1 = *(const f32x4*)(sk + 8 * q + 4);
#pragma unroll
            for (int e8 = 0; e8 < 8; ++e8) { const float nwe = e8 < 4 ? n0[e8 & 3] : n1[e8 & 3], kwe = e8 < 4 ? k0[e8 & 3] : k1[e8 & 3]; res[e8] = (os[e8] * ((hv[q][e8] - mu) * rs * nwe) + kwe * xc[e8]) * zs[e8]; }
            *(bf16x8*)(A2 + o + 8 * q) = pack8(res); }
    }
}
template <class ColMap>
__device__ __forceinline__ void transpose_item(const float* W, int K, int N, bf16* WT, int ldt, ColMap cmap, float scale, LAS float* scr, int item, int lane) {
    const int nblk = N / 32, kb = item / nblk, nb = item % nblk, k0 = 64 * kb, n0 = 32 * nb;
    float tv[32];
#pragma unroll
    for (int i = 0; i < 32; ++i) tv[i] = W[(size_t)(k0 + 2 * i + (lane >> 5)) * N + cmap(n0 + (lane & 31))];
#pragma unroll
    for (int i = 0; i < 32; ++i) scr[(2 * i + (lane >> 5)) * 33 + (lane & 31)] = tv[i];
    asm volatile("s_waitcnt lgkmcnt(0)" ::: "memory");
    const int c = lane & 7;
#pragma unroll
    for (int jj = 0; jj < 4; ++jj) { const int n = (lane >> 3) + 8 * jj; const LAS float* s = scr + (8 * c) * 33 + n;
        u32x4 o; o[0] = pg8::cvt_pk_bf16(s[0 * 33] * scale, s[1 * 33] * scale); o[1] = pg8::cvt_pk_bf16(s[2 * 33] * scale, s[3 * 33] * scale); o[2] = pg8::cvt_pk_bf16(s[4 * 33] * scale, s[5 * 33] * scale); o[3] = pg8::cvt_pk_bf16(s[6 * 33] * scale, s[7 * 33] * scale);
        *(u32x4*)(WT + (size_t)(n0 + n) * ldt + k0 + 8 * c) = o; }
    asm volatile("s_waitcnt lgkmcnt(0)" ::: "memory");
}
struct MapId { __device__ __forceinline__ int operator()(int n) const { return n; } };
struct MapSwa { __device__ __forceinline__ int operator()(int n) const { return swa_pos2orig(n); } };
__device__ __forceinline__ void convert_set(const Params& P, LAS unsigned char* lds, int set, int iw, int nw, int wave, int lane) {
    const float* wq_ = lp(P.in[I_MWQ]); const float* wk_ = lp(P.in[I_MWK]); const float* wv_ = lp(P.in[I_MWV]);
    LAS float* scr = (LAS float*)(lds + wave * 16384);
    constexpr int I_SW = (D / 64) * (SWA_N / 32), I_SO = (D / 64) * (D / 32), I_MW = (D / 64) * (ML_N / 32), I_QK = (512 / 64) * (512 / 32), I_MO = (MI / 64) * (D / 32);
    constexpr int N_SWA = I_SW + I_SO, N_ML = I_MW + 12 * I_QK + I_MO;
    const int total = set == 0 ? N_SWA : set == 1 ? N_ML : N_SWA + N_ML;
    for (int it = iw; it < total; it += nw) { int r = it; int j = set == 0 ? 0 : set == 1 ? 0 : 1; bool swa = set == 0;
        if (set == 2) { if (r < N_SWA) swa = true; else r -= N_SWA; }
        if (swa) {
            if (r < I_SW) { transpose_item(P.in[I_SWIN] + (size_t)j * D * SWA_N, D, SWA_N, WSP(bf16, W_SWIN) + (size_t)j * SWA_N * D, D, MapSwa(), 1.f, scr, r, lane); continue; } r -= I_SW;
            transpose_item(P.in[I_SWOUT] + (size_t)j * D * D, D, D, WSP(bf16, W_SWOUT) + (size_t)j * D * D, D, MapId(), 1.f, scr, r, lane); continue; }
        if (r < I_MW) { transpose_item(P.in[I_MWIN] + (size_t)j * D * ML_N, D, ML_N, WSP(bf16, W_MWIN) + (size_t)j * ML_N * D, D, MapId(), 1.f, scr, r, lane); continue; } r -= I_MW;
        if (r < 12 * I_QK) { const int w = r / (4 * I_QK), h = (r / I_QK) % 4, q = r % I_QK;
            transpose_item((w == 0 ? wq_ : w == 1 ? wk_ : wv_) + ((size_t)j * 4 + h) * 512 * 512, 512, 512, WSP(bf16, W_MWQ) + (size_t)(j * 3 + w) * 4 * 512 * 512 + h * 512, 2048, MapId(), w == 1 ? 0.044194173824159216f : 1.f, scr, q, lane); continue; } r -= 12 * I_QK;
        transpose_item(P.in[I_MWOUT] + (size_t)j * MI * D, MI, D, WSP(bf16, W_MWOUT) + (size_t)j * D * MI, MI, MapId(), 1.f, scr, r, lane);
    }
}
__device__ __forceinline__ void prologue_fast(const Params& P, LAS unsigned char* lds, int gw, int ngw, int wave, int lane, long gt, long gs) {
    const float* wq_ = lp(P.in[I_MWQ]); const float* wk_ = lp(P.in[I_MWK]); const float* wv_ = lp(P.in[I_MWV]);
    convert_set(P, lds, 0, gw, ngw, wave, lane);
    { float* bt = WSP(float, W_BIAS); const float* rb = P.in[I_RELB]; for (long i = gt; i < 16 * 132; i += gs) { const int h = (int)(i / 132), dd = (int)(i % 132); bt[i] = rb[rel_bucket(dd > 128 ? 128 : dd) * 16 + h]; } }
}
__device__ __forceinline__ void gmat_items(const Params& P, int j, int it0, int n, int wave, int lane) {
    const float* wq_ = lp(P.in[I_MWQ]); const float* wk_ = lp(P.in[I_MWK]); const float* wv_ = lp(P.in[I_MWV]);
    float* G = WSP(float, W_G);
    for (int it = it0 + wave; it < it0 + n; it += 8) { const int d = it & 511, h = (it >> 9) & 3, kg = (it >> 11) & 1;
        float a[8];
#pragma unroll
        for (int g = 0; g < 8; ++g) a[g] = 0.f;
        for (int part = 0; part < (kg == 0 ? 2 : 1); ++part) { const int w = kg == 0 ? part : 2; const float sc = w == 1 ? 0.044194173824159216f : 1.f;
            const float* wr = (w == 0 ? wq_ : w == 1 ? wk_ : wv_) + (((size_t)j * 4 + h) * 512 + d) * 512 + 8 * lane; const float* wg = P.in[I_MWG] + (size_t)j * 6144 * 8 + (size_t)(w * 2048 + h * 512 + 8 * lane) * 8;
            const f32x4 x0 = *(const f32x4*)wr * sc, x1 = *(const f32x4*)(wr + 4) * sc;
#pragma unroll
            for (int e8 = 0; e8 < 8; ++e8) { const float x = e8 < 4 ? x0[e8 & 3] : x1[e8 & 3]; const f32x4 g0 = *(const f32x4*)(wg + e8 * 8), g1 = *(const f32x4*)(wg + e8 * 8 + 4);
#pragma unroll
                for (int g = 0; g < 4; ++g) { a[g] += x * g0[g]; a[4 + g] += x * g1[g]; } } }
#pragma unroll
        for (int g = 0; g < 8; ++g) a[g] = wsum(a[g]);
        if (lane < 8) { float v = 0.f;
#pragma unroll
            for (int g = 0; g < 8; ++g) v = lane == g ? a[g] : v;
            G[(size_t)j * 4096 * 8 + (size_t)(kg * 2048 + h * 512 + d) * 8 + lane] = v; } }
}
__device__ __forceinline__ int wq_pull(unsigned* ctr, LAS unsigned* slot, int tid);
__device__ __forceinline__ void gmat_deferred(const Params& P, int j, unsigned* ctr, LAS unsigned* slot, int tid) {
    for (;;) { const int c = wq_pull(ctr, slot, tid); if (c >= 256) break; gmat_items(P, j, c * 16, 16, tid >> 6, tid & 63); }
}
__device__ __forceinline__ void cache_part(const Params& P, int part, long gt, long gs) {
    bf16* KC = WSP(bf16, W_KC); bf16* VTC = WSP(bf16, W_VTC);
    const float* cmk = lp(P.in[I_CMK]); const float* ck = lp(P.in[I_CK]); const float* cmv = lp(P.in[I_CMV]); const float* cv = lp(P.in[I_CV]);
    if (part < 2) { const long jb0 = (long)part * DECB;
        for (long i = gt; i < (long)DECB * KCN * 32; i += gs) { const int c8 = (int)(i % 32) * 8, key = (int)((i / 32) % KCN); const long jb = jb0 + i / (32 * KCN);
            float f[8];
#pragma unroll
            for (int e = 0; e < 8; ++e) f[e] = 0.f;
            const float* src = key < 16 ? cmk + ((size_t)jb * 16 + key) * 256 + c8 : key < 144 ? ck + ((size_t)jb * 128 + key - 16) * 256 + c8 : nullptr;
            if (src) { const f32x4 a = *(const f32x4*)src, b = *(const f32x4*)(src + 4);
#pragma unroll
                for (int e = 0; e < 4; ++e) { f[e] = a[e]; f[4 + e] = b[e]; } }
            *(bf16x8*)(KC + ((size_t)jb * KCN + key) * 256 + c8) = pack8(f); }
        for (long i = gt; i < (long)DECB * 256 * (KCN / 8); i += gs) { const int c = (int)(i % 256), k8 = (int)((i / 256) % (KCN / 8)) * 8; const long jb = jb0 + i / (256 * (KCN / 8));
            float f[8];
#pragma unroll
            for (int e = 0; e < 8; ++e) { const int key = k8 + e; f[e] = key < 16 ? cmv[((size_t)jb * 16 + key) * 256 + c] : key < 144 ? cv[((size_t)jb * 128 + key - 16) * 256 + c] : 0.f; }
            *(bf16x8*)(VTC + ((size_t)jb * 256 + c) * KCN + k8) = pack8(f); }
    } else { const float* src = part == 2 ? ck : cv; float* dst = P.out + (part == 2 ? O_SK : O_SV);
        for (long i = gt; i < 2L * DECB * 124 * 64; i += gs) { const int c4 = (int)(i % 64) * 4, key = (int)((i / 64) % 124); const long jb = i / (64 * 124);
            *(f32x4*)(dst + ((size_t)jb * 128 + key) * 256 + c4) = *(const f32x4*)(src + ((size_t)jb * 128 + key + 4) * 256 + c4); } }
}
__device__ __forceinline__ int wq_pull(unsigned* ctr, LAS unsigned* slot, int tid);
__device__ __forceinline__ void cache_deferred(const Params& P, int part, unsigned* ctr, LAS unsigned* slot, int tid) {
    constexpr int NCHUNK = 256;
    for (;;) { const int c = wq_pull(ctr, slot, tid); if (c >= NCHUNK) break; cache_part(P, part, (long)c * 512 + tid, (long)NCHUNK * 512); }
}
__device__ __forceinline__ void sample_item(const Params& P, int j, LAS unsigned char* lds, int it, int tid) {
    const int bs = it >> 2, h = it & 3, row0 = ROW_SAMP + bs * TS, wave = tid >> 6, lane = tid & 63;
    LAS float* qk = (LAS float*)lds;
    LAS float* red = (LAS float*)(lds + 16384);
    LAS float* sc = (LAS float*)(lds + 16384 + 32768);
    LAS float* vs = (LAS float*)(lds + 16384 + 32768 + 1024);
    const bf16* Q = WSP(bf16, W_MQ); const bf16* K = WSP(bf16, W_MK); const bf16* VT = WSP(bf16, W_MVT); bf16* H = WSP(bf16, W_H);
    const size_t so = (((size_t)j * DECB + bs) * 4 + h) * 512 * 512, no = (((size_t)j * DECB + bs) * 4 + h) * 512;
    const float* cin = P.in[I_SC] + so; float* cout = P.out + O_SCC + so; const float* nin = P.in[I_SN] + no;
    const int e4 = (tid & 127) * 4, dq = tid >> 7;
    const float* cp = cin + (size_t)(dq * 128) * 512 + e4; float* op = cout + (size_t)(dq * 128) * 512 + e4;
    f32x4 ca[8], cb[8], cc[8];
#define SI_LOAD(blk, r0) do { _Pragma("unroll") for (int u = 0; u < 8; ++u) blk[u] = __builtin_nontemporal_load((const f32x4*)(cp + (size_t)((r0) + u) * 512)); __builtin_amdgcn_sched_barrier(0); } while (0)
    SI_LOAD(ca, 0); SI_LOAD(cb, 8);
    { const int d = tid;
#pragma unroll
      for (int t = 0; t < 4; ++t) { qk[d * 8 + t] = bf2f(Q[(size_t)(row0 + t) * MI + h * 512 + d]); qk[d * 8 + 4 + t] = bf2f(K[(size_t)(row0 + t) * MI + h * 512 + d]); vs[t * 512 + d] = bf2f(VT[vtb_idx(row0 + t, h, d)]); } }
    __syncthreads();
    for (int idx = wave; idx < 14; idx += 8) { int t, jj; float a = 0.f;
        if (idx < 10) { t = idx < 1 ? 0 : idx < 3 ? 1 : idx < 6 ? 2 : 3; jj = idx - (t * (t + 1)) / 2;
            for (int d = lane; d < 512; d += 64) a += qk[d * 8 + t] * qk[d * 8 + 4 + jj];
            a = wsum(a); if (lane == 0) sc[t * 4 + jj] = a; }
        else { t = idx - 10; for (int d = lane; d < 512; d += 64) a += qk[d * 8 + t] * nin[d]; a = wsum(a); if (lane == 0) sc[16 + t] = a; } }
    __syncthreads();
    if (tid < 4) { const int t = tid, r = row0 + t; const float sa = WSP(float, W_SA)[(size_t)r * 4 + h], wi = WSP(float, W_SWI)[(size_t)r * 4 + h]; float s = 0.f;
        for (int jj = 0; jj < 4; ++jj) { float p = 0.f; if (jj <= t) p = sc[t * 4 + jj] * __expf(sa + WSP(float, W_SCJ)[(size_t)(row0 + jj) * 4 + h]); sc[32 + t * 4 + jj] = p; s += p; }
        const float den = s + wi * sc[16 + t]; sc[48 + t] = fmaxf(fabsf(den), WSP(float, W_SEM)[(size_t)r * 4 + h]); sc[52 + t] = wi; sc[56 + t] = WSP(float, W_SWK)[(size_t)r * 4 + h];
        if (t == 0) sc[60] = WSP(float, W_DEC)[(size_t)BATCH * 4 * NCH + it]; }
    __syncthreads();
    const float dec = sc[60];
    f32x4 wv[4], acc[4];
#pragma unroll
    for (int t = 0; t < 4; ++t) { wv[t] = *(const LAS f32x4*)(vs + t * 512 + e4) * sc[56 + t]; acc[t] = (f32x4){0.f, 0.f, 0.f, 0.f}; }
    const LAS float* qp = qk + (dq * 128) * 8;
#define SI_PROC(blk, r0) do { _Pragma("unroll") for (int u = 0; u < 8; ++u) { const f32x4 qv = *(const LAS f32x4*)(qp + ((r0) + u) * 8), kv = *(const LAS f32x4*)(qp + ((r0) + u) * 8 + 4); \
        f32x4 o = blk[u] * dec; _Pragma("unroll") for (int t = 0; t < 4; ++t) { acc[t] += blk[u] * qv[t]; o += wv[t] * kv[t]; } \
        __builtin_nontemporal_store(o, (f32x4*)(op + (size_t)((r0) + u) * 512)); __builtin_amdgcn_sched_barrier(0); } } while (0)
#pragma unroll 1
    for (int d0 = 0; d0 < 120; d0 += 24) {
        SI_LOAD(cc, d0 + 16); SI_PROC(ca, d0);
        SI_LOAD(ca, d0 + 24); SI_PROC(cb, d0 + 8);
        SI_LOAD(cb, (d0 + 32 < 128 ? d0 + 32 : 120)); SI_PROC(cc, d0 + 16); }
    SI_PROC(ca, 120);
#undef SI_LOAD
#undef SI_PROC
#pragma unroll
    for (int t = 0; t < 4; ++t) *(LAS f32x4*)(red + (dq * 4 + t) * 512 + e4) = acc[t];
    __syncthreads();
    { const int e = tid;
#pragma unroll
      for (int t = 0; t < 4; ++t) { float a = (red[(0 * 4 + t) * 512 + e] + red[(1 * 4 + t) * 512 + e]) + (red[(2 * 4 + t) * 512 + e] + red[(3 * 4 + t) * 512 + e]); a *= sc[52 + t];
#pragma unroll
          for (int jj = 0; jj < 4; ++jj) a += sc[32 + t * 4 + jj] * vs[jj * 512 + e];
          H[(size_t)(row0 + t) * MI + h * 512 + e] = f2bf(a / sc[48 + t]); }
      float n = dec * nin[e];
#pragma unroll
      for (int t = 0; t < 4; ++t) n += sc[56 + t] * qk[e * 8 + 4 + t];
      P.out[O_SNN + no + e] = n; }
    __syncthreads();
}
__device__ __forceinline__ int wq_pull(unsigned* ctr, LAS unsigned* slot, int tid) {
    if (tid == 0) *slot = __hip_atomic_fetch_add(ctr, 1u, __ATOMIC_RELAXED, __HIP_MEMORY_SCOPE_AGENT);
    __syncthreads(); const int v = (int)*slot; __syncthreads(); return v;
}
__device__ __forceinline__ void meta_scores(const Params& P, int wv, int nwv, int lane) {
    const bf16* Q = WSP(bf16, W_MQ); const bf16* K = WSP(bf16, W_MK); const float* SA = WSP(float, W_SA); const float* SCJ = WSP(float, W_SCJ); float* PSM = WSP(float, W_PSM); float* DEN = WSP(float, W_DEN);
    for (int i = wv; i < BATCH * 4 * NMETA; i += nwv) { const int it = i >> 4, t = i & 15, b = it >> 2, h = it & 3, row0 = ROW_META + b * NMETA, r = row0 + t;
        float qv[8]; unpack8(*(const bf16x8*)(Q + (size_t)r * MI + h * 512 + 8 * lane), qv); float s = 0.f;
        for (int jj = 0; jj < NMETA; ++jj) { float v = 0.f;
            if (jj <= t) { float kv[8]; unpack8(*(const bf16x8*)(K + (size_t)(row0 + jj) * MI + h * 512 + 8 * lane), kv); float a = 0.f;
#pragma unroll
                for (int e8 = 0; e8 < 8; ++e8) a += qv[e8] * kv[e8];
                v = wsum(a) * __expf(SA[(size_t)r * 4 + h] + SCJ[(size_t)(row0 + jj) * 4 + h]); }
            if (lane == 0) PSM[(size_t)it * 256 + t * 16 + jj] = v; s += v; }
        if (lane == 0) DEN[(size_t)r * 4 + h] = s; }
}
}
constexpr int LDS_MISC_OFF = 131072, LDS_BYTES = 147456;
constexpr int CW_BAR = 4096, CW_QUEUE = 16384;
#ifndef QA_ITEMS
#define QA_ITEMS (DECB * 4)
#endif
#define GAS __attribute__((address_space(1)))
template <class T> __device__ __forceinline__ T* GP(T* p) { return (T*)(T GAS*)p; }
template <class T> __device__ __forceinline__ T* GPL(T* p) { T GAS* g = (T GAS*)p; asm volatile("" : "+s"(g)); return (T*)g; }
__global__ void __launch_bounds__(512, 2) mega(Params P) {
    extern __shared__ __attribute__((aligned(16))) unsigned char lds[];
    LAS unsigned char* ldsb = (LAS unsigned char*)lds;
    LAS unsigned* misc = (LAS unsigned*)(ldsb + LDS_MISC_OFF);
    if (threadIdx.x < 64) misc[threadIdx.x] = 0u;
    __syncthreads();
    XcdBarrier bar = xcd_barrier_post((unsigned*)(P.ws + W_CTL) + CW_BAR, (volatile LAS unsigned*)(misc + 8));
    const long gt = (long)blockIdx.x * 512 + threadIdx.x, gs = (long)gridDim.x * 512;
    const int G = (int)gridDim.x, cwg = (int)blockIdx.x;
#define LAUNDER() Params Pl = P; { Pl.ws = GPL(Pl.ws); Pl.out = GPL(Pl.out); \
    _Pragma("unroll") for (int i_ = 0; i_ < N_IN; ++i_) Pl.in[i_] = GP(Pl.in[i_]); } long gtl = gt; asm volatile("" : "+v"(gtl))
#define RUNNB(ph, a0, a1) do { LAUNDER(); dispatch<ph>(Pl, a0, a1, gtl, gs); } while (0)
#define RUN(ph, a0, a1) do { RUNNB(ph, a0, a1); xcd_barrier(bar); } while (0)
#define BAR() xcd_barrier(bar)
#ifndef PR_A
#define PR_A 1
#endif
#ifndef PR_A2
#define PR_A2 PR_A
#endif
#ifndef PR_A3
#define PR_A3 PR_A
#endif
#ifndef PR_A3_KMODE
#define PR_A3_KMODE 0
#endif
#ifndef PR_F
#define PR_F 0
#endif
#ifndef PR_B
#define PR_B 1
#endif
#ifndef PR_C
#define PR_C 1
#endif
#ifndef PR_D
#define PR_D 1
#endif
#ifndef PR_D1
#define PR_D1 PR_D
#endif
#ifndef PR_D2
#define PR_D2 PR_D
#endif
#ifndef PR_D3
#define PR_D3 PR_D
#endif
#ifndef PR_D4
#define PR_D4 PR_D
#endif
#ifndef PR_D5
#define PR_D5 PR_D
#endif
#ifndef PR_E
#define PR_E 1
#endif
#define REP(n) for (int rp_ = 0; rp_ < (n); ++rp_)
#define WV_ARGS (int)(gtl >> 6), G * 8, (int)(gtl & 63)
    REP(PR_E) {
    { LAUNDER(); el::prologue_fast(Pl, ldsb, (int)(gtl >> 6), G * 8, (int)((gtl >> 6) & 7), (int)(gtl & 63), gtl, gs); el::cache_part(Pl, 0, gtl, gs); }
    BAR(); }
    for (int layer = 0; layer < 4; ++layer) {
        const int j = layer >> 1;
        REP(PR_D1) { { LAUNDER(); el::norm_fast(Pl, layer, WV_ARGS); }
        BAR(); }
        if ((layer & 1) == 0) {
            REP(PR_A) { { LAUNDER(); pg8::PlainOrder S; S.init(WSP2(Pl, bf16, W_XN), D, WSP2(Pl, bf16, W_SWIN) + (size_t)j * SWA_N * D, D, MPAD, SWA_N, D, G, cwg);
              pg8::EpiSwaIn E{Pl, j}; pg8::gemm_phase(ldsb, D, D, S, E);
              constexpr int NU = (MPAD / 256) * (SWA_N / 256); const int first_idle = NU % G;
              if (layer == 2) el::cache_deferred(Pl, 2, (unsigned*)(Pl.ws + W_CTL) + CW_QUEUE + (20 + rp_) * 64, misc + 16, (int)(gtl & 511));
              if (layer == 0 && cwg >= first_idle) el::convert_set(Pl, ldsb, 1, (cwg - first_idle) * 8 + (int)((gtl >> 6) & 7), (G - first_idle) * 8, (int)((gtl >> 6) & 7), (int)(gtl & 63)); }
            BAR(); }
            REP(PR_B) { RUNNB(PH_SWAOUT, j, 0);
            { LAUNDER(); at::att_phase(Pl, j, ldsb, (int)(gtl >> 6), G * 8, (int)(gtl & 511)); }
            BAR(); }
            for (int rp_ = PR_F; rp_ >= 0; --rp_) { { LAUNDER(); pg8::SplitTailOrder S; S.init(WSP2(Pl, bf16, W_OG), D, WSP2(Pl, bf16, W_SWOUT) + (size_t)j * D * D, D, D, G, cwg);
              pg8::EpiResid E{Pl.in[I_XP], WSP2(Pl, bf16, W_X16), WSP2(Pl, float, W_X), Pl.out, layer == 0 ? 0 : 1, rp_ ? (long)(512u << 20) / 4 : 0L}; pg8::gemm_phase(ldsb, D, D, S, E); }
            { LAUNDER(); el::gmat_deferred(Pl, j, (unsigned*)(Pl.ws + W_CTL) + CW_QUEUE + (28 + j * 2 + rp_) * 64, misc + 16, (int)(gtl & 511)); }
            BAR(); }
        } else {
            REP(PR_A2) { { LAUNDER(); pg8::PlainOrder S; S.init(WSP2(Pl, bf16, W_XN), D, WSP2(Pl, bf16, W_MWIN) + (size_t)j * ML_N * D, D, MPAD, ML_N, D, G, cwg);
              pg8::EpiMlIn E{Pl, j}; pg8::gemm_phase(ldsb, D, D, S, E);
              constexpr int NU = (MPAD / 256) * (ML_N / 256); const int first_idle = NU % G;
              if (layer == 3) el::cache_deferred(Pl, 3, (unsigned*)(Pl.ws + W_CTL) + CW_QUEUE + (24 + rp_) * 64, misc + 16, (int)(gtl & 511));
              if (layer == 1 && cwg >= first_idle) el::convert_set(Pl, ldsb, 2, (cwg - first_idle) * 8 + (int)((gtl >> 6) & 7), (G - first_idle) * 8, (int)((gtl >> 6) & 7), (int)(gtl & 63)); }
            BAR(); }
            REP(PR_D2) { { LAUNDER(); el::convgates_fast(Pl, j, ldsb, WV_ARGS, (int)(gtl & 511)); }
            BAR(); }
            constexpr int NSCG = BATCH * 4 + 1;
            REP(PR_A3) { if (cwg >= G - NSCG) { LAUNDER(); el::scal_wg(Pl, j, ldsb, cwg - (G - NSCG), (int)(gtl & 511)); }
            else
            { LAUNDER(); pg8::M3Order S{(const char*)WSP2(Pl, bf16, W_XC), (const char*)WSP2(Pl, bf16, W_XM), (const char*)(WSP2(Pl, bf16, W_MWQ) + (size_t)j * 3 * 4 * 512 * 512), MPAD / 256, G - NSCG, cwg, rp_ == 0 ? 0 : PR_A3_KMODE};
              pg8::EpiM3 E{Pl}; pg8::gemm_phase(ldsb, MI, MI, S, E); }
            if (layer == 1) { LAUNDER(); el::cache_deferred(Pl, 1, (unsigned*)(Pl.ws + W_CTL) + CW_QUEUE + (16 + rp_) * 64, misc + 16, (int)(gtl & 511)); }
            BAR(); }
            constexpr int NSAMP_A = QA_ITEMS;
            constexpr int NSTW = BATCH * 4 * 16;
            REP(PR_C) { if (cwg < NSTW) {
                { LAUNDER(); st::state_scan(Pl, j, ldsb, cwg, (int)threadIdx.x); }
                { LAUNDER(); pg8::POrder S{(const char*)WSP2(Pl, bf16, W_MQ), (const char*)WSP2(Pl, bf16, W_MK), (NP / 256) * 4, NSTW, cwg};
                  pg8::EpiP E{Pl}; pg8::gemm_phase(ldsb, MI, MI, S, E); } }
            else { LAUNDER(); el::meta_scores(Pl, (int)(gtl >> 6) - NSTW * 8, (G - NSTW) * 8, (int)(gtl & 63)); }
            { LAUNDER(); unsigned* ctr = (unsigned*)(Pl.ws + W_CTL) + CW_QUEUE + (j * 2 + rp_ * 4) * 64; for (;;) { const int it = el::wq_pull(ctr, misc + 16, (int)(gtl & 511)); if (it >= NSAMP_A) break; el::sample_item(Pl, j, ldsb, it, (int)(gtl & 511)); } }
            BAR(); }
            REP(PR_D3) { { LAUNDER(); ph_den_fast(Pl, (int)(gtl >> 6), G * 8, (int)(gtl & 63)); }
            RUNNB(PH_SMALLM, j, 1);
            { LAUNDER(); unsigned* ctr = (unsigned*)(Pl.ws + W_CTL) + CW_QUEUE + (j * 2 + 1 + rp_ * 4) * 64; for (;;) { const int it = NSAMP_A + el::wq_pull(ctr, misc + 16, (int)(gtl & 511)); if (it >= DECB * 4) break; el::sample_item(Pl, j, ldsb, it, (int)(gtl & 511)); } }
            BAR(); }
            REP(PR_D4) {
            { LAUNDER(); el::hnorm_fast(Pl, j, NP, WV_ARGS); }
            { LAUNDER(); pg8::NumOrder S{(const char*)WSP2(Pl, bf16, W_MQ), (const char*)WSP2(Pl, bf16, W_P), (const char*)WSP2(Pl, bf16, W_CT), (const char*)WSP2(Pl, bf16, W_MVT), (NP / 256) * 4, G, cwg};
              pg8::EpiNum E{Pl}; pg8::gemm_phase(ldsb, MI, MI, S, E);
              asm volatile("s_waitcnt vmcnt(0)" ::: "memory"); __syncthreads(); __builtin_amdgcn_fence(__ATOMIC_ACQUIRE, "agent"); asm volatile("s_waitcnt vmcnt(0)" ::: "memory");
              for (int k = 0;; ++k) { const int id = S.job(k); if (id < 0) break; el::hnorm_block(Pl, j, id >> 2, id & 3, (int)((gtl >> 6) & 7), (int)(gtl & 63)); } }
            BAR(); }
            for (int rp_ = PR_F; rp_ >= 0; --rp_) { { LAUNDER(); pg8::SplitTailOrder S; S.init(WSP2(Pl, bf16, W_A2), MI, WSP2(Pl, bf16, W_MWOUT) + (size_t)j * D * MI, MI, MI, G, cwg);
              pg8::EpiResid E{Pl.in[I_XP], WSP2(Pl, bf16, W_X16), WSP2(Pl, float, W_X), Pl.out, layer == 3 ? 2 : 1, rp_ ? (long)(512u << 20) / 4 : 0L}; pg8::gemm_phase(ldsb, MI, MI, S, E); }
            BAR(); }
        }
    }
    { LAUNDER(); const float* X = WSP2(Pl, float, W_X) + (size_t)ROW_SAMP * D; float* ys = Pl.out + O_YS; for (long i = gtl; i < (long)NS * D / 4; i += gs) *(pg8::f32x4*)(ys + 4 * i) = *(const pg8::f32x4*)(X + 4 * i); }
}
extern "C" void kernel_launch(void* const* d_in, const int* in_sizes, int n_in, void* d_out, int out_size, void* d_ws, size_t ws_size, hipStream_t stream) {
    Params P; memset(&P, 0, sizeof(P));
    for (int i = 0; i < N_IN; ++i) P.in[i] = (const float*)d_in[i];
    P.out = (float*)d_out; P.ws = (unsigned char*)d_ws;
    if (ws_size < W_END) { fprintf(stderr, "ws too small: %zu < %zu\n", ws_size, (size_t)W_END); return; }
    static int grid = 0;
    if (!grid) {
        int dev = 0, cus = 0, per_cu = 0;
        (void)hipGetDevice(&dev);
        (void)hipDeviceGetAttribute(&cus, hipDeviceAttributeMultiprocessorCount, dev);
        (void)hipFuncSetAttribute((const void*)mega, hipFuncAttributeMaxDynamicSharedMemorySize, LDS_BYTES);
        (void)hipOccupancyMaxActiveBlocksPerMultiprocessor(&per_cu, mega, 512, LDS_BYTES);
        if (per_cu < 1) { fprintf(stderr, "mega: occupancy query says 0 blocks per CU\n"); per_cu = 1; }
        grid = cus;
    }
    (void)hipMemsetAsync(P.ws + W_CTL, 0, 1u << 20, stream);
    mega<<<grid, 512, LDS_BYTES, stream>>>(P);
}
```

```cpp
#include <hip/hip_runtime.h>
#include <cstdio>
#include <cstring>
#include <cmath>
#define HD __device__ static
#define UNROLL _Pragma("unroll")
#ifndef SEQ
#define SEQ 8192
#endif
#ifndef BATCH
#define BATCH 2
#endif
#ifndef DECB
#define DECB 128
#endif
typedef unsigned short bf16;
constexpr int D = 1024, NMETA = 16, TS = 4, PAST = 8192;
constexpr int NP = BATCH * SEQ, NM = BATCH * NMETA, NS = DECB * TS;
constexpr int ROW_META = NP, ROW_SAMP = NP + NM, NROWS = NP + NM + NS, MPAD = (NROWS + 255) / 256 * 256;
constexpr int SWA_N = 2560, MI = 2048, MH = 4, MD = 512, ML_N = 6144;
constexpr int LCH = 256, NCH = SEQ / LCH + 1;
constexpr int KCN = 160;
constexpr float EPS = 1e-6f;

enum { I_XP = 0, I_XS, I_CK, I_CV, I_CMK, I_CMV, I_SC, I_SN, I_SM, I_SCONV, I_META, I_RELB, I_NORMW, I_SWIN, I_SQN, I_SKN, I_SSINK, I_SWOUT,
       I_MWIN, I_MCW, I_MCB, I_MWQ, I_MWK, I_MWV, I_MWG, I_MBG, I_MHN, I_MSKIP, I_MWOUT, N_IN };
constexpr size_t O_YP = 0, O_YS = O_YP + (size_t)NP * D, O_PK = O_YS + (size_t)NS * D, O_PV = O_PK + (size_t)2 * BATCH * 128 * 256,
    O_PMK = O_PV + (size_t)2 * BATCH * 128 * 256, O_PMV = O_PMK + (size_t)2 * BATCH * 16 * 256, O_PC = O_PMV + (size_t)2 * BATCH * 16 * 256,
    O_PN = O_PC + (size_t)2 * BATCH * 4 * 512 * 512, O_PM = O_PN + (size_t)2 * BATCH * 4 * 512, O_PCONV = O_PM + (size_t)2 * BATCH * 4,
    O_SK = O_PCONV + (size_t)2 * BATCH * 3 * 2048, O_SV = O_SK + (size_t)2 * DECB * 128 * 256, O_SCC = O_SV + (size_t)2 * DECB * 128 * 256,
    O_SNN = O_SCC + (size_t)2 * DECB * 4 * 512 * 512, O_SMM = O_SNN + (size_t)2 * DECB * 4 * 512, O_SCONV = O_SMM + (size_t)2 * DECB * 4,
    O_END = O_SCONV + (size_t)2 * DECB * 3 * 2048;
constexpr size_t al(size_t x) { return (x + 255) / 256 * 256; }
constexpr size_t W_CTL = 0;
constexpr size_t W_X = 1u << 20;
constexpr size_t W_XN = W_X + al((size_t)MPAD * D * 4);
constexpr size_t W_SWIN = W_XN + al((size_t)MPAD * D * 2);
constexpr size_t W_SWOUT = W_SWIN + al((size_t)2 * SWA_N * D * 2);
constexpr size_t W_MWIN = W_SWOUT + al((size_t)2 * D * D * 2);
constexpr size_t W_MWQ = W_MWIN + al((size_t)2 * ML_N * D * 2);
constexpr size_t W_MWOUT = W_MWQ + al((size_t)2 * 3 * 4 * 512 * 512 * 2);
constexpr size_t W_G = W_MWOUT + al((size_t)2 * D * MI * 2);
constexpr size_t W_BIAS = W_G + al((size_t)2 * 4096 * 8 * 4);
constexpr size_t W_Q = W_BIAS + al(16 * 132 * 4);
constexpr size_t W_K = W_Q + al((size_t)MPAD * D * 2);
constexpr size_t W_VT = W_K + al((size_t)MPAD * 256 * 2);
constexpr size_t W_GS = W_VT + al((size_t)MPAD * 256 * 2);
constexpr size_t W_OG = W_GS + al((size_t)MPAD * D * 2);
constexpr size_t W_KC = W_OG + al((size_t)MPAD * D * 2);
constexpr size_t W_VTC = W_KC + al((size_t)2 * DECB * KCN * 256 * 2);
constexpr size_t W_XM = W_VTC + al((size_t)2 * DECB * KCN * 256 * 2);
constexpr size_t W_ZS = W_XM + al((size_t)MPAD * MI * 2);
constexpr size_t W_OS = W_ZS + al((size_t)MPAD * MI * 2);
constexpr size_t W_XC = W_OS + al((size_t)MPAD * MI * 2);
constexpr size_t W_GATES = W_XC + al((size_t)MPAD * MI * 2);
constexpr size_t W_MQ = W_GATES + al((size_t)MPAD * 8 * 4);
constexpr size_t W_MK = W_MQ + al((size_t)MPAD * MI * 2);
constexpr size_t W_MKT = W_MK + al((size_t)MPAD * MI * 2);
constexpr size_t W_MVT = W_MKT + al((size_t)MPAD * MI * 2);
constexpr size_t W_SA = W_MVT + al((size_t)(MPAD / 256) * 512 * 2048 * 2);
constexpr size_t W_SCJ = W_SA + al((size_t)MPAD * 4 * 4);
constexpr size_t W_SWI = W_SCJ + al((size_t)MPAD * 4 * 4);
constexpr size_t W_SEM = W_SWI + al((size_t)MPAD * 4 * 4);
constexpr size_t W_SWK = W_SEM + al((size_t)MPAD * 4 * 4);
constexpr size_t W_DEC = W_SWK + al((size_t)MPAD * 4 * 4);
constexpr size_t W_P = W_DEC + al((size_t)(BATCH * 4 * NCH + DECB * 4) * 4);
constexpr size_t W_DENI = W_P + al((size_t)NP * 2048 * 2);
constexpr size_t W_DEN = W_DENI + al((size_t)NP * 16 * 4);
constexpr size_t W_CT = W_DEN + al((size_t)MPAD * 4 * 4);
constexpr size_t W_CST = W_CT + al((size_t)BATCH * 4 * (NCH - 1) * 512 * 512 * 2);
constexpr size_t W_NST = W_CST + al((size_t)BATCH * 4 * 512 * 512 * 4);
constexpr size_t W_NRUN = W_NST + al((size_t)BATCH * 4 * NCH * 512 * 4);
constexpr size_t W_PSM = W_NRUN + al((size_t)BATCH * 4 * 512 * 4);
constexpr size_t W_H = W_PSM + al((size_t)(BATCH + DECB) * 4 * 256 * 4);
constexpr size_t W_A2 = W_H + al((size_t)MPAD * MI * 2);
constexpr size_t W_TMP = W_A2 + al((size_t)MPAD * MI * 2);
constexpr size_t W_END = W_TMP + al((size_t)MPAD * ML_N * 4);
constexpr size_t W_X16 = W_TMP;

struct Params {
    const float* in[N_IN];
    float* out;
    unsigned char* ws;
};
#define WSP(T, off) ((T*)(P.ws + (off)))

HD inline float bf2f(bf16 v) { unsigned u = (unsigned)v << 16; float f; __builtin_memcpy(&f, &u, 4); return f; }
HD inline bf16 f2bf(float f) { unsigned u; __builtin_memcpy(&u, &f, 4); u += 0x7fffu + ((u >> 16) & 1u); return (bf16)(u >> 16); }
HD inline float siluf(float x) { return x / (1.f + expf(-x)); }
HD inline float sigmf(float x) { return 1.f / (1.f + expf(-x)); }
HD inline float logsigf(float x) { return x >= 0.f ? -log1pf(expf(-x)) : x - log1pf(expf(x)); }

HD inline int swa_pos2orig(int n) { const int t = n & ~255, l = n & 255; return t + (((l >> 5) & 3) << 6) + ((l >> 7) << 5) + (l & 31); }
HD inline int swa_orig2pos(int o) { const int t = o & ~255, l = o & 255; return t + (((l >> 5) & 1) << 7) + ((l >> 6) << 5) + (l & 31); }

HD inline size_t vtb_idx(int row, int h, int e) { return ((size_t)(row >> 8) * 512 + e) * 2048 + h * 512 + (row & 255); }
HD inline size_t ctb_idx(int c, int b, int h, int e, int d) { return (((size_t)(c - 1) * BATCH + b) * 512 + e) * 2048 + h * 512 + d; }
HD inline int rel_bucket(int n) {
    if (n < 16) return n;
    int v = 16 + (int)(logf((float)n / 16.f) / 2.0794415416798357f * 16.f);
    return v > 31 ? 31 : v;
}

HD inline int prev_row(int r) {
    if (r < NP) { const int t = r % SEQ; return t > 0 ? r - 1 : ROW_META + (r / SEQ) * NMETA + (NMETA - 1); }
    if (r < ROW_SAMP) { const int i = (r - ROW_META) % NMETA; return i > 0 ? r - 1 : -1; }
    return ((r - ROW_SAMP) % TS) > 0 ? r - 1 : -2;
}

enum { PH_WCONV = 0, PH_GMAT, PH_INITX, PH_CACHE, PH_NORM, PH_S1E, PH_ATT, PH_RESID, PH_M1E, PH_CONV, PH_GATES, PH_SCAL, PH_PMAT, PH_STATE, PH_DEN, PH_NUM,
       PH_SMALLS, PH_SMALLM, PH_HNORM, PH_SWAOUT, PH_FINAL };

HD inline void ph_wconv(const Params& P, long gt, long gs) {
    for (int j = 0; j < 2; ++j) {
        { bf16* dst = WSP(bf16, W_SWIN) + (size_t)j * SWA_N * D; const float* src = P.in[I_SWIN] + (size_t)j * D * SWA_N;
          for (long i = gt; i < (long)SWA_N * D; i += gs) { const int n = (int)(i / D), k = (int)(i % D); dst[i] = f2bf(src[(size_t)k * SWA_N + swa_pos2orig(n)]); } }
        { bf16* dst = WSP(bf16, W_SWOUT) + (size_t)j * D * D; const float* src = P.in[I_SWOUT] + (size_t)j * D * D;
          for (long i = gt; i < (long)D * D; i += gs) { const int n = (int)(i / D), k = (int)(i % D); dst[i] = f2bf(src[(size_t)k * D + n]); } }
        { bf16* dst = WSP(bf16, W_MWIN) + (size_t)j * ML_N * D; const float* src = P.in[I_MWIN] + (size_t)j * D * ML_N;
          for (long i = gt; i < (long)ML_N * D; i += gs) { const int n = (int)(i / D), k = (int)(i % D); dst[i] = f2bf(src[(size_t)k * ML_N + n]); } }
        for (int w = 0; w < 3; ++w) { bf16* dst = WSP(bf16, W_MWQ) + (size_t)(j * 3 + w) * 4 * 512 * 512; const float* src = P.in[I_MWQ + w] + (size_t)j * 4 * 512 * 512;
          const float sc = (w == 1) ? 0.044194173824159216f : 1.f;
          for (long i = gt; i < (long)4 * 512 * 512; i += gs) { const int e = (int)(i >> 11), h = (int)((i >> 9) & 3), d = (int)(i & 511); dst[i] = f2bf(src[((size_t)h * 512 + d) * 512 + e] * sc); } }
        { bf16* dst = WSP(bf16, W_MWOUT) + (size_t)j * D * MI; const float* src = P.in[I_MWOUT] + (size_t)j * MI * D;
          for (long i = gt; i < (long)D * MI; i += gs) { const int n = (int)(i / MI), k = (int)(i % MI); dst[i] = f2bf(src[(size_t)k * D + n]); } }
    }
    { float* bt = WSP(float, W_BIAS); const float* rb = P.in[I_RELB];
      for (long i = gt; i < 16 * 132; i += gs) { const int h = (int)(i / 132), dd = (int)(i % 132); bt[i] = rb[rel_bucket(dd > 128 ? 128 : dd) * 16 + h]; } }
}
HD inline void ph_gmat(const Params& P, long gt, long gs) {
    float* G = WSP(float, W_G);
    for (long i = gt; i < 2L * 4096 * 8; i += gs) {
        const int j = (int)(i / (4096 * 8)), c = (int)((i / 8) % 4096), g = (int)(i % 8);
        const float* wg = P.in[I_MWG] + (size_t)j * 6144 * 8;
        float acc = 0.f;
        if (c < 2048) { const int h = c >> 9, d = c & 511;
            const float* wq = P.in[I_MWQ] + ((size_t)(j * 4 + h) * 512 + d) * 512; const float* wk = P.in[I_MWK] + ((size_t)(j * 4 + h) * 512 + d) * 512;
            float a = 0.f, b = 0.f;
            for (int e = 0; e < 512; ++e) { a += wq[e] * wg[(size_t)(h * 512 + e) * 8 + g]; b += wk[e] * wg[(size_t)(2048 + h * 512 + e) * 8 + g]; }
            acc = a + b * 0.044194173824159216f;
        } else { const int cc = c - 2048, h = cc >> 9, d = cc & 511;
            const float* wv = P.in[I_MWV] + ((size_t)(j * 4 + h) * 512 + d) * 512;
            for (int e = 0; e < 512; ++e) acc += wv[e] * wg[(size_t)(4096 + h * 512 + e) * 8 + g];
        }
        G[i] = acc;
    }
}
HD inline void ph_initx(const Params& P, long gt, long gs) {
    float* X = WSP(float, W_X);
    for (long i = gt; i < (long)MPAD * D; i += gs) { const int r = (int)(i / D), c = (int)(i % D); float v = 0.f;
        if (r < NP) v = P.in[I_XP][i]; else if (r < ROW_SAMP) v = P.in[I_META][(size_t)((r - ROW_META) % NMETA) * D + c]; else if (r < NROWS) v = P.in[I_XS][(size_t)(r - ROW_SAMP) * D + c];
        X[i] = v; }
}
HD inline void ph_cache(const Params& P, long gt, long gs) {
    bf16* KC = WSP(bf16, W_KC); bf16* VTC = WSP(bf16, W_VTC);
    for (long i = gt; i < 2L * DECB * KCN * 256; i += gs) {
        const int c = (int)(i % 256), key = (int)((i / 256) % KCN); const long jb = i / (256 * KCN);
        float kv = 0.f, vv = 0.f;
        if (key < 16) { kv = P.in[I_CMK][((size_t)jb * 16 + key) * 256 + c]; vv = P.in[I_CMV][((size_t)jb * 16 + key) * 256 + c]; }
        else if (key < 144) { kv = P.in[I_CK][((size_t)jb * 128 + key - 16) * 256 + c]; vv = P.in[I_CV][((size_t)jb * 128 + key - 16) * 256 + c]; }
        { KC[i] = f2bf(kv); VTC[((size_t)jb * 256 + c) * KCN + key] = f2bf(vv); }
    }
    for (long i = gt; i < 2L * DECB * 124 * 256; i += gs) { const int c = (int)(i % 256), key = (int)((i / 256) % 124); const long jb = i / (256 * 124);
        P.out[O_SK + ((size_t)jb * 128 + key) * 256 + c] = P.in[I_CK][((size_t)jb * 128 + key + 4) * 256 + c];
        P.out[O_SV + ((size_t)jb * 128 + key) * 256 + c] = P.in[I_CV][((size_t)jb * 128 + key + 4) * 256 + c]; }
}
HD inline void ph_norm(const Params& P, int layer, long gt, long gs) {
    const float* X = WSP(float, W_X); bf16* XN = WSP(bf16, W_XN); const float* w = P.in[I_NORMW] + (size_t)layer * D;
    for (long r = gt; r < MPAD; r += gs) {
        const float* x = X + (size_t)r * D; bf16* o = XN + (size_t)r * D;
        if (r >= NROWS) { for (int c = 0; c < D; ++c) o[c] = 0; continue; }
        float s = 0.f; for (int c = 0; c < D; ++c) s += x[c] * x[c];
        const float rs = 1.f / sqrtf(s / D + EPS);
        for (int c = 0; c < D; ++c) o[c] = f2bf(x[c] * rs * w[c]);
    }
}
HD inline void swa_store_kv(const Params& P, int j, int r, int kvh, int d, float val, bool isv) {
    if (!isv) WSP(bf16, W_K)[(size_t)r * 256 + kvh * 64 + d] = f2bf(val); else WSP(bf16, W_VT)[(size_t)(kvh * 64 + d) * MPAD + r] = f2bf(val);
}
HD inline void ph_swaout(const Params& P, int j, long gt, long gs) {
    const bf16* K = WSP(bf16, W_K); const bf16* VT = WSP(bf16, W_VT);
    constexpr int NOR = BATCH * 128 + NM + NS;
    for (long i = gt; i < (long)NOR * 256; i += gs) { const int c = (int)(i % 256); int q = (int)(i / 256); int r; size_t ok, ov;
        if (q < BATCH * 128) { const int b = q / 128, tt = q % 128; r = b * SEQ + SEQ - 128 + tt; ok = O_PK + (((size_t)j * BATCH + b) * 128 + tt) * 256 + c; ov = ok - O_PK + O_PV; }
        else if (q < BATCH * 128 + NM) { q -= BATCH * 128; r = ROW_META + q; ok = O_PMK + ((size_t)j * NM + q) * 256 + c; ov = ok - O_PMK + O_PMV; }
        else { q -= BATCH * 128 + NM; r = ROW_SAMP + q; const int bs = q / TS, t = q % TS; ok = O_SK + (((size_t)j * DECB + bs) * 128 + 124 + t) * 256 + c; ov = ok - O_SK + O_SV; }
        P.out[ok] = bf2f(K[(size_t)r * 256 + c]); P.out[ov] = bf2f(VT[(size_t)c * MPAD + r]); }
}
HD inline void ph_s1e(const Params& P, int j, long gt, long gs) {
    const float* T = WSP(float, W_TMP);
    for (long i = gt; i < (long)MPAD * 40; i += gs) {
        const int r = (int)(i / 40), g = (int)(i % 40);
        float x[64];
        UNROLL for (int d = 0; d < 64; ++d) x[d] = T[(size_t)r * SWA_N + swa_orig2pos(g * 64 + d)];
        if (g < 20) {
            float s = 0.f; UNROLL for (int d = 0; d < 64; ++d) s += x[d] * x[d];
            const float rs = 1.f / sqrtf(s / 64.f + EPS);
            if (g < 16) { const float* qn = P.in[I_SQN] + j * 64; bf16* Q = WSP(bf16, W_Q) + (size_t)r * D + g * 64;
                UNROLL for (int d = 0; d < 64; ++d) Q[d] = f2bf(x[d] * rs * qn[d] * 0.125f); }
            else { const float* kn = P.in[I_SKN] + j * 64; UNROLL for (int d = 0; d < 64; ++d) swa_store_kv(P, j, r, g - 16, d, x[d] * rs * kn[d], false); }
        } else if (g < 24) { UNROLL for (int d = 0; d < 64; ++d) swa_store_kv(P, j, r, g - 20, d, x[d], true); }
        else { bf16* GS = WSP(bf16, W_GS) + (size_t)r * D + (g - 24) * 64; UNROLL for (int d = 0; d < 64; ++d) GS[d] = f2bf(siluf(x[d])); }
    }
}
HD inline void att_key(const bf16* kp, const bf16* vp, long vstride, const bf16* q, float bias, float& m, float& l, float* o) {
    float s = 0.f; UNROLL for (int d = 0; d < 64; ++d) s += bf2f(q[d]) * bf2f(kp[d]);
    s += bias;
    if (s > m) { const float c = expf(m - s); l *= c; UNROLL for (int d = 0; d < 64; ++d) o[d] *= c; m = s; }
    const float p = expf(s - m); l += p;
    UNROLL for (int d = 0; d < 64; ++d) o[d] += p * bf2f(vp[(size_t)d * vstride]);
}
HD inline void ph_att(const Params& P, int j, long gt, long gs) {
    const bf16* Q = WSP(bf16, W_Q); const bf16* K = WSP(bf16, W_K); const bf16* VT = WSP(bf16, W_VT); const float* BT = WSP(float, W_BIAS);
    const bf16* GS = WSP(bf16, W_GS); bf16* OG = WSP(bf16, W_OG);
    for (long i = gt; i < (long)NROWS * 16; i += gs) {
        const int r = (int)(i / 16), h = (int)(i % 16), kvh = h >> 2;
        float o[64]; UNROLL for (int d = 0; d < 64; ++d) o[d] = 0.f; const bf16* q = Q + (size_t)r * D + h * 64;
        float m = P.in[I_SSINK][j * 16 + h], l = 1.f; const float* bt = BT + h * 132;
        if (r < ROW_SAMP) {
            int b, pos; if (r < NP) { b = r / SEQ; pos = r % SEQ + 16; } else { b = (r - ROW_META) / NMETA; pos = (r - ROW_META) % NMETA; }
            for (int mi = 0; mi < 16 && mi <= pos; ++mi) { const int kr = ROW_META + b * NMETA + mi; const int dist = pos - mi;
                att_key(K + (size_t)kr * 256 + kvh * 64, VT + (size_t)(kvh * 64) * MPAD + kr, MPAD, q, bt[dist > 128 ? 128 : dist], m, l, o); }
            if (r < NP) { const int t = pos - 16; for (int t2 = (t > 128 ? t - 128 : 0); t2 <= t; ++t2) { const int kr = b * SEQ + t2;
                att_key(K + (size_t)kr * 256 + kvh * 64, VT + (size_t)(kvh * 64) * MPAD + kr, MPAD, q, bt[t - t2], m, l, o); } }
        } else {
            const int bs = (r - ROW_SAMP) / TS, t = (r - ROW_SAMP) % TS;
            const bf16* kc = WSP(bf16, W_KC) + ((size_t)j * DECB + bs) * KCN * 256 + kvh * 64; const bf16* vc = WSP(bf16, W_VTC) + (((size_t)j * DECB + bs) * 256 + kvh * 64) * KCN;
            for (int key = 0; key < 148; ++key) {
                int dist; if (key < 16) dist = PAST + t - key; else if (key < 144) { dist = 128 + t - (key - 16); if (dist > 128) continue; } else { dist = t - (key - 144); if (dist < 0) continue; }
                if (key < 144) att_key(kc + (size_t)key * 256, vc + key, KCN, q, bt[dist > 128 ? 128 : dist], m, l, o);
                else { const int kr = ROW_SAMP + bs * TS + (key - 144); att_key(K + (size_t)kr * 256 + kvh * 64, VT + (size_t)(kvh * 64) * MPAD + kr, MPAD, q, bt[dist], m, l, o); } }
        }
        const float inv = 1.f / l;
        UNROLL for (int d = 0; d < 64; ++d) OG[(size_t)r * D + h * 64 + d] = f2bf(o[d] * inv * bf2f(GS[(size_t)r * D + h * 64 + d]));
    }
}
HD inline void ph_resid(const Params& P, int last, long gt, long gs) {
    float* X = WSP(float, W_X); const float* T = WSP(float, W_TMP);
    for (long i = gt; i < (long)NROWS * D; i += gs) { const float v = X[i] + T[i]; X[i] = v;
        if (last) { const int r = (int)(i / D); if (r < NP) P.out[O_YP + i] = v; else if (r >= ROW_SAMP) P.out[O_YS + (i - (size_t)ROW_SAMP * D)] = v; } }
}
HD inline void ph_m1e(const Params& P, int j, long gt, long gs) {
    const float* T = WSP(float, W_TMP); bf16* XM = WSP(bf16, W_XM); bf16* ZS = WSP(bf16, W_ZS); bf16* OS = WSP(bf16, W_OS);
    for (long i = gt; i < (long)MPAD * ML_N; i += gs) { const int r = (int)(i / ML_N), c = (int)(i % ML_N); const float v = T[i];
        if (c < 2048) { XM[(size_t)r * MI + c] = f2bf(v);
            if (r < NP) { const int b = r / SEQ, t = r % SEQ; if (t >= SEQ - 3) P.out[O_PCONV + (((size_t)j * BATCH + b) * 3 + (t - (SEQ - 3))) * 2048 + c] = v; }
            else if (r >= ROW_SAMP && r < NROWS) { const int bs = (r - ROW_SAMP) / TS, t = (r - ROW_SAMP) % TS; if (t >= 1) P.out[O_SCONV + (((size_t)j * DECB + bs) * 3 + (t - 1)) * 2048 + c] = v; } }
        else if (c < 4096) ZS[(size_t)r * MI + c - 2048] = f2bf(siluf(v));
        else OS[(size_t)r * MI + c - 4096] = f2bf(sigmf(v)); }
}
HD inline float conv_in(const Params& P, int j, int r, int back, int c) {
    int rr = r;
    for (int s = 0; s < back; ++s) { const int p = prev_row(rr);
        if (p == -1) return 0.f;
        if (p == -2) { const int bs = (r - ROW_SAMP) / TS; const int remaining = back - s;
            return P.in[I_SCONV][(((size_t)j * DECB + bs) * 3 + (3 - remaining)) * 2048 + c]; }
        rr = p; }
    return bf2f(WSP(bf16, W_XM)[(size_t)rr * MI + c]);
}
HD inline void ph_conv(const Params& P, int j, long gt, long gs) {
    bf16* XC = WSP(bf16, W_XC); const float* cw = P.in[I_MCW] + (size_t)j * 4 * 2048; const float* cb = P.in[I_MCB] + (size_t)j * 2048;
    for (long i = gt; i < (long)MPAD * MI; i += gs) { const int r = (int)(i / MI), c = (int)(i % MI);
        if (r >= NROWS) { XC[i] = 0; continue; }
        float a = cb[c];
        for (int w = 0; w < 4; ++w) a += conv_in(P, j, r, 3 - w, c) * cw[w * 2048 + c];
        XC[i] = f2bf(siluf(a)); }
}
HD inline void ph_gates(const Params& P, int j, long gt, long gs) {
    const bf16* XC = WSP(bf16, W_XC); const bf16* XM = WSP(bf16, W_XM); const float* G = WSP(float, W_G) + (size_t)j * 4096 * 8; float* GA = WSP(float, W_GATES);
    for (long i = gt; i < (long)NROWS * 8; i += gs) { const int r = (int)(i / 8), g = (int)(i % 8);
        float a = P.in[I_MBG][j * 8 + g];
        for (int c = 0; c < 2048; ++c) a += bf2f(XC[(size_t)r * MI + c]) * G[(size_t)c * 8 + g] + bf2f(XM[(size_t)r * MI + c]) * G[(size_t)(2048 + c) * 8 + g];
        GA[i] = a; }
}
HD inline void scal_chunk(const float* GA, int h, int row0, int L, float& m, float* SA, float* SCJ, float* SWI, float* SEM, float* SWK, float& decay) {
    float b = 0.f, pm = -3.0e38f; const float m_prev = m; float mt = m_prev;
    for (int t = 0; t < L; ++t) { const int r = row0 + t; const float ip = GA[(size_t)r * 8 + h], lf = logsigf(GA[(size_t)r * 8 + 4 + h]);
        b += lf; const float cj = ip - b; pm = cj > pm ? cj : pm; const float mx = m_prev > pm ? m_prev : pm;
        mt = b + mx; SA[r * 4 + h] = -mx; SCJ[r * 4 + h] = cj; SWI[r * 4 + h] = expf(m_prev - mx); SEM[r * 4 + h] = expf(-mt); }
    const float g = b, m_new = mt;
    for (int t = 0; t < L; ++t) { const int r = row0 + t; SWK[r * 4 + h] = expf(g + SCJ[r * 4 + h] - m_new); }
    decay = expf(g + m_prev - m_new); m = m_new;
}
HD inline void ph_scal(const Params& P, int j, long gt, long gs) {
    const float* GA = WSP(float, W_GATES); float* SA = WSP(float, W_SA); float* SCJ = WSP(float, W_SCJ); float* SWI = WSP(float, W_SWI); float* SEM = WSP(float, W_SEM); float* SWK = WSP(float, W_SWK);
    float* DEC = WSP(float, W_DEC);
    for (long i = gt; i < (long)(BATCH + DECB) * 4; i += gs) {
        if (i < BATCH * 4) { const int b = (int)(i / 4), h = (int)(i % 4); float m = 0.f;
            for (int c = 0; c < NCH; ++c) { float dec; const int row0 = c == 0 ? ROW_META + b * NMETA : b * SEQ + (c - 1) * LCH;
                scal_chunk(GA, h, row0, c == 0 ? NMETA : LCH, m, SA, SCJ, SWI, SEM, SWK, dec); DEC[(size_t)i * NCH + c] = dec; }
            P.out[O_PM + (size_t)j * BATCH * 4 + i] = m;
        } else { const long k = i - BATCH * 4; const int bs = (int)(k / 4), h = (int)(k % 4); float m = P.in[I_SM][(size_t)j * DECB * 4 + k]; float dec;
            scal_chunk(GA, h, ROW_SAMP + bs * TS, TS, m, SA, SCJ, SWI, SEM, SWK, dec); DEC[(size_t)BATCH * 4 * NCH + k] = dec;
            P.out[O_SMM + (size_t)j * DECB * 4 + k] = m; }
    }
}
HD inline void ph_pmat(const Params& P, long gt, long gs) {
    const bf16* Q = WSP(bf16, W_MQ); const bf16* K = WSP(bf16, W_MK); const float* SA = WSP(float, W_SA); const float* SCJ = WSP(float, W_SCJ); bf16* PM = WSP(bf16, W_P);
    for (long i = gt; i < (long)NP * 4 * 64; i += gs) { const int j4 = (int)(i % 64) * 4, h = (int)((i / 64) % 4), r = (int)(i / 256);
        const int tt = r % LCH, r0 = r - tt; const bf16* q = Q + (size_t)r * MI + h * 512;
        for (int jj = j4; jj < j4 + 4; ++jj) { float v = 0.f;
            if (jj <= tt) { const bf16* k = K + (size_t)(r0 + jj) * MI + h * 512; float s = 0.f; for (int d = 0; d < 512; ++d) s += bf2f(q[d]) * bf2f(k[d]);
                v = s * expf(SA[r * 4 + h] + SCJ[(r0 + jj) * 4 + h]); }
            PM[(size_t)r * 2048 + h * 512 + jj] = f2bf(v); } }
}
HD inline void ph_state(const Params& P, int j, int c, long gt, long gs) {
    const bf16* KT = WSP(bf16, W_MKT); const bf16* VT = WSP(bf16, W_MVT); const float* SWK = WSP(float, W_SWK); const float* DEC = WSP(float, W_DEC);
    float* CST = WSP(float, W_CST); bf16* CT = WSP(bf16, W_CT); float* NST = WSP(float, W_NST); float* NRUN = WSP(float, W_NRUN);
    const int L = c == 0 ? NMETA : LCH;
    for (long i = gt; i < (long)BATCH * 4 * 512 * 128; i += gs) { const int d4 = (int)(i % 128) * 4, e = (int)((i / 128) % 512), bh = (int)(i / (128 * 512)); const int b = bh / 4, h = bh % 4;
        const int row0 = c == 0 ? ROW_META + b * NMETA : b * SEQ + (c - 1) * LCH; const float dec = DEC[(size_t)bh * NCH + c];
        float acc[4] = {0.f, 0.f, 0.f, 0.f};
        const bf16* vt = VT + vtb_idx(row0, h, e);
        for (int t = 0; t < L; ++t) { const float wv = SWK[(row0 + t) * 4 + h] * bf2f(vt[t]);
            UNROLL for (int u = 0; u < 4; ++u) acc[u] += wv * bf2f(KT[(size_t)(h * 512 + d4 + u) * MPAD + row0 + t]); }
        UNROLL for (int u = 0; u < 4; ++u) { const size_t si = ((size_t)bh * 512 + e) * 512 + d4 + u; const float old = c == 0 ? 0.f : CST[si];
            if (c >= 1) CT[ctb_idx(c, b, h, e, d4 + u)] = f2bf(old);
            const float nv = dec * old + acc[u]; CST[si] = nv;
            if (c == NCH - 1) P.out[O_PC + (((size_t)j * BATCH * 4 + bh) * 512 + d4 + u) * 512 + e] = nv; }
        if (e == 0) UNROLL for (int u = 0; u < 4; ++u) { const int d = d4 + u; float a = 0.f;
            for (int t = 0; t < L; ++t) a += SWK[(row0 + t) * 4 + h] * bf2f(KT[(size_t)(h * 512 + d) * MPAD + row0 + t]);
            const float old = c == 0 ? 0.f : NRUN[bh * 512 + d]; NST[((size_t)bh * NCH + c) * 512 + d] = old; const float nv = dec * old + a; NRUN[bh * 512 + d] = nv;
            if (c == NCH - 1) P.out[O_PN + ((size_t)j * BATCH * 4 + bh) * 512 + d] = nv; }
    }
}
HD inline void ph_den(const Params& P, long gt, long gs) {
    const bf16* Q = WSP(bf16, W_MQ); const bf16* PM = WSP(bf16, W_P); const float* NST = WSP(float, W_NST); const float* SWI = WSP(float, W_SWI); float* DEN = WSP(float, W_DEN);
    for (long i = gt; i < (long)NP * 4; i += gs) { const int r = (int)(i / 4), h = (int)(i % 4), b = r / SEQ, c = (r % SEQ) / LCH + 1, bh = b * 4 + h;
        float s = 0.f; for (int jj = 0; jj < 256; ++jj) s += bf2f(PM[(size_t)r * 2048 + h * 512 + jj]);
        float qn = 0.f; const float* n = NST + ((size_t)bh * NCH + c) * 512; for (int d = 0; d < 512; ++d) qn += bf2f(Q[(size_t)r * MI + h * 512 + d]) * n[d];
        DEN[r * 4 + h] = s + SWI[r * 4 + h] * qn; }
}
HD inline void ph_num(const Params& P, long gt, long gs) {
    const bf16* Q = WSP(bf16, W_MQ); const bf16* PM = WSP(bf16, W_P); const bf16* CT = WSP(bf16, W_CT); const bf16* VT = WSP(bf16, W_MVT);
    const float* SWI = WSP(float, W_SWI); const float* SEM = WSP(float, W_SEM); const float* DEN = WSP(float, W_DEN); bf16* H = WSP(bf16, W_H);
    for (long i = gt; i < (long)NP * 4 * 128; i += gs) { const int e4 = (int)(i % 128) * 4, h = (int)((i / 128) % 4), r = (int)(i / 512); const int b = r / SEQ, tt = r % LCH, r0 = r - tt, c = (r % SEQ) / LCH + 1, bh = b * 4 + h;
        const bf16* q = Q + (size_t)r * MI + h * 512; const bf16* p = PM + (size_t)r * 2048 + h * 512;
        const float wi = SWI[r * 4 + h]; const float den = DEN[r * 4 + h]; const float dd = fmaxf(fabsf(den), SEM[r * 4 + h]);
        UNROLL for (int u = 0; u < 4; ++u) { const int e = e4 + u; const bf16* ct = CT + ctb_idx(c, b, h, e, 0);
            float a = 0.f; for (int d = 0; d < 512; ++d) a += bf2f(q[d]) * bf2f(ct[d]);
            a *= wi; const bf16* vt = VT + vtb_idx(r0, h, e);
            for (int jj = 0; jj <= tt; ++jj) a += bf2f(p[jj]) * bf2f(vt[jj]);
            H[(size_t)r * MI + h * 512 + e] = f2bf(a / dd); } }
}
HD inline void small_item(long it, int& h, int& row0, int& L, bool& samp, int& idx) {
    if (it < BATCH * 4) { idx = (int)(it / 4); h = (int)(it % 4); row0 = ROW_META + idx * NMETA; L = NMETA; samp = false; }
    else { const long k = it - BATCH * 4; idx = (int)(k / 4); h = (int)(k % 4); row0 = ROW_SAMP + idx * TS; L = TS; samp = true; }
}
HD inline void ph_smalls(const Params& P, int j, int only_meta, long gt, long gs) {
    const bf16* Q = WSP(bf16, W_MQ); const bf16* K = WSP(bf16, W_MK); const float* SA = WSP(float, W_SA); const float* SCJ = WSP(float, W_SCJ); const float* SWI = WSP(float, W_SWI);
    float* PSM = WSP(float, W_PSM); float* DEN = WSP(float, W_DEN);
    for (long i = gt; i < (long)(only_meta ? BATCH : BATCH + DECB) * 4 * 16; i += gs) { const long it = i / 16; const int t = (int)(i % 16); int h, row0, L, idx; bool samp; small_item(it, h, row0, L, samp, idx);
        if (t >= L) continue; const int r = row0 + t; const bf16* q = Q + (size_t)r * MI + h * 512; float s = 0.f;
        for (int jj = 0; jj < 16; ++jj) { float v = 0.f;
            if (jj <= t) { const bf16* k = K + (size_t)(row0 + jj) * MI + h * 512; float a = 0.f; for (int d = 0; d < 512; ++d) a += bf2f(q[d]) * bf2f(k[d]); v = a * expf(SA[r * 4 + h] + SCJ[(row0 + jj) * 4 + h]); }
            PSM[(size_t)it * 256 + t * 16 + jj] = v; s += v; }
        float qn = 0.f;
        if (samp) { const float* n = P.in[I_SN] + (((size_t)j * DECB + idx) * 4 + h) * 512; for (int d = 0; d < 512; ++d) qn += bf2f(q[d]) * n[d]; }
        DEN[r * 4 + h] = s + SWI[r * 4 + h] * qn; }
}
HD inline void ph_smallm(const Params& P, int j, int only_meta, long gt, long gs) {
    const bf16* Q = WSP(bf16, W_MQ); const bf16* K = WSP(bf16, W_MK); const bf16* VT = WSP(bf16, W_MVT); const float* PSM = WSP(float, W_PSM);
    const float* SWI = WSP(float, W_SWI); const float* SEM = WSP(float, W_SEM); const float* SWK = WSP(float, W_SWK); const float* DEN = WSP(float, W_DEN); const float* DEC = WSP(float, W_DEC); bf16* H = WSP(bf16, W_H);
    for (long i = gt; i < (long)(only_meta ? BATCH : BATCH + DECB) * 4 * 512; i += gs) { const long it = i / 512; const int x = (int)(i % 512); int h, row0, L, idx; bool samp; small_item(it, h, row0, L, samp, idx);
        float v[16];
        UNROLL for (int t = 0; t < 16; ++t) v[t] = t < L ? bf2f(VT[vtb_idx(row0 + t, h, x)]) : 0.f;
        float acc0 = 0.f, acc1 = 0.f, acc2 = 0.f, acc3 = 0.f;
        if (samp) { const size_t so = (((size_t)j * DECB + idx) * 4 + h) * 512 * 512; const float* cin = P.in[I_SC] + so; float* cout = P.out + O_SCC + so; const float dec = DEC[(size_t)BATCH * 4 * NCH + (it - BATCH * 4)];
            const float wv0 = SWK[(row0 + 0) * 4 + h] * v[0], wv1 = SWK[(row0 + 1) * 4 + h] * v[1], wv2 = SWK[(row0 + 2) * 4 + h] * v[2], wv3 = SWK[(row0 + 3) * 4 + h] * v[3];
            const bf16* q0 = Q + (size_t)row0 * MI + h * 512; const bf16* k0 = K + (size_t)row0 * MI + h * 512;
            for (int d = 0; d < 512; ++d) { const float ci = cin[(size_t)d * 512 + x]; float a = dec * ci;
                acc0 += bf2f(q0[d]) * ci; acc1 += bf2f(q0[MI + d]) * ci; acc2 += bf2f(q0[2 * MI + d]) * ci; acc3 += bf2f(q0[3 * MI + d]) * ci;
                a += wv0 * bf2f(k0[d]) + wv1 * bf2f(k0[MI + d]) + wv2 * bf2f(k0[2 * MI + d]) + wv3 * bf2f(k0[3 * MI + d]);
                cout[(size_t)d * 512 + x] = a; }
            const size_t no = (((size_t)j * DECB + idx) * 4 + h) * 512 + x; float a = dec * P.in[I_SN][no];
            for (int t = 0; t < 4; ++t) a += SWK[(row0 + t) * 4 + h] * bf2f(K[(size_t)(row0 + t) * MI + h * 512 + x]);
            P.out[O_SNN + no] = a; }
        UNROLL for (int t = 0; t < 16; ++t) { if (t < L) { const int r = row0 + t; const float ac = t == 0 ? acc0 : t == 1 ? acc1 : t == 2 ? acc2 : t == 3 ? acc3 : 0.f; float a = SWI[r * 4 + h] * ac;
            UNROLL for (int jj = 0; jj < 16; ++jj) if (jj <= t) a += PSM[(size_t)it * 256 + t * 16 + jj] * v[jj];
            H[(size_t)r * MI + h * 512 + x] = f2bf(a / fmaxf(fabsf(DEN[r * 4 + h]), SEM[r * 4 + h])); } } }
}
HD inline void ph_hnorm(const Params& P, int j, long gt, long gs) {
    const bf16* H = WSP(bf16, W_H); const bf16* OS = WSP(bf16, W_OS); const bf16* XC = WSP(bf16, W_XC); const bf16* ZS = WSP(bf16, W_ZS); bf16* A2 = WSP(bf16, W_A2);
    const float* hn = P.in[I_MHN] + (size_t)j * 2048; const float* sk = P.in[I_MSKIP] + (size_t)j * 2048;
    for (long i = gt; i < (long)MPAD * 4; i += gs) { const int r = (int)(i / 4), h = (int)(i % 4); const size_t o = (size_t)r * MI + h * 512;
        if (r >= NROWS) { for (int e = 0; e < 512; ++e) A2[o + e] = 0; continue; }
        float s = 0.f; for (int e = 0; e < 512; ++e) s += bf2f(H[o + e]); const float mu = s / 512.f;
        float q = 0.f; for (int e = 0; e < 512; ++e) { const float dlt = bf2f(H[o + e]) - mu; q += dlt * dlt; } const float rs = 1.f / sqrtf(q / 512.f + EPS);
        for (int e = 0; e < 512; ++e) { const int c = h * 512 + e; const float y = (bf2f(H[o + e]) - mu) * rs * hn[c];
            A2[o + e] = f2bf((bf2f(OS[o + e]) * y + sk[c] * bf2f(XC[o + e])) * bf2f(ZS[o + e])); } }
}

template <int PH> HD inline void dispatch(const Params& P, int a0, int a1, long gt, long gs) {
    if constexpr (PH == PH_WCONV) ph_wconv(P, gt, gs);
    else if constexpr (PH == PH_GMAT) ph_gmat(P, gt, gs);
    else if constexpr (PH == PH_INITX) ph_initx(P, gt, gs);
    else if constexpr (PH == PH_CACHE) ph_cache(P, gt, gs);
    else if constexpr (PH == PH_NORM) ph_norm(P, a0, gt, gs);
    else if constexpr (PH == PH_S1E) ph_s1e(P, a0, gt, gs);
    else if constexpr (PH == PH_ATT) ph_att(P, a0, gt, gs);
    else if constexpr (PH == PH_RESID) ph_resid(P, a0, gt, gs);
    else if constexpr (PH == PH_M1E) ph_m1e(P, a0, gt, gs);
    else if constexpr (PH == PH_CONV) ph_conv(P, a0, gt, gs);
    else if constexpr (PH == PH_GATES) ph_gates(P, a0, gt, gs);
    else if constexpr (PH == PH_SCAL) ph_scal(P, a0, gt, gs);
    else if constexpr (PH == PH_PMAT) ph_pmat(P, gt, gs);
    else if constexpr (PH == PH_STATE) ph_state(P, a0, a1, gt, gs);
    else if constexpr (PH == PH_DEN) ph_den(P, gt, gs);
    else if constexpr (PH == PH_NUM) ph_num(P, gt, gs);
    else if constexpr (PH == PH_SMALLS) ph_smalls(P, a0, a1, gt, gs);
    else if constexpr (PH == PH_SMALLM) ph_smallm(P, a0, a1, gt, gs);
    else if constexpr (PH == PH_HNORM) ph_hnorm(P, a0, gt, gs);
    else if constexpr (PH == PH_SWAOUT) ph_swaout(P, a0, gt, gs);
}
struct GemmDesc { const bf16* A; const bf16* B; void* C; long lda, ldb, ldc; int M, N, K, mode; };
HD inline void ph_gemm(const GemmDesc& g, long gt, long gs) {
    const int nm = g.M / 4, nn = g.N / 4;
    for (long i = gt; i < (long)nm * nn; i += gs) { const int m0 = (int)(i / nn) * 4, n0 = (int)(i % nn) * 4;
        float acc[4][4]; UNROLL for (int a = 0; a < 4; ++a) UNROLL for (int b = 0; b < 4; ++b) acc[a][b] = 0.f;
        for (int k = 0; k < g.K; k += 8) {
            float av[4][8], bv[4][8];
            UNROLL for (int a = 0; a < 4; ++a) UNROLL for (int kk = 0; kk < 8; ++kk) av[a][kk] = bf2f(g.A[(size_t)(m0 + a) * g.lda + k + kk]);
            UNROLL for (int b = 0; b < 4; ++b) UNROLL for (int kk = 0; kk < 8; ++kk) bv[b][kk] = bf2f(g.B[(size_t)(n0 + b) * g.ldb + k + kk]);
            UNROLL for (int a = 0; a < 4; ++a) UNROLL for (int b = 0; b < 4; ++b) UNROLL for (int kk = 0; kk < 8; ++kk) acc[a][b] += av[a][kk] * bv[b][kk];
        }
        UNROLL for (int a = 0; a < 4; ++a) UNROLL for (int b = 0; b < 4; ++b) { const float v = acc[a][b];
            if (g.mode == 0) ((float*)g.C)[(size_t)(m0 + a) * g.ldc + n0 + b] = v;
            else if (g.mode == 1) ((bf16*)g.C)[(size_t)(m0 + a) * g.ldc + n0 + b] = f2bf(v);
            else ((bf16*)g.C)[(size_t)(n0 + b) * g.ldc + m0 + a] = f2bf(v); }
    }
}
#define LAS __attribute__((address_space(3)))
#define XB_TMO      128
#define XB_XCNT(j)  (256  + 64 * (j))
#define XB_XSUB(j)  (1280 + 64 * (j))
#define XB_XGEN(j)  (2304 + 64 * (j))
#define XB_TOP      3328
#define XB_TOPGEN   3392
#define XCD_BAR_WORDS 3456
#define XB_SPIN_CAP (1u << 24)

__device__ __forceinline__ unsigned xb_ld(unsigned* p)              { return __hip_atomic_load(p, __ATOMIC_RELAXED, __HIP_MEMORY_SCOPE_AGENT); }
__device__ __forceinline__ unsigned xb_add(unsigned* p, unsigned v) { return __hip_atomic_fetch_add(p, v, __ATOMIC_RELAXED, __HIP_MEMORY_SCOPE_AGENT); }
__device__ __forceinline__ unsigned xb_xcc_id() { return (unsigned)__builtin_amdgcn_s_getreg((3 << 11) | 20) & 0xFu; }
#define XB_SPIN(cond, bar) do { unsigned _sp = 0; while (cond) { __builtin_amdgcn_s_sleep(1); \
    if ((++_sp & 255u) == 0u) { if (xb_ld(&(bar)[XB_TMO])) break; if (_sp > XB_SPIN_CAP) { atomicAdd(&(bar)[XB_TMO], 1u); break; } } } } while (0)

struct XcdBarrier {
    unsigned* bar; unsigned x;
    volatile LAS unsigned* st;
};

__device__ __forceinline__ XcdBarrier xcd_barrier_post(unsigned* bar, volatile LAS unsigned* st) {
    XcdBarrier b; b.bar = bar; b.x = xb_xcc_id(); b.st = st;
    if (threadIdx.x == 0) (void)xb_add(&bar[XB_XCNT(b.x)], 1u);
    return b;
}
__device__ __forceinline__ void xcd_barrier_complete(unsigned* bar, unsigned x, unsigned& nloc, unsigned& nx) {
    const unsigned G = gridDim.x * gridDim.y * gridDim.z;
    unsigned sum, cnt, mine, sp = 0u;
    for (;;) {
        sum = 0u; cnt = 0u; mine = 0u;
#pragma unroll
        for (unsigned j = 0; j < 16; ++j) { const unsigned c = xb_ld(&bar[XB_XCNT(j)]); sum += c; cnt += (c > 0u) ? 1u : 0u; mine = (j == x) ? c : mine; }
        if (sum == G) break;
        __builtin_amdgcn_s_sleep(1);
        if ((++sp & 255u) == 0u) { if (xb_ld(&bar[XB_TMO])) break; if (sp > XB_SPIN_CAP) { atomicAdd(&bar[XB_TMO], 1u); break; } }
    }
    nloc = mine > 0u ? mine : 1u; nx = cnt > 0u ? cnt : 1u;
}

__device__ __forceinline__ void xcd_barrier(const XcdBarrier& b) {
    asm volatile("s_waitcnt vmcnt(0)" ::: "memory");
    __syncthreads();
    if (threadIdx.x == 0) {
        unsigned* bar = b.bar;
        __builtin_amdgcn_s_waitcnt(0);
        unsigned nloc = b.st[0], nx = b.st[1];
        if (nloc == 0u) { xcd_barrier_complete(bar, b.x, nloc, nx); b.st[0] = nloc; b.st[1] = nx; }
        const unsigned old = xb_add(&bar[XB_XSUB(b.x)], 1u);
        const unsigned gen = old / nloc;
        if (old + 1u == (gen + 1u) * nloc) {
            __builtin_amdgcn_fence(__ATOMIC_RELEASE, "agent");
            asm volatile("s_waitcnt vmcnt(0)" ::: "memory");
            const unsigned og = xb_add(&bar[XB_TOP], 1u);
            const unsigned tg = og / nx;
            if (og + 1u == (tg + 1u) * nx) xb_add(&bar[XB_TOPGEN], 1u);
            else XB_SPIN(xb_ld(&bar[XB_TOPGEN]) == tg, bar);
            __builtin_amdgcn_fence(__ATOMIC_ACQUIRE, "agent");
            xb_add(&bar[XB_XGEN(b.x)], 1u);
            asm volatile("s_waitcnt vmcnt(0)" ::: "memory");
        } else {
            XB_SPIN(xb_ld(&bar[XB_XGEN(b.x)]) == gen, bar);
            __builtin_amdgcn_fence(__ATOMIC_ACQUIRE, "agent");
            asm volatile("s_waitcnt vmcnt(0)" ::: "memory");
        }
    }
    __syncthreads();
}

#define WSP2(PP, T, off) ((T*)((PP).ws + (off)))
namespace pg8 {
typedef short bf16x8 __attribute__((ext_vector_type(8)));
typedef float f32x4 __attribute__((ext_vector_type(4)));
typedef unsigned u32x2 __attribute__((ext_vector_type(2)));
constexpr int BM = 256, BK = 64, HALF = 128, HTB = HALF * BK * 2, STAGE_BYTES = 8 * HTB;
__device__ __forceinline__ int lds_byte(int r, int c) { const int st = (r >> 4) * 2 + (c >> 5), rr = r & 15, cc = c & 31, ob = rr * 64 + cc * 2; return st * 1024 + (ob ^ (((ob >> 9) & 1) << 5)); }
__device__ __forceinline__ void stage_rc(int b, int& R, int& C) { const int st = b / 1024, sb = b % 1024, swz = sb ^ (((sb >> 9) & 1) << 5); R = (st >> 1) * 16 + swz / 64; C = (st & 1) * 32 + (swz % 64) / 2; }
__device__ __forceinline__ unsigned cvt_pk_bf16(float lo, float hi) {
    typedef __bf16 b2_t __attribute__((ext_vector_type(2))); typedef float f2_t __attribute__((ext_vector_type(2)));
    const f2_t v = {lo, hi}; const b2_t r = __builtin_convertvector(v, b2_t); return __builtin_bit_cast(unsigned, r); }
__device__ __forceinline__ int perm32(int rho) { const int n = rho >> 4, i = rho & 15; return 8 * (i >> 2) + 4 * n + (i & 3); }
struct Unit { const char* A; const char* B; int pm, pn, aux, nt; };
template <class Epi, class Sched>
__device__ __forceinline__ void gemm_phase(LAS unsigned char* lds, const int lda, const int ldb, const Sched& S, const Epi& E) {
    int tid = threadIdx.x; asm volatile("" : "+v"(tid));
    const int wid = __builtin_amdgcn_readfirstlane(tid >> 6), lane = tid & 63, wr = wid >> 2, wc = wid & 3, fr = lane & 15, fq = lane >> 4;
    unsigned voffA[2], voffB[2];
#pragma unroll
    for (int i = 0; i < 2; ++i) { int R, C; stage_rc(tid * 16 + i * 8192, R, C); const int Rb = Epi::PERM ? ((R & ~31) + perm32(R & 31)) : R;
        voffA[i] = (unsigned)(R * lda + C) * 2u; voffB[i] = (unsigned)(Rb * ldb + C) * 2u; }
    const size_t kstep = (size_t)(BK * 2);
    const size_t hstepA = (size_t)HALF * lda * 2, hstepB = (size_t)HALF * ldb * 2;
    const unsigned ldsw = (unsigned)wid * 1024u;
    const int aoff = lds_byte(wr * 64 + fr, fq * 8), boff = lds_byte(wc * 32 + fr, fq * 8);
#define PG8_SA(b, h) (((b) * 2 + (h)) * HTB)
#define PG8_SB(b, h) ((4 + (b) * 2 + (h)) * HTB)
#define PG8_STAGE(bufoff, gbase, voff) do { _Pragma("unroll") for (int _i = 0; _i < 2; ++_i) \
        __builtin_amdgcn_global_load_lds((const unsigned*)((const char*)(gbase) + (voff)[_i]), (LAS unsigned*)(lds + (bufoff) + ldsw + _i * 8192), 16, 0, 0); } while (0)
#define PG8_LDA(dst, b, h) do { _Pragma("unroll") for (int m = 0; m < 4; ++m) _Pragma("unroll") for (int k = 0; k < 2; ++k) dst[m][k] = *(const LAS bf16x8*)(lds + PG8_SA(b, h) + aoff + m * 2048 + k * 1024); } while (0)
#define PG8_LDB(dst, b, h) do { _Pragma("unroll") for (int n = 0; n < 2; ++n) _Pragma("unroll") for (int k = 0; k < 2; ++k) dst[n][k] = *(const LAS bf16x8*)(lds + PG8_SB(b, h) + boff + n * 2048 + k * 1024); } while (0)
#define PG8_MMA(ai, bj, At, Bt) do { __builtin_amdgcn_s_setprio(1); _Pragma("unroll") for (int m = 0; m < 4; ++m) _Pragma("unroll") for (int n = 0; n < 2; ++n) _Pragma("unroll") for (int k = 0; k < 2; ++k) \
        acc[ai][bj][m][n] = __builtin_amdgcn_mfma_f32_16x16x32_bf16(Bt[n][k], At[m][k], acc[ai][bj][m][n], 0, 0, 0); __builtin_amdgcn_s_setprio(0); } while (0)
#define PG8_WAIT_V(n) asm volatile("s_waitcnt vmcnt(" #n ")" ::: "memory")
#define PG8_WAIT_L(n) asm volatile("s_waitcnt lgkmcnt(" #n ")" ::: "memory")
#define PG8_BAR __builtin_amdgcn_s_barrier()
#define PG8_SCHED __builtin_amdgcn_sched_barrier(0)
    Unit cur, nxt; int ui = 0;
    if (!S.next(0, cur)) return;
    f32x4 acc[2][2][4][2];
#pragma unroll
    for (int a = 0; a < 2; ++a)
#pragma unroll
        for (int b = 0; b < 2; ++b)
#pragma unroll
            for (int m = 0; m < 4; ++m)
#pragma unroll
                for (int n = 0; n < 2; ++n) acc[a][b][m][n] = (f32x4){0.f, 0.f, 0.f, 0.f};
    bf16x8 At[4][2], B0[2][2], B1[2][2];
    const char* cA = cur.A; const char* cB = cur.B;
    PG8_STAGE(PG8_SB(0, 0), cB, voffB); PG8_STAGE(PG8_SB(0, 1), cB + hstepB, voffB); PG8_STAGE(PG8_SA(0, 0), cA, voffA); PG8_STAGE(PG8_SA(0, 1), cA + hstepA, voffA);
    if (wr == 1) PG8_BAR;
    PG8_WAIT_V(2); PG8_BAR;
    PG8_STAGE(PG8_SB(1, 0), cB + kstep, voffB); PG8_STAGE(PG8_SA(1, 0), cA + kstep, voffA); PG8_STAGE(PG8_SB(1, 1), cB + hstepB + kstep, voffB);
    PG8_WAIT_V(6); PG8_BAR;
    for (;;) {
        const bool has_next = S.next(ui + 1, nxt);
        const char* nA = has_next ? nxt.A : cA; const char* nB = has_next ? nxt.B : cB; const int nt = cur.nt;
        for (int t = 0; t < nt; t += 2) {
            const bool last = (t == nt - 2);
            const char* a1 = cA + (size_t)(t + 1) * kstep;
            const char* a2 = last ? nA : cA + (size_t)(t + 2) * kstep; const char* b2 = last ? nB : cB + (size_t)(t + 2) * kstep;
            const char* a3 = a2 + kstep; const char* b3 = b2 + kstep;
            PG8_LDB(B0, 0, 0); PG8_LDB(B1, 0, 1); PG8_SCHED; PG8_LDA(At, 0, 0); PG8_STAGE(PG8_SA(1, 1), a1 + hstepA, voffA);
            PG8_WAIT_V(8); PG8_WAIT_L(0); PG8_BAR; PG8_MMA(0, 0, At, B0); PG8_MMA(0, 1, At, B1); PG8_BAR; PG8_SCHED;
            PG8_LDA(At, 0, 1); PG8_STAGE(PG8_SB(0, 0), b2, voffB); PG8_STAGE(PG8_SB(0, 1), b2 + hstepB, voffB); PG8_STAGE(PG8_SA(0, 0), a2, voffA);
            PG8_WAIT_V(8); PG8_WAIT_L(0); PG8_BAR; PG8_MMA(1, 0, At, B0); PG8_MMA(1, 1, At, B1); PG8_BAR; PG8_SCHED;
            PG8_LDB(B0, 1, 0); PG8_LDB(B1, 1, 1); PG8_SCHED; PG8_LDA(At, 1, 0); PG8_STAGE(PG8_SA(0, 1), a2 + hstepA, voffA);
            PG8_WAIT_V(8); PG8_WAIT_L(0); PG8_BAR; PG8_MMA(0, 0, At, B0); PG8_MMA(0, 1, At, B1); PG8_BAR; PG8_SCHED;
            PG8_LDA(At, 1, 1); PG8_STAGE(PG8_SB(1, 0), b3, voffB); PG8_STAGE(PG8_SB(1, 1), b3 + hstepB, voffB); PG8_STAGE(PG8_SA(1, 0), a3, voffA);
            PG8_WAIT_V(8); PG8_WAIT_L(0); PG8_BAR; PG8_MMA(1, 0, At, B0); PG8_MMA(1, 1, At, B1); PG8_BAR; PG8_SCHED;
        }
        if (wr == 0) PG8_BAR;
        const bool keep = E(acc, cur, wr, wc, fr, fq);
        if (!has_next) break;
        if (!keep) {
#pragma unroll
        for (int a = 0; a < 2; ++a)
#pragma unroll
            for (int b = 0; b < 2; ++b)
#pragma unroll
                for (int m = 0; m < 4; ++m)
#pragma unroll
                    for (int n = 0; n < 2; ++n) acc[a][b][m][n] = (f32x4){0.f, 0.f, 0.f, 0.f};
        }
        cur = nxt; cA = nA; cB = nB; ++ui;
        if (wr == 1) PG8_BAR;
    }
    PG8_WAIT_V(0);
    PG8_BAR;
#undef PG8_SA
#undef PG8_SB
#undef PG8_STAGE
#undef PG8_LDA
#undef PG8_LDB
#undef PG8_MMA
#undef PG8_WAIT_V
#undef PG8_WAIT_L
#undef PG8_BAR
#undef PG8_SCHED
}
struct PlainOrder {
    const char* A; const char* B; size_t tstepA, tstepB; int nM, nN, nwg, G, c, nt;
    __device__ __forceinline__ void init(const bf16* A_, int lda, const bf16* B_, int ldb, int M, int N, int K, int G_, int c_) { nt = K / BK;
        A = (const char*)A_; B = (const char*)B_; tstepA = (size_t)BM * lda * 2; tstepB = (size_t)BM * ldb * 2; nM = M / BM; nN = N / BM; nwg = nM * nN; G = G_; c = c_; }
    __device__ __forceinline__ bool next(int i, Unit& u) const {
        const long L = (long)i * G + c; if (L >= nwg) return false;
        int wgid = (int)L; { const int q = nwg / 8, r = nwg % 8, xcd = wgid % 8, off = wgid / 8; wgid = (xcd < r ? xcd * (q + 1) : r * (q + 1) + (xcd - r) * q) + off; }
        const int nig = 8 * nN, gid = wgid / nig, fm = gid * 8, gsz = (nM - fm) < 8 ? (nM - fm) : 8;
        u.pm = fm + ((wgid % nig) % gsz); u.pn = (wgid % nig) / gsz; u.aux = 0; u.nt = nt;
        u.A = A + (size_t)u.pm * tstepA; u.B = B + (size_t)u.pn * tstepB; return true;
    }
};
struct SplitTailOrder {
    const char* A; const char* B; size_t tstepA, tstepB; int K, nmain, G, c, nM;
    __device__ __forceinline__ void init(const bf16* A_, int lda, const bf16* B_, int ldb, int K_, int G_, int c_) {
        A = (const char*)A_; B = (const char*)B_; tstepA = (size_t)BM * lda * 2; tstepB = (size_t)BM * ldb * 2; K = K_; nM = NP / BM; nmain = nM * 4; G = G_; c = c_; }
    __device__ __forceinline__ bool next(int i, Unit& u) const {
        const long L = (long)i * G + c;
        if (L < nmain) { int wgid = (int)L; { const int q = nmain / 8, r = nmain % 8, xcd = wgid % 8, off = wgid / 8; wgid = (xcd < r ? xcd * (q + 1) : r * (q + 1) + (xcd - r) * q) + off; }
            const int nig = 8 * 4, gid = wgid / nig, fm = gid * 8, gsz = (nM - fm) < 8 ? (nM - fm) : 8;
            u.pm = fm + ((wgid % nig) % gsz); u.pn = (wgid % nig) / gsz; u.aux = 0; u.nt = K / BK; u.A = A + (size_t)u.pm * tstepA; u.B = B + (size_t)u.pn * tstepB; return true; }
        const int s = (int)(L - nmain); if (s >= (MPAD / BM - nM) * 16) return false;
        const int kq = s & 3; u.pn = (s >> 2) & 3; u.pm = nM + (s >> 4); u.aux = 1; u.nt = K / BK / 4;
        u.A = A + (size_t)u.pm * tstepA + (size_t)kq * (K / 4) * 2; u.B = B + (size_t)u.pn * tstepB + (size_t)kq * (K / 4) * 2; return true;
    }
};
}
namespace pg8 {
__device__ __forceinline__ u32x2 pk4(f32x4 v) { u32x2 w; w.x = cvt_pk_bf16(v[0], v[1]); w.y = cvt_pk_bf16(v[2], v[3]); return w; }
typedef unsigned u32x4e __attribute__((ext_vector_type(4)));
__device__ __forceinline__ u32x4e pk8(f32x4 a, f32x4 b) { u32x4e w; w[0] = cvt_pk_bf16(a[0], a[1]); w[1] = cvt_pk_bf16(a[2], a[3]); w[2] = cvt_pk_bf16(b[0], b[1]); w[3] = cvt_pk_bf16(b[2], b[3]); return w; }
__device__ __forceinline__ float silu_fast(float x) { return x * __builtin_amdgcn_rcpf(1.f + __expf(-x)); }
__device__ __forceinline__ float sigm_fast(float x) { return __builtin_amdgcn_rcpf(1.f + __expf(-x)); }

struct EpiResid {
    static constexpr bool PERM = false;
    const float* xin; bf16* X16; float* X32; float* out; int mode; long dummy_off;
    __device__ __forceinline__ bool operator()(f32x4 (&acc)[2][2][4][2], const Unit& u, int wr, int wc, int fr_, int fq_) const {
        int fr = fr_, fq = fq_; asm volatile("" : "+v"(fr), "+v"(fq));
        const int row0 = u.pm * BM + wr * 64 + fr, col0 = u.pn * BM + wc * 32 + 4 * fq;
        if (u.aux == 1) {
#pragma unroll
            for (int ai = 0; ai < 2; ++ai)
#pragma unroll
                for (int m = 0; m < 4; ++m) { const int row = row0 + ai * HALF + m * 16;
                    if (row < NROWS) { float* ap = X32 + (size_t)row * D + col0 + dummy_off;
#pragma unroll
                        for (int bj = 0; bj < 2; ++bj)
#pragma unroll
                            for (int n = 0; n < 2; ++n)
#pragma unroll
                                for (int e = 0; e < 4; ++e) __hip_atomic_fetch_add(ap + bj * HALF + n * 16 + e, acc[ai][bj][m][n][e], __ATOMIC_RELAXED, __HIP_MEMORY_SCOPE_AGENT); } }
            return false;
        }
#pragma unroll
        for (int ai = 0; ai < 2; ++ai) { f32x4 xv[4][2][2];
#pragma unroll
            for (int m = 0; m < 4; ++m) { const size_t o = (size_t)(row0 + ai * HALF + m * 16) * D + col0;
#pragma unroll
                for (int bj = 0; bj < 2; ++bj)
#pragma unroll
                    for (int n = 0; n < 2; ++n) {
                        if (mode == 0) xv[m][bj][n] = *(const f32x4*)(xin + o + bj * HALF + n * 16);
                        else { const u32x2 t = *(const u32x2*)(X16 + o + bj * HALF + n * 16); xv[m][bj][n] = (f32x4){__uint_as_float(t.x << 16), __uint_as_float(t.x & 0xffff0000u), __uint_as_float(t.y << 16), __uint_as_float(t.y & 0xffff0000u)}; } } }
#pragma unroll
            for (int m = 0; m < 4; ++m) { const size_t o = (size_t)(row0 + ai * HALF + m * 16) * D + col0;
#pragma unroll
                for (int bj = 0; bj < 2; ++bj)
#pragma unroll
                    for (int n = 0; n < 2; ++n) { const f32x4 v = xv[m][bj][n] + acc[ai][bj][m][n];
                        if (dummy_off) *(u32x2*)(X16 + (size_t)NP * D + o + bj * HALF + n * 16) = pk4(v);
                        else if (mode == 2) *(f32x4*)(out + O_YP + o + bj * HALF + n * 16) = v;
                        else *(u32x2*)(X16 + o + bj * HALF + n * 16) = pk4(v); } }
            asm volatile("" ::: "memory"); }
        return false;
    }
};
struct EpiSwaIn {
    static constexpr bool PERM = true;
    Params P; int j;
    __device__ __forceinline__ static float rownorm(const f32x4 (&acc)[2][2][4][2], int ai, int m) {
        float ss = 0.f;
#pragma unroll
        for (int bj = 0; bj < 2; ++bj)
#pragma unroll
            for (int n = 0; n < 2; ++n) { const f32x4 x = acc[ai][bj][m][n]; ss += (x[0] * x[0] + x[1] * x[1]) + (x[2] * x[2] + x[3] * x[3]); }
        ss += __shfl_xor(ss, 16); ss += __shfl_xor(ss, 32);
        return 1.f / sqrtf(ss * (1.f / 64.f) + EPS);
    }
    __device__ __forceinline__ bool operator()(f32x4 (&acc)[2][2][4][2], const Unit& u, int wr, int wc, int fr_, int fq_) const {
        int fr = fr_, fq = fq_; asm volatile("" : "+v"(fr), "+v"(fq));
        const int row0 = u.pm * BM + wr * 64 + fr, pn = u.pn;
        if (pn < 5) { const bool isq = pn < 4; const float* nw = (isq ? P.in[I_SQN] : P.in[I_SKN]) + j * 64 + 8 * fq;
            bf16* dst = isq ? WSP(bf16, W_Q) + (size_t)row0 * D + (pn * 4 + wc) * 64 + 8 * fq : WSP(bf16, W_K) + (size_t)row0 * 256 + wc * 64 + 8 * fq; const size_t ld = isq ? D : 256;
            const float sc = isq ? 0.18033688011112042f   : 1.f;
            const f32x4 w00 = *(const f32x4*)(nw), w01 = *(const f32x4*)(nw + 4), w10 = *(const f32x4*)(nw + 32), w11 = *(const f32x4*)(nw + 36);
#pragma unroll
            for (int ai = 0; ai < 2; ++ai)
#pragma unroll
                for (int m = 0; m < 4; ++m) { const float rs = rownorm(acc, ai, m) * sc; bf16* qp = dst + (size_t)(ai * HALF + m * 16) * ld;
                    *(u32x4e*)(qp) = pk8(acc[ai][0][m][0] * w00 * rs, acc[ai][0][m][1] * w01 * rs);
                    *(u32x4e*)(qp + 32) = pk8(acc[ai][1][m][0] * w10 * rs, acc[ai][1][m][1] * w11 * rs); }
        } else if (pn == 5) { bf16* VT = WSP(bf16, W_VT) + (size_t)(wc * 64 + 8 * fq) * MPAD + row0;
#pragma unroll
            for (int ai = 0; ai < 2; ++ai)
#pragma unroll
                for (int m = 0; m < 4; ++m) {
#pragma unroll
                    for (int bj = 0; bj < 2; ++bj)
#pragma unroll
                        for (int n = 0; n < 2; ++n) { const f32x4 v = acc[ai][bj][m][n]; const int dd = 32 * bj + 4 * n;
#pragma unroll
                            for (int e = 0; e < 4; ++e) VT[(size_t)(dd + e) * MPAD + ai * HALF + m * 16] = f2bf(v[e]); } }
        } else { bf16* GS = WSP(bf16, W_GS) + (size_t)row0 * D + (pn - 6) * 256 + wc * 64 + 8 * fq;
#pragma unroll
            for (int ai = 0; ai < 2; ++ai)
#pragma unroll
                for (int m = 0; m < 4; ++m) { bf16* gp = GS + (size_t)(ai * HALF + m * 16) * D;
#pragma unroll
                    for (int bj = 0; bj < 2; ++bj) { f32x4 v0, v1;
#pragma unroll
                        for (int e = 0; e < 4; ++e) { v0[e] = silu_fast(acc[ai][bj][m][0][e]); v1[e] = silu_fast(acc[ai][bj][m][1][e]); }
                        *(u32x4e*)(gp + 32 * bj) = pk8(v0, v1); } }
        }
        return false;
    }
};
struct EpiMlIn {
    static constexpr bool PERM = true;
    Params P; int j;
    __device__ __forceinline__ bool operator()(f32x4 (&acc)[2][2][4][2], const Unit& u, int wr, int wc, int fr_, int fq_) const {
        int fr = fr_, fq = fq_; asm volatile("" : "+v"(fr), "+v"(fq));
        const int row0 = u.pm * BM + wr * 64 + fr, pn = u.pn, kind = pn >> 3, col0 = (pn & 7) * BM + wc * 32 + 8 * fq;
        bf16* dst = kind == 0 ? WSP(bf16, W_XM) : kind == 1 ? WSP(bf16, W_ZS) : WSP(bf16, W_OS);
#pragma unroll
        for (int ai = 0; ai < 2; ++ai)
#pragma unroll
            for (int m = 0; m < 4; ++m) { const int row = row0 + ai * HALF + m * 16; bf16* dp = dst + (size_t)row * MI + col0;
                float* op = nullptr;
                if (kind == 0) { if (row < NP) { const int b = row / SEQ, t = row % SEQ; if (t >= SEQ - 3) op = P.out + O_PCONV + (((size_t)j * BATCH + b) * 3 + (t - (SEQ - 3))) * 2048 + col0; }
                    else if (row >= ROW_SAMP && row < NROWS) { const int bs = (row - ROW_SAMP) / TS, t = (row - ROW_SAMP) % TS; if (t >= 1) op = P.out + O_SCONV + (((size_t)j * DECB + bs) * 3 + (t - 1)) * 2048 + col0; } }
#pragma unroll
                for (int bj = 0; bj < 2; ++bj) { const f32x4 x0 = acc[ai][bj][m][0], x1 = acc[ai][bj][m][1]; f32x4 v0 = x0, v1 = x1;
                    if (kind == 1) {
#pragma unroll
                        for (int e = 0; e < 4; ++e) { v0[e] = silu_fast(x0[e]); v1[e] = silu_fast(x1[e]); } }
                    if (kind == 2) {
#pragma unroll
                        for (int e = 0; e < 4; ++e) { v0[e] = sigm_fast(x0[e]); v1[e] = sigm_fast(x1[e]); } }
                    *(u32x4e*)(dp + bj * HALF) = pk8(v0, v1);
                    if (op) { *(f32x4*)(op + bj * HALF) = x0; *(f32x4*)(op + bj * HALF + 4) = x1; } } }
        return false;
    }
};
struct EpiM3 {
    static constexpr bool PERM = true;
    Params P;
    __device__ __forceinline__ bool operator()(f32x4 (&acc)[2][2][4][2], const Unit& u, int wr, int wc, int fr_, int fq_) const {
        int fr = fr_, fq = fq_; asm volatile("" : "+v"(fr), "+v"(fq));
        const int kind = u.aux >> 2, h = u.aux & 3;
        bf16* C; size_t ldc;
        if (kind == 0) { C = WSP(bf16, W_MQ) + h * 512; ldc = MI; } else if (kind == 1) { C = WSP(bf16, W_MK) + h * 512; ldc = MI; }
        else if (kind == 2) { C = WSP(bf16, W_MKT) + (size_t)h * 512 * MPAD; ldc = MPAD; } else { C = WSP(bf16, W_MVT) + (size_t)u.pn * 512 * 2048 + h * 512; ldc = 2048; }
        const int row0 = u.pm * BM + wr * 64 + fr, col0 = (kind == 3 ? 0 : u.pn * BM) + wc * 32 + 8 * fq;
#pragma unroll
        for (int ai = 0; ai < 2; ++ai)
#pragma unroll
            for (int m = 0; m < 4; ++m) { bf16* dp = C + (size_t)(row0 + ai * HALF + m * 16) * ldc + col0;
#pragma unroll
                for (int bj = 0; bj < 2; ++bj) *(u32x4e*)(dp + bj * HALF) = pk8(acc[ai][bj][m][0], acc[ai][bj][m][1]); }
        return false;
    }
};
struct M3Order {
    const char* XC; const char* XM; const char* W; int ntt, Gp, c, kmode;
    __device__ __forceinline__ bool next(int i, Unit& u) const {
        const int x = c & 7, r = c >> 3, nx = (Gp - x + 7) >> 3, id = i * nx + r;
        if (id >= ntt * 3) return false;
        const int tt = id / 3, kk = id - 3 * tt, kind = kk == 2 ? 3 : kk;
        const int h = x >> 1, half = x & 1;
        const char* act = (kind == 3 ? XM : XC) + ((size_t)tt * 256 * MI + h * 512) * 2;
        const char* w = W + ((size_t)(kind == 0 ? 0 : kind == 3 ? 2 : 1) * 512 * MI + (size_t)half * 256 * MI + h * 512) * 2;
        u.aux = kind * 4 + h; u.nt = 8;
        if (kind < 2) { u.A = act; u.B = w; u.pm = tt; u.pn = half; } else { u.A = w; u.B = act; u.pm = half; u.pn = tt; }
        return true;
    }
};
struct EpiP {
    static constexpr bool PERM = true;
    Params P;
    __device__ __forceinline__ bool operator()(f32x4 (&acc)[2][2][4][2], const Unit& u, int wr, int wc, int fr_, int fq_) const {
        int fr = fr_, fq = fq_; asm volatile("" : "+v"(fr), "+v"(fq));
        const int h = u.aux, r0 = u.pm * BM; const float* SA = WSP(float, W_SA); const float* SCJ = WSP(float, W_SCJ); bf16* PB = WSP(bf16, W_P); float* DENI = WSP(float, W_DENI);
        float cj[2][2][4];
#pragma unroll
        for (int bj = 0; bj < 2; ++bj)
#pragma unroll
            for (int n = 0; n < 2; ++n)
#pragma unroll
                for (int e = 0; e < 4; ++e) cj[bj][n][e] = SCJ[(size_t)(r0 + bj * HALF + wc * 32 + 8 * fq + 4 * n + e) * 4 + h];
#pragma unroll
        for (int ai = 0; ai < 2; ++ai)
#pragma unroll
            for (int m = 0; m < 4; ++m) { const int tl = ai * HALF + wr * 64 + m * 16 + fr; const float at = SA[(size_t)(r0 + tl) * 4 + h]; float s = 0.f;
                bf16* pp = PB + (size_t)(r0 + tl) * 2048 + h * 512 + wc * 32 + 8 * fq;
#pragma unroll
                for (int bj = 0; bj < 2; ++bj) { f32x4 v[2];
#pragma unroll
                    for (int n = 0; n < 2; ++n) { const int j0 = bj * HALF + wc * 32 + 8 * fq + 4 * n;
#pragma unroll
                        for (int e = 0; e < 4; ++e) { v[n][e] = (j0 + e <= tl) ? acc[ai][bj][m][n][e] * __expf(at + cj[bj][n][e]) : 0.f; s += v[n][e]; } }
                    *(u32x4e*)(pp + bj * HALF) = pk8(v[0], v[1]); }
                s += __shfl_xor(s, 16); s += __shfl_xor(s, 32);
                if (fq == 0) DENI[((size_t)(r0 + tl) * 4 + h) * 4 + wc] = s; }
        return false;
    }
};
struct POrder {
    const char* Q; const char* K; int nwg, G, c;
    __device__ __forceinline__ bool next(int i, Unit& u) const {
        const long L = (long)i * G + c; if (L >= nwg) return false;
        const int tt = (int)L >> 2, h = (int)L & 3; const size_t off = ((size_t)tt * 256 * MI + h * 512) * 2;
        u.A = Q + off; u.B = K + off; u.pm = tt; u.pn = 0; u.aux = h; u.nt = 8; return true;
    }
};
struct EpiNum {
    static constexpr bool PERM = true;
    Params P;
    __device__ __forceinline__ bool operator()(f32x4 (&acc)[2][2][4][2], const Unit& u, int wr, int wc, int fr_, int fq_) const {
        int fr = fr_, fq = fq_; asm volatile("" : "+v"(fr), "+v"(fq));
        const int h = u.aux >> 1, seg = u.aux & 1, row0 = u.pm * BM + wr * 64 + fr;
        if (seg == 0) { const float* SWI = WSP(float, W_SWI);
#pragma unroll
            for (int ai = 0; ai < 2; ++ai)
#pragma unroll
                for (int m = 0; m < 4; ++m) { const float wi = SWI[(size_t)(row0 + ai * HALF + m * 16) * 4 + h];
#pragma unroll
                    for (int bj = 0; bj < 2; ++bj)
#pragma unroll
                        for (int n = 0; n < 2; ++n) acc[ai][bj][m][n] *= wi; }
            return true;
        }
        const float* DEN = WSP(float, W_DEN); const float* SEM = WSP(float, W_SEM); bf16* H = WSP(bf16, W_H) + h * 512 + u.pn * BM + wc * 32 + 8 * fq;
#pragma unroll
        for (int ai = 0; ai < 2; ++ai)
#pragma unroll
            for (int m = 0; m < 4; ++m) { const size_t row = row0 + ai * HALF + m * 16; const float inv = 1.f / fmaxf(fabsf(DEN[row * 4 + h]), SEM[row * 4 + h]); bf16* hp = H + row * MI;
#pragma unroll
                for (int bj = 0; bj < 2; ++bj) *(u32x4e*)(hp + bj * HALF) = pk8(acc[ai][bj][m][0] * inv, acc[ai][bj][m][1] * inv); }
        return false;
    }
};
struct NumOrder {
    const char* Q; const char* PB; const char* CT; const char* VT; int njob, G, c;
    __device__ __forceinline__ int job(int k) const { const long L = (long)k * G + c; if (L >= njob) return -1; int id = (int)L; { const int q = njob / 8, r = njob % 8, xcd = id % 8, off = id / 8; id = (xcd < r ? xcd * (q + 1) : r * (q + 1) + (xcd - r) * q) + off; } return id; }
    __device__ __forceinline__ bool next(int i, Unit& u) const {
        const int id = job(i >> 2); if (id < 0) return false;
        const int tt = id >> 2, h = id & 3, half = (i >> 1) & 1, seg = i & 1;
        const int b = tt / (SEQ / 256), c1 = tt % (SEQ / 256) + 1;
        u.pm = tt; u.pn = half; u.aux = h * 2 + seg;
        if (seg == 0) { u.A = Q + ((size_t)tt * 256 * MI + h * 512) * 2; u.B = CT + ctb_idx(c1, b, h, half * 256, 0) * 2; u.nt = 8; }
        else { u.A = PB + ((size_t)tt * 256 * 2048 + h * 512) * 2; u.B = VT + (((size_t)tt * 512 + half * 256) * 2048 + h * 512) * 2; u.nt = 4; }
        return true;
    }
};
}
__device__ __forceinline__ void ph_den_fast(const Params& P, int gw, int ngw, int lane) {
    const bf16* Q = WSP(bf16, W_MQ); const float* NST = WSP(float, W_NST); const float* SWI = WSP(float, W_SWI); const float* DENI = WSP(float, W_DENI); float* DEN = WSP(float, W_DEN);
    const int h = lane >> 4, sub = lane & 15;
    for (int r = gw; r < NP; r += ngw) { const int b = r / SEQ, c = (r % SEQ) / LCH + 1;
        const bf16* q = Q + (size_t)r * MI + h * 512 + sub * 32; const float* n = NST + ((size_t)(b * 4 + h) * NCH + c) * 512 + sub * 32; float a = 0.f;
#pragma unroll
        for (int k = 0; k < 32; k += 8) { const pg8::bf16x8 qv = *(const pg8::bf16x8*)(q + k);
#pragma unroll
            for (int e = 0; e < 8; ++e) a += bf2f((bf16)qv[e]) * n[k + e]; }
        a += __shfl_xor(a, 1); a += __shfl_xor(a, 2); a += __shfl_xor(a, 4); a += __shfl_xor(a, 8);
        if (sub == 0) { const float* dp = DENI + ((size_t)r * 4 + h) * 4; DEN[(size_t)r * 4 + h] = (dp[0] + dp[1]) + (dp[2] + dp[3]) + SWI[(size_t)r * 4 + h] * a; } }
}

namespace st {
typedef short bf16x8 __attribute__((ext_vector_type(8)));
typedef float f32x16 __attribute__((ext_vector_type(16)));
typedef float f32x4 __attribute__((ext_vector_type(4)));
typedef unsigned u32x2 __attribute__((ext_vector_type(2)));
typedef unsigned u32x4 __attribute__((ext_vector_type(4)));
__device__ __forceinline__ bf16x8 scale8(bf16x8 v, const LAS float* w) {
    const f32x4 w0 = *(const LAS f32x4*)w, w1 = *(const LAS f32x4*)(w + 4);
    const u32x4 u = __builtin_bit_cast(u32x4, v); u32x4 r;
    r[0] = pg8::cvt_pk_bf16(__uint_as_float(u[0] << 16) * w0[0], __uint_as_float(u[0] & 0xffff0000u) * w0[1]);
    r[1] = pg8::cvt_pk_bf16(__uint_as_float(u[1] << 16) * w0[2], __uint_as_float(u[1] & 0xffff0000u) * w0[3]);
    r[2] = pg8::cvt_pk_bf16(__uint_as_float(u[2] << 16) * w1[0], __uint_as_float(u[2] & 0xffff0000u) * w1[1]);
    r[3] = pg8::cvt_pk_bf16(__uint_as_float(u[3] << 16) * w1[2], __uint_as_float(u[3] & 0xffff0000u) * w1[3]);
    return __builtin_bit_cast(bf16x8, r);
}
constexpr int ST_STAGE = 65536, ST_WK_OFF = 131072 + 1024;
__device__ __forceinline__ unsigned kkey(unsigned row) { return ((row & 3u) << 2) | ((row >> 2) & 3u); }
__device__ __forceinline__ void st_issue(LAS unsigned char* lds, int buf, const char* kbase, const char* vbase, int wave, int lane) {
    const int rsub = lane >> 4, q = lane & 15;
#pragma unroll
    for (int i = 0; i < 4; ++i) { const int row = wave * 16 + i * 4 + rsub;
        __builtin_amdgcn_global_load_lds((const unsigned*)(kbase + (size_t)row * 4096 + 16 * (q ^ kkey(row))), (LAS unsigned*)(lds + buf * ST_STAGE + (wave * 16 + i * 4) * 256), 16, 0, 0);
        __builtin_amdgcn_global_load_lds((const unsigned*)(vbase + (size_t)row * 4096 + 16 * (q ^ (row & 15))), (LAS unsigned*)(lds + buf * ST_STAGE + 32768 + (wave * 16 + i * 4) * 256), 16, 0, 0); }
}
typedef unsigned short u16x4 __attribute__((ext_vector_type(4)));
__device__ __forceinline__ void state_scan(const Params& P, int j, LAS unsigned char* lds, int w, int tid_) {
    int tid = tid_; asm volatile("" : "+v"(tid));
    const int bh = w >> 4, b = bh >> 2, h = bh & 3, dg = (w >> 2) & 3, eg = w & 3;
    const int wave = __builtin_amdgcn_readfirstlane(tid >> 6), lane = tid & 63, l32 = lane & 31, lh = lane >> 5;
    const int dt = wave >> 1, et = (wave & 1) * 2;
    const int dbase = dg * 128 + dt * 32, ebase = eg * 128 + et * 32;
    const bool do_n = (eg == 0) && ((wave & 1) == 0);
    const bf16* MK = WSP(bf16, W_MK); const bf16* VT = WSP(bf16, W_MVT); const float* SWK = WSP(float, W_SWK); const float* DEC = WSP(float, W_DEC);
    bf16* CT = WSP(bf16, W_CT); float* NST = WSP(float, W_NST);
    LAS float* wk = (LAS float*)(lds + ST_WK_OFF);
    f32x16 acc0, acc1, accn;
#pragma unroll
    for (int i = 0; i < 16; ++i) { acc0[i] = 0.f; acc1[i] = 0.f; accn[i] = 0.f; }
    u32x4 onesu; onesu[0] = onesu[1] = onesu[2] = onesu[3] = 0x3f803f80u; const bf16x8 ones = __builtin_bit_cast(bf16x8, onesu);
    {   const int row0 = ROW_META + b * NMETA;
        if (tid < NMETA) wk[tid] = SWK[(size_t)(row0 + tid) * 4 + h];
        __syncthreads();
        if (do_n && l32 == 0) {
#pragma unroll
            for (int i = 0; i < 16; ++i) NST[((size_t)bh * NCH + 0) * 512 + dbase + 8 * (i >> 2) + 4 * lh + (i & 3)] = 0.f; }
        u32x4 au;
#pragma unroll
        for (int i = 0; i < 4; ++i) { const unsigned lo = MK[(size_t)(row0 + 8 * lh + 2 * i) * MI + h * 512 + dbase + l32], hi = MK[(size_t)(row0 + 8 * lh + 2 * i + 1) * MI + h * 512 + dbase + l32]; au[i] = lo | (hi << 16); }
        const bf16x8 a = scale8(__builtin_bit_cast(bf16x8, au), wk + 8 * lh);
        const bf16* v0 = VT + vtb_idx(row0, h, ebase + l32) + 8 * lh;
        const bf16x8 b0 = *(const bf16x8*)v0, b1 = *(const bf16x8*)(v0 + (size_t)32 * 2048);
        acc0 = __builtin_amdgcn_mfma_f32_32x32x16_bf16(a, b0, acc0, 0, 0, 0); acc1 = __builtin_amdgcn_mfma_f32_32x32x16_bf16(a, b1, acc1, 0, 0, 0);
        if (do_n) accn = __builtin_amdgcn_mfma_f32_32x32x16_bf16(a, ones, accn, 0, 0, 0);
    }
    const int row1 = b * SEQ;
    const char* kcol = (const char*)(MK + h * 512 + dg * 128);
    st_issue(lds, 0, kcol + (size_t)row1 * 4096, (const char*)(VT + vtb_idx(row1, h, eg * 128)), wave, lane);
    unsigned tra[2];
    { const unsigned hh = lane >> 5, blk = (lane >> 4) & 1, q = (lane & 15) >> 2, p = lane & 3;
#pragma unroll
      for (unsigned t = 0; t < 2; ++t) { const unsigned row = 8 * hh + 4 * t + q, ch = 4 * dt + 2 * blk + (p >> 1); tra[t] = 256u * row + 16u * (ch ^ kkey(row)) + 8u * (p & 1); } }
    for (int sidx = 0; sidx < 2 * (NCH - 1); ++sidx) {
        const int c = 1 + (sidx >> 1), half = sidx & 1, row0 = row1 + (c - 1) * LCH, buf = sidx & 1;
        LAS float* wkc = wk + (c & 1) * 256;
        float dec = 1.f;
        if (half == 0) { if (tid < LCH) wkc[tid] = SWK[(size_t)(row0 + tid) * 4 + h]; dec = DEC[(size_t)bh * NCH + c]; }
        asm volatile("s_waitcnt vmcnt(0)" ::: "memory");
        __syncthreads();
        if (sidx + 1 < 2 * (NCH - 1)) { const int tok = row1 + (sidx + 1) * 128;
            st_issue(lds, buf ^ 1, kcol + (size_t)tok * 4096, (const char*)(VT + vtb_idx(tok, h, eg * 128)), wave, lane); }
        if (half == 0) {
#pragma unroll
            for (int g = 0; g < 4; ++g) { u32x2 p0, p1;
                p0.x = pg8::cvt_pk_bf16(acc0[4 * g], acc0[4 * g + 1]); p0.y = pg8::cvt_pk_bf16(acc0[4 * g + 2], acc0[4 * g + 3]);
                p1.x = pg8::cvt_pk_bf16(acc1[4 * g], acc1[4 * g + 1]); p1.y = pg8::cvt_pk_bf16(acc1[4 * g + 2], acc1[4 * g + 3]);
                *(u32x2*)(CT + ctb_idx(c, b, h, ebase + l32, dbase + 8 * g + 4 * lh)) = p0;
                *(u32x2*)(CT + ctb_idx(c, b, h, ebase + 32 + l32, dbase + 8 * g + 4 * lh)) = p1; }
            if (do_n && l32 == 0) {
#pragma unroll
                for (int i = 0; i < 16; ++i) NST[((size_t)bh * NCH + c) * 512 + dbase + 8 * (i >> 2) + 4 * lh + (i & 3)] = accn[i]; }
#pragma unroll
            for (int i = 0; i < 16; ++i) { acc0[i] *= dec; acc1[i] *= dec; accn[i] *= dec; }
        }
        u16x4 kt0[8], kt1[8];
        { const unsigned a0 = (unsigned)(buf * ST_STAGE) + tra[0], a1 = (unsigned)(buf * ST_STAGE) + tra[1];
          asm volatile(
            "ds_read_b64_tr_b16 %0, %16\n\tds_read_b64_tr_b16 %1, %17\n\tds_read_b64_tr_b16 %2, %16 offset:4096\n\tds_read_b64_tr_b16 %3, %17 offset:4096\n\t"
            "ds_read_b64_tr_b16 %4, %16 offset:8192\n\tds_read_b64_tr_b16 %5, %17 offset:8192\n\tds_read_b64_tr_b16 %6, %16 offset:12288\n\tds_read_b64_tr_b16 %7, %17 offset:12288\n\t"
            "ds_read_b64_tr_b16 %8, %16 offset:16384\n\tds_read_b64_tr_b16 %9, %17 offset:16384\n\tds_read_b64_tr_b16 %10, %16 offset:20480\n\tds_read_b64_tr_b16 %11, %17 offset:20480\n\t"
            "ds_read_b64_tr_b16 %12, %16 offset:24576\n\tds_read_b64_tr_b16 %13, %17 offset:24576\n\tds_read_b64_tr_b16 %14, %16 offset:28672\n\tds_read_b64_tr_b16 %15, %17 offset:28672\n\t"
            "s_waitcnt lgkmcnt(0)"
            : "=&v"(kt0[0]), "=&v"(kt1[0]), "=&v"(kt0[1]), "=&v"(kt1[1]), "=&v"(kt0[2]), "=&v"(kt1[2]), "=&v"(kt0[3]), "=&v"(kt1[3]),
              "=&v"(kt0[4]), "=&v"(kt1[4]), "=&v"(kt0[5]), "=&v"(kt1[5]), "=&v"(kt0[6]), "=&v"(kt1[6]), "=&v"(kt0[7]), "=&v"(kt1[7])
            : "v"(a0), "v"(a1) : "memory"); }
        const LAS unsigned char* v0 = lds + buf * ST_STAGE + 32768 + (et * 32 + l32) * 256; const LAS unsigned char* v1 = v0 + 32 * 256;
        const int sw = l32 & 15;
#pragma unroll
        for (int s = 0; s < 8; ++s) { const int slot = ((2 * s + lh) ^ sw) * 16;
            u32x4 au; { const u32x2 x0 = __builtin_bit_cast(u32x2, kt0[s]), x1 = __builtin_bit_cast(u32x2, kt1[s]); au[0] = x0.x; au[1] = x0.y; au[2] = x1.x; au[3] = x1.y; }
            const bf16x8 a = scale8(__builtin_bit_cast(bf16x8, au), wkc + half * 128 + s * 16 + 8 * lh);
            const bf16x8 b0 = *(const LAS bf16x8*)(v0 + slot), b1 = *(const LAS bf16x8*)(v1 + slot);
            acc0 = __builtin_amdgcn_mfma_f32_32x32x16_bf16(a, b0, acc0, 0, 0, 0);
            acc1 = __builtin_amdgcn_mfma_f32_32x32x16_bf16(a, b1, acc1, 0, 0, 0);
            if (do_n) accn = __builtin_amdgcn_mfma_f32_32x32x16_bf16(a, ones, accn, 0, 0, 0); }
    }
    float* oc = P.out + O_PC + ((size_t)j * BATCH * 4 + bh) * 512 * 512;
#pragma unroll
    for (int i = 0; i < 16; ++i) { const int d = dbase + 8 * (i >> 2) + 4 * lh + (i & 3); oc[(size_t)d * 512 + ebase + l32] = acc0[i]; oc[(size_t)d * 512 + ebase + 32 + l32] = acc1[i]; }
    if (do_n && l32 == 0) {
#pragma unroll
        for (int i = 0; i < 16; ++i) P.out[O_PN + ((size_t)j * BATCH * 4 + bh) * 512 + dbase + 8 * (i >> 2) + 4 * lh + (i & 3)] = accn[i]; }
    __syncthreads();
}
}
namespace at {
typedef short bf16x8 __attribute__((ext_vector_type(8)));
typedef float f32x16 __attribute__((ext_vector_type(16)));
typedef unsigned u32x2 __attribute__((ext_vector_type(2)));
typedef unsigned u32x4 __attribute__((ext_vector_type(4)));
constexpr int NI_P = (NP / 32) * 16, NI_M = BATCH * 16, NI_S = DECB * 4, NI = NI_P + NI_M + NI_S;
struct TileSrc { const bf16* k; const bf16* v; int vstride, kbase, thr, off, nval; };
__device__ __forceinline__ void att_phase(const Params& P, int j, LAS unsigned char* lds, int gw, int ngw, int tid_) {
    int tid = tid_; asm volatile("" : "+v"(tid));
    gw = __builtin_amdgcn_readfirstlane(gw);
    const int lane = tid & 63, l32 = lane & 31, lh = lane >> 5;
    LAS float* bt = (LAS float*)lds;
    LAS unsigned char* wl = lds + 16384 + ((tid >> 6) & 7) * 8192;
    { const float* BT = WSP(float, W_BIAS); for (int i = tid; i < 16 * 132; i += 512) bt[i] = BT[i] * 1.4426950408889634f; }
    __syncthreads();
    const bf16* Q = WSP(bf16, W_Q); const bf16* K = WSP(bf16, W_K); const bf16* VT = WSP(bf16, W_VT); const bf16* GS = WSP(bf16, W_GS); bf16* OG = WSP(bf16, W_OG);
    const bf16* KC = WSP(bf16, W_KC) + (size_t)j * DECB * KCN * 256; const bf16* VTC = WSP(bf16, W_VTC) + (size_t)j * DECB * 256 * KCN;
    const float* sinks = P.in[I_SSINK] + j * 16;
    for (int item = gw; item < NI; item += ngw) {
        int kind, b = 0, t0 = 0, bs = 0, h0, nq, pmask, hshift, qrow0, qpos0, ti0 = 0, ti1;
        if (item < NI_P) { kind = 0; const int qb = item >> 4; h0 = item & 15; qrow0 = qb * 32; b = qrow0 / SEQ; t0 = qrow0 % SEQ; nq = 32; pmask = 31; hshift = 5; qpos0 = 16 + t0; ti1 = 6; }
        else if (item < NI_P + NI_M) { kind = 1; const int i2 = item - NI_P; b = i2 >> 4; h0 = i2 & 15; qrow0 = ROW_META + b * NMETA; nq = 16; pmask = 15; hshift = 5; qpos0 = 0; ti1 = 1; }
        else { kind = 2; const int i3 = item - NI_P - NI_M; bs = i3 >> 2; h0 = (i3 & 3) * 4; qrow0 = ROW_SAMP + bs * TS; nq = 16; pmask = 3; hshift = 2; qpos0 = PAST; ti1 = 6; }
        const int kvh = h0 >> 2;
        const int cq = l32 < nq ? l32 : (l32 & (nq - 1));
        const int qrow = qrow0 + (cq & pmask), qhead = h0 + (cq >> hshift), qpos = qpos0 + (cq & pmask);
        auto tile_src = [&](int ti) -> TileSrc { TileSrc s;
            if (kind == 2) { if (ti < 5) { s.k = KC + ((size_t)bs * KCN + 32 * ti) * 256 + kvh * 64; s.v = VTC + ((size_t)bs * 256 + kvh * 64) * KCN + 32 * ti; s.vstride = KCN; s.kbase = 32 * ti; s.thr = 16; s.off = PAST - 128 - 16; s.nval = 144; }
                             else { s.k = K + (size_t)qrow0 * 256 + kvh * 64; s.v = VT + (size_t)(kvh * 64) * MPAD + qrow0; s.vstride = MPAD; s.kbase = PAST; s.thr = 0x7fffffff; s.off = 0; s.nval = PAST + TS; } }
            else if (ti == 0) { const int r = ROW_META + b * NMETA; s.k = K + (size_t)r * 256 + kvh * 64; s.v = VT + (size_t)(kvh * 64) * MPAD + r; s.vstride = MPAD; s.kbase = 0; s.thr = 0x7fffffff; s.off = 0; s.nval = 16; }
            else { const int tk0 = t0 - 128 + 32 * (ti - 1), r = b * SEQ + tk0; s.k = K + (size_t)r * 256 + kvh * 64; s.v = VT + (size_t)(kvh * 64) * MPAD + r; s.vstride = MPAD; s.kbase = 16 + tk0; s.thr = 0x7fffffff; s.off = 0; s.nval = 0x7fffffff; }
            return s; };
        auto next_ti = [&](int ti) -> int { int n = ti + 1; if (kind == 0 && ti == 0 && t0 < 128) n = 1 + (128 - t0) / 32; return n; };
        bf16x8 qf[4];
        { const bf16* qp = Q + (size_t)qrow * D + qhead * 64 + 8 * lh;
#pragma unroll
          for (int s = 0; s < 4; ++s) qf[s] = *(const bf16x8*)(qp + 16 * s); }
        const LAS float* bth = bt + qhead * 132;
        float m = sinks[qhead] * 1.4426950408889634f, l = 1.f;
        f32x16 o0, o1;
#pragma unroll
        for (int i = 0; i < 16; ++i) { o0[i] = 0.f; o1[i] = 0.f; }
        bf16x8 kr[4], vr[4];
        int ti = ti0; TileSrc cur = tile_src(ti);
        auto load_tile = [&](const TileSrc& s) {
            const bf16* kp = s.k + (size_t)(lane >> 3) * 256 + 8 * (lane & 7);
#pragma unroll
            for (int q = 0; q < 4; ++q) kr[q] = *(const bf16x8*)(kp + (size_t)q * 8 * 256);
            const bf16* vp = s.v + (size_t)(lane >> 2) * s.vstride + 8 * (lane & 3);
#pragma unroll
            for (int q = 0; q < 4; ++q) vr[q] = *(const bf16x8*)(vp + (size_t)q * 16 * s.vstride); };
        load_tile(cur);
        while (ti < ti1) {
#pragma unroll
            for (int q = 0; q < 4; ++q) { const int row = 8 * q + (lane >> 3); *(LAS bf16x8*)(wl + row * 128 + 16 * ((lane & 7) ^ ((row >> 1) & 7))) = kr[q]; }
#pragma unroll
            for (int q = 0; q < 4; ++q) { const int row = 16 * q + (lane >> 2); *(LAS bf16x8*)(wl + 4096 + row * 64 + 16 * ((lane & 3) ^ ((row >> 2) & 3))) = vr[q]; }
            const TileSrc me = cur;
            const int tn = next_ti(ti);
            if (tn < ti1) { cur = tile_src(tn); load_tile(cur); }
            bf16x8 kf[4];
#pragma unroll
            for (int s = 0; s < 4; ++s) kf[s] = *(const LAS bf16x8*)(wl + l32 * 128 + 16 * ((2 * s + lh) ^ ((l32 >> 1) & 7)));
            f32x16 sT;
#pragma unroll
            for (int i = 0; i < 16; ++i) sT[i] = 0.f;
#pragma unroll
            for (int s = 0; s < 4; ++s) sT = __builtin_amdgcn_mfma_f32_32x32x16_bf16(kf[s], qf[s], sT, 0, 0, 0);
            bf16x8 va[2][2];
#pragma unroll
            for (int dt = 0; dt < 2; ++dt)
#pragma unroll
                for (int s = 0; s < 2; ++s) { const int row = dt * 32 + l32, key = (row >> 2) & 3; const LAS unsigned char* rp = wl + 4096 + row * 64 + 8 * lh;
                    const u32x2 p0 = *(const LAS u32x2*)(rp + 16 * ((2 * s) ^ key)), p1 = *(const LAS u32x2*)(rp + 16 * ((2 * s + 1) ^ key));
                    u32x4 t; t[0] = p0.x; t[1] = p0.y; t[2] = p1.x; t[3] = p1.y; va[dt][s] = __builtin_bit_cast(bf16x8, t); }
            float mx = m;
            if (kind == 0 && ti >= 2 && ti <= 4) {
                const LAS float* bq = bth + (qpos - me.kbase - 31);
#pragma unroll
                for (int i = 0; i < 16; ++i) { const int kk = 8 * (i >> 2) + 4 * lh + (i & 3); const float sv = sT[i] + bq[31 - kk]; sT[i] = sv; mx = fmaxf(mx, sv); }
            } else {
#pragma unroll
                for (int i = 0; i < 16; ++i) { const int kk = 8 * (i >> 2) + 4 * lh + (i & 3), kg = me.kbase + kk, pos = kg + (kg >= me.thr ? me.off : 0), dist = qpos - pos;
                    const bool vis = (kg < me.nval) && (dist >= 0) && (dist <= 128 || pos < 16);
                    const int di = dist < 0 ? 0 : (dist > 128 ? 128 : dist);
                    const float sv = vis ? sT[i] + bth[di] : -3.0e38f; sT[i] = sv; mx = fmaxf(mx, sv); }
            }
            mx = fmaxf(mx, __shfl_xor(mx, 32));
            float ps = 0.f;
#pragma unroll
            for (int i = 0; i < 16; ++i) { const float p = __builtin_amdgcn_exp2f(sT[i] - mx); sT[i] = p; ps += p; }
            ps += __shfl_xor(ps, 32);
            if (__any(mx > m)) {
                const float corr = __builtin_amdgcn_exp2f(m - mx); m = mx; l *= corr;
#pragma unroll
                for (int i = 0; i < 16; ++i) { o0[i] *= corr; o1[i] *= corr; } }
            l += ps;
#pragma unroll
            for (int s = 0; s < 2; ++s) { u32x4 pk;
#pragma unroll
                for (int q = 0; q < 4; ++q) pk[q] = pg8::cvt_pk_bf16(sT[8 * s + 2 * q], sT[8 * s + 2 * q + 1]);
                const bf16x8 pb = __builtin_bit_cast(bf16x8, pk);
                o0 = __builtin_amdgcn_mfma_f32_32x32x16_bf16(va[0][s], pb, o0, 0, 0, 0);
                o1 = __builtin_amdgcn_mfma_f32_32x32x16_bf16(va[1][s], pb, o1, 0, 0, 0); }
            ti = tn;
        }
        if (l32 < nq) { const float inv = 1.f / l; const size_t ob = (size_t)qrow * D + qhead * 64 + 4 * lh;
#pragma unroll
            for (int g = 0; g < 4; ++g) {
                { const u32x2 gv = *(const u32x2*)(GS + ob + 8 * g); u32x2 w;
                  w.x = pg8::cvt_pk_bf16(o0[4 * g] * inv * __uint_as_float(gv.x << 16), o0[4 * g + 1] * inv * __uint_as_float(gv.x & 0xffff0000u));
                  w.y = pg8::cvt_pk_bf16(o0[4 * g + 2] * inv * __uint_as_float(gv.y << 16), o0[4 * g + 3] * inv * __uint_as_float(gv.y & 0xffff0000u)); *(u32x2*)(OG + ob + 8 * g) = w; }
                { const u32x2 gv = *(const u32x2*)(GS + ob + 32 + 8 * g); u32x2 w;
                  w.x = pg8::cvt_pk_bf16(o1[4 * g] * inv * __uint_as_float(gv.x << 16), o1[4 * g + 1] * inv * __uint_as_float(gv.x & 0xffff0000u));
                  w.y = pg8::cvt_pk_bf16(o1[4 * g + 2] * inv * __uint_as_float(gv.y << 16), o1[4 * g + 3] * inv * __uint_as_float(gv.y & 0xffff0000u)); *(u32x2*)(OG + ob + 32 + 8 * g) = w; } }
        }
    }
    __syncthreads();
}
}
namespace el {
__device__ __forceinline__ const float* lp(const float* p) { const float __attribute__((address_space(1)))* g = (const float __attribute__((address_space(1)))*)p; asm volatile("" : "+s"(g));
    return (const float*)g; }
typedef short bf16x8 __attribute__((ext_vector_type(8)));
typedef float f32x4 __attribute__((ext_vector_type(4)));
typedef unsigned u32x2 __attribute__((ext_vector_type(2)));
typedef unsigned u32x4 __attribute__((ext_vector_type(4)));
__device__ __forceinline__ float wsum(float v) {
#pragma unroll
    for (int o = 1; o < 64; o <<= 1) v += __shfl_xor(v, o);
    return v;
}
__device__ __forceinline__ void unpack8(bf16x8 v, float (&f)[8]) { const u32x4 u = __builtin_bit_cast(u32x4, v);
#pragma unroll
    for (int i = 0; i < 4; ++i) { f[2 * i] = __uint_as_float(u[i] << 16); f[2 * i + 1] = __uint_as_float(u[i] & 0xffff0000u); } }
__device__ __forceinline__ bf16x8 pack8(const float (&f)[8]) { u32x4 u;
#pragma unroll
    for (int i = 0; i < 4; ++i) u[i] = pg8::cvt_pk_bf16(f[2 * i], f[2 * i + 1]);
    return __builtin_bit_cast(bf16x8, u); }

__device__ __forceinline__ void norm_fast(const Params& P, int layer, int gw, int ngw, int lane) {
    float* X = WSP(float, W_X); const bf16* X16 = WSP(bf16, W_X16); bf16* XN = WSP(bf16, W_XN); const float* w = P.in[I_NORMW] + (size_t)layer * D;
    const float* xp_ = lp(P.in[I_XP]); const float* xm_ = lp(P.in[I_META]); const float* xs_ = lp(P.in[I_XS]);
    f32x4 wv[4];
#pragma unroll
    for (int k = 0; k < 4; ++k) wv[k] = *(const f32x4*)(w + 4 * lane + 256 * k);
    for (int r = gw; r < MPAD; r += ngw) {
        bf16* o = XN + (size_t)r * D + 4 * lane;
        if (r >= NROWS) {
#pragma unroll
            for (int k = 0; k < 4; ++k) *(u32x2*)(o + 256 * k) = (u32x2){0u, 0u};
            continue; }
        f32x4 v[4]; float s = 0.f;
        if (layer > 0 && r < NP) {
#pragma unroll
            for (int k = 0; k < 4; ++k) { const u32x2 t = *(const u32x2*)(X16 + (size_t)r * D + 4 * lane + 256 * k);
                v[k] = (f32x4){__uint_as_float(t.x << 16), __uint_as_float(t.x & 0xffff0000u), __uint_as_float(t.y << 16), __uint_as_float(t.y & 0xffff0000u)}; }
        } else { const float* src = X + (size_t)r * D;
            if (layer == 0) { if (r < NP) src = xp_ + (size_t)r * D; else if (r < ROW_SAMP) src = xm_ + (size_t)((r - ROW_META) % NMETA) * D; else src = xs_ + (size_t)(r - ROW_SAMP) * D; }
#pragma unroll
            for (int k = 0; k < 4; ++k) v[k] = *(const f32x4*)(src + 4 * lane + 256 * k); }
#pragma unroll
        for (int k = 0; k < 4; ++k) s += (v[k][0] * v[k][0] + v[k][1] * v[k][1]) + (v[k][2] * v[k][2] + v[k][3] * v[k][3]);
        const float rs = 1.f / sqrtf(wsum(s) * (1.f / D) + EPS);
#pragma unroll
        for (int k = 0; k < 4; ++k) { if (layer == 0 && r >= NP) *(f32x4*)(X + (size_t)r * D + 4 * lane + 256 * k) = v[k]; *(u32x2*)(o + 256 * k) = pg8::pk4(v[k] * wv[k] * rs); }
    }
}
__device__ __forceinline__ void convgates_fast(const Params& P, int j, LAS unsigned char* lds, int gw, int ngw, int lane, int tid) {
    const bf16* XM = WSP(bf16, W_XM); bf16* XC = WSP(bf16, W_XC); const float* G = WSP(float, W_G) + (size_t)j * 4096 * 8; float* GA = WSP(float, W_GATES);
    const float* cw = P.in[I_MCW] + (size_t)j * 4 * 2048; const float* cb = P.in[I_MCB] + (size_t)j * 2048;
    LAS float* Gt = (LAS float*)lds;
    for (int i = tid; i < 4096 * 2; i += 512) { const f32x4 v = *(const f32x4*)(G + (size_t)i * 4); const int c = i >> 1, g0 = (i & 1) * 4;
#pragma unroll
        for (int g = 0; g < 4; ++g) Gt[(g0 + g) * 4096 + c] = v[g]; }
    __syncthreads();
    for (int grp = gw; grp < MPAD / 4; grp += ngw) {
        const int r0 = grp * 4;
        if (r0 >= NROWS) { for (int t = 0; t < 4; ++t)
#pragma unroll
            for (int k = 0; k < 4; ++k) *(u32x4*)(XC + (size_t)(r0 + t) * MI + 8 * lane + 512 * k) = (u32x4){0u, 0u, 0u, 0u};
            continue; }
        int hmode, hrow = 0; const float* hs = nullptr;
        if (r0 < NP) { hmode = 1; const int t = r0 % SEQ; hrow = t > 0 ? r0 - 3 : ROW_META + (r0 / SEQ) * NMETA + NMETA - 3; }
        else if (r0 < ROW_SAMP) { const int i = (r0 - ROW_META) % NMETA; hmode = i > 0 ? 1 : 0; hrow = r0 - 3; }
        else { hmode = 2; hs = P.in[I_SCONV] + ((size_t)j * DECB + (r0 - ROW_SAMP) / TS) * 3 * 2048; }
        float ga[4][8];
#pragma unroll
        for (int t = 0; t < 4; ++t)
#pragma unroll
            for (int g = 0; g < 8; ++g) ga[t][g] = 0.f;
#pragma unroll 1
        for (int k = 0; k < 4; ++k) { const int c0 = 8 * lane + 512 * k;
            float x[7][8];
#pragma unroll
            for (int t = 0; t < 3; ++t) {
                if (hmode == 1) unpack8(*(const bf16x8*)(XM + (size_t)(hrow + t) * MI + c0), x[t]);
                else if (hmode == 2) { const f32x4 a = *(const f32x4*)(hs + (size_t)t * 2048 + c0), b = *(const f32x4*)(hs + (size_t)t * 2048 + c0 + 4);
#pragma unroll
                    for (int e = 0; e < 4; ++e) { x[t][e] = a[e]; x[t][4 + e] = b[e]; } }
                else {
#pragma unroll
                    for (int e = 0; e < 8; ++e) x[t][e] = 0.f; } }
#pragma unroll
            for (int t = 0; t < 4; ++t) unpack8(*(const bf16x8*)(XM + (size_t)(r0 + t) * MI + c0), x[3 + t]);
            float xc[4][8];
            { float wgt[5][8];
#pragma unroll
              for (int wv = 0; wv < 4; ++wv) { const f32x4 a = *(const f32x4*)(cw + (size_t)wv * 2048 + c0), b = *(const f32x4*)(cw + (size_t)wv * 2048 + c0 + 4);
#pragma unroll
                  for (int e = 0; e < 4; ++e) { wgt[wv][e] = a[e]; wgt[wv][4 + e] = b[e]; } }
              { const f32x4 a = *(const f32x4*)(cb + c0), b = *(const f32x4*)(cb + c0 + 4);
#pragma unroll
                for (int e = 0; e < 4; ++e) { wgt[4][e] = a[e]; wgt[4][4 + e] = b[e]; } }
#pragma unroll
              for (int t = 0; t < 4; ++t) {
#pragma unroll
                  for (int e = 0; e < 8; ++e) { const float a = wgt[4][e] + x[t][e] * wgt[0][e] + x[t + 1][e] * wgt[1][e] + x[t + 2][e] * wgt[2][e] + x[t + 3][e] * wgt[3][e]; xc[t][e] = pg8::silu_fast(a); }
                  *(bf16x8*)(XC + (size_t)(r0 + t) * MI + c0) = pack8(xc[t]); } }
#pragma unroll
            for (int g = 0; g < 8; ++g) { const LAS float* gq = Gt + g * 4096 + c0; const LAS float* gm = gq + 2048;
                const f32x4 q0 = *(const LAS f32x4*)gq, q1 = *(const LAS f32x4*)(gq + 4), m0 = *(const LAS f32x4*)gm, m1 = *(const LAS f32x4*)(gm + 4);
#pragma unroll
                for (int t = 0; t < 4; ++t) { float a = ga[t][g];
#pragma unroll
                    for (int e = 0; e < 4; ++e) a += xc[t][e] * q0[e] + xc[t][4 + e] * q1[e] + x[3 + t][e] * m0[e] + x[3 + t][4 + e] * m1[e];
                    ga[t][g] = a; }
                asm volatile("" ::: "memory"); }
        }
#pragma unroll
        for (int t = 0; t < 4; ++t)
#pragma unroll
            for (int g = 0; g < 8; ++g) ga[t][g] = wsum(ga[t][g]);
        if (lane < 32) { const int t = lane >> 3, g = lane & 7; float v = 0.f;
#pragma unroll
            for (int tt = 0; tt < 4; ++tt)
#pragma unroll
                for (int gg = 0; gg < 8; ++gg) v = (tt == t && gg == g) ? ga[tt][gg] : v;
            if (r0 + t < NROWS) GA[(size_t)(r0 + t) * 8 + g] = v + P.in[I_MBG][j * 8 + g]; }
    }
    __syncthreads();
}
__device__ __forceinline__ float scan_add(float v, int lane) {
#pragma unroll
    for (int o = 1; o < 64; o <<= 1) { const float t = __shfl_up(v, o); if (lane >= o) v += t; }
    return v; }
__device__ __forceinline__ float scan_max(float v, int lane) {
#pragma unroll
    for (int o = 1; o < 64; o <<= 1) { const float t = __shfl_up(v, o); if (lane >= o) v = fmaxf(v, t); }
    return v; }
constexpr int SC_MAXC = (NCH + 7) / 8;
__device__ __forceinline__ void scal_wg(const Params& P, int j, LAS unsigned char* lds, int team, int tid) {
    const float* GA = WSP(float, W_GATES); float* SA = WSP(float, W_SA); float* SCJ = WSP(float, W_SCJ); float* SWI = WSP(float, W_SWI); float* SEM = WSP(float, W_SEM); float* SWK = WSP(float, W_SWK); float* DEC = WSP(float, W_DEC);
    const int wave = tid >> 6, lane = tid & 63;
    LAS float* xg = (LAS float*)lds; LAS float* xp = xg + 64; LAS float* xm = xp + 64;
    if (team < BATCH * 4) { const int b = team >> 2, h = team & 3;
        float bl[SC_MAXC][4], cj[SC_MAXC][4], pex[SC_MAXC];
#pragma unroll
        for (int k = 0; k < SC_MAXC; ++k) { const int c = wave + 8 * k;
            if (c < NCH) { const int row0 = c == 0 ? ROW_META + b * NMETA : b * SEQ + (c - 1) * LCH; const int nper = c == 0 ? 1 : 4; const bool act = c == 0 ? lane < NMETA : true; const int tb = lane * nper;
                float ip[4]; float run = 0.f, pmx = -3.0e38f;
#pragma unroll
                for (int u = 0; u < 4; ++u) { if (u < nper && act) { const int r = row0 + tb + u; ip[u] = GA[(size_t)r * 8 + h]; run += logsigf(GA[(size_t)r * 8 + 4 + h]); } else ip[u] = 0.f; bl[k][u] = run; }
                const float incl = scan_add(run, lane), excl = incl - run;
#pragma unroll
                for (int u = 0; u < 4; ++u) { bl[k][u] += excl; cj[k][u] = (u < nper && act) ? ip[u] - bl[k][u] : -3.0e38f; pmx = fmaxf(pmx, cj[k][u]); }
                const float pin = scan_max(pmx, lane); float pe = __shfl_up(pin, 1); if (lane == 0) pe = -3.0e38f; pex[k] = pe;
                if (lane == 63) { xg[c] = incl; xp[c] = pin; } } }
        __syncthreads();
        if (tid == 0) { float m = 0.f; for (int c = 0; c < NCH; ++c) { xm[c] = m; const float g = xg[c], mn = g + fmaxf(m, xp[c]); DEC[(size_t)team * NCH + c] = __expf(g + m - mn); m = mn; }
            P.out[O_PM + (size_t)j * BATCH * 4 + team] = m; }
        __syncthreads();
#pragma unroll
        for (int k = 0; k < SC_MAXC; ++k) { const int c = wave + 8 * k;
            if (c < NCH) { const int row0 = c == 0 ? ROW_META + b * NMETA : b * SEQ + (c - 1) * LCH; const int nper = c == 0 ? 1 : 4; const bool act = c == 0 ? lane < NMETA : true; const int tb = lane * nper;
                const float m_prev = xm[c], g = xg[c], m_new = g + fmaxf(m_prev, xp[c]); float pr = pex[k];
#pragma unroll
                for (int u = 0; u < 4; ++u) if (u < nper && act) { const int r = row0 + tb + u; pr = fmaxf(pr, cj[k][u]); const float mx = fmaxf(m_prev, pr), mt = bl[k][u] + mx;
                    SA[(size_t)r * 4 + h] = -mx; SCJ[(size_t)r * 4 + h] = cj[k][u]; SWI[(size_t)r * 4 + h] = __expf(m_prev - mx); SEM[(size_t)r * 4 + h] = __expf(-mt); SWK[(size_t)r * 4 + h] = __expf(g + cj[k][u] - m_new); } } }
    } else { for (int k = tid; k < DECB * 4; k += 512) { const int bs = k >> 2, h = k & 3; float m = P.in[I_SM][(size_t)j * DECB * 4 + k]; float dec;
            scal_chunk(GA, h, ROW_SAMP + bs * TS, TS, m, SA, SCJ, SWI, SEM, SWK, dec); DEC[(size_t)BATCH * 4 * NCH + k] = dec; P.out[O_SMM + (size_t)j * DECB * 4 + k] = m; } }
    __syncthreads();
}
__device__ __forceinline__ void hnorm_fast(const Params& P, int j, int r_lo, int gw, int ngw, int lane) {
    const bf16* H = WSP(bf16, W_H); const bf16* OS = WSP(bf16, W_OS); const bf16* XC = WSP(bf16, W_XC); const bf16* ZS = WSP(bf16, W_ZS); bf16* A2 = WSP(bf16, W_A2);
    const float* hn = P.in[I_MHN] + (size_t)j * 2048 + 32 * lane; const float* sk = P.in[I_MSKIP] + (size_t)j * 2048 + 32 * lane;
    bf16x8 hv_[4], os_[4], xc_[4], zs_[4];
    int r = r_lo + gw;
    if (r < NROWS) { const size_t o = (size_t)r * MI + 32 * lane;
#pragma unroll
        for (int q = 0; q < 4; ++q) { hv_[q] = *(const bf16x8*)(H + o + 8 * q); os_[q] = *(const bf16x8*)(OS + o + 8 * q); xc_[q] = *(const bf16x8*)(XC + o + 8 * q); zs_[q] = *(const bf16x8*)(ZS + o + 8 * q); } }
    for (; r < MPAD; r += ngw) { const size_t o = (size_t)r * MI + 32 * lane;
        if (r >= NROWS) {
#pragma unroll
            for (int q = 0; q < 4; ++q) *(u32x4*)(A2 + o + 8 * q) = (u32x4){0u, 0u, 0u, 0u};
            continue; }
        bf16x8 hc[4], oc[4], xcur[4], zc[4];
#pragma unroll
        for (int q = 0; q < 4; ++q) { hc[q] = hv_[q]; oc[q] = os_[q]; xcur[q] = xc_[q]; zc[q] = zs_[q]; }
        const int rn = r + ngw;
        if (rn < NROWS) { const size_t on = (size_t)rn * MI + 32 * lane;
#pragma unroll
            for (int q = 0; q < 4; ++q) { hv_[q] = *(const bf16x8*)(H + on + 8 * q); os_[q] = *(const bf16x8*)(OS + on + 8 * q); xc_[q] = *(const bf16x8*)(XC + on + 8 * q); zs_[q] = *(const bf16x8*)(ZS + on + 8 * q); } }
        float hv[4][8]; float s = 0.f;
#pragma unroll
        for (int q = 0; q < 4; ++q) { unpack8(hc[q], hv[q]);
#pragma unroll
            for (int e = 0; e < 8; ++e) s += hv[q][e]; }
        s += __shfl_xor(s, 1); s += __shfl_xor(s, 2); s += __shfl_xor(s, 4); s += __shfl_xor(s, 8);
        const float mu = s * (1.f / 512.f); float qq = 0.f;
#pragma unroll
        for (int q = 0; q < 4; ++q)
#pragma unroll
            for (int e = 0; e < 8; ++e) { const float dl = hv[q][e] - mu; qq += dl * dl; }
        qq += __shfl_xor(qq, 1); qq += __shfl_xor(qq, 2); qq += __shfl_xor(qq, 4); qq += __shfl_xor(qq, 8);
        const float rs = 1.f / sqrtf(qq * (1.f / 512.f) + EPS);
#pragma unroll
        for (int q = 0; q < 4; ++q) { float os[8], xc[8], zs[8], res[8];
            unpack8(oc[q], os); unpack8(xcur[q], xc); unpack8(zc[q], zs);
            const f32x4 n0 = *(const f32x4*)(hn + 8 * q), n1 = *(const f32x4*)(hn + 8 * q + 4), k0 = *(const f32x4*)(sk + 8 * q), k1 = *(const f32x4*)(sk + 8 * q + 4);
#pragma unroll
            for (int e = 0; e < 8; ++e) { const float nwe = e < 4 ? n0[e & 3] : n1[e & 3], kwe = e < 4 ? k0[e & 3] : k1[e & 3]; res[e] = (os[e] * ((hv[q][e] - mu) * rs * nwe) + kwe * xc[e]) * zs[e]; }
            *(bf16x8*)(A2 + o + 8 * q) = pack8(res); }
    }
}
__device__ __forceinline__ void hnorm_block(const Params& P, int j, int tt, int h, int wave, int lane) {
    const bf16* H = WSP(bf16, W_H); const bf16* OS = WSP(bf16, W_OS); const bf16* XC = WSP(bf16, W_XC); const bf16* ZS = WSP(bf16, W_ZS); bf16* A2 = WSP(bf16, W_A2);
    const int sub = lane & 15, rq = lane >> 4; const int col = h * 512 + 32 * sub;
    const float* hn = P.in[I_MHN] + (size_t)j * 2048 + col; const float* sk = P.in[I_MSKIP] + (size_t)j * 2048 + col;
    bf16x8 hv_[4], os_[4], xc_[4], zs_[4];
    { const size_t o = (size_t)(tt * 256 + wave * 4 + rq) * MI + col;
#pragma unroll
      for (int q = 0; q < 4; ++q) { hv_[q] = *(const bf16x8*)(H + o + 8 * q); os_[q] = *(const bf16x8*)(OS + o + 8 * q); xc_[q] = *(const bf16x8*)(XC + o + 8 * q); zs_[q] = *(const bf16x8*)(ZS + o + 8 * q); } }
#pragma unroll 1
    for (int it = 0; it < 8; ++it) { const size_t o = (size_t)(tt * 256 + it * 32 + wave * 4 + rq) * MI + col;
        bf16x8 hc[4], oc[4], xcur[4], zc[4];
#pragma unroll
        for (int q = 0; q < 4; ++q) { hc[q] = hv_[q]; oc[q] = os_[q]; xcur[q] = xc_[q]; zc[q] = zs_[q]; }
        if (it < 7) { const size_t on = o + (size_t)32 * MI;
#pragma unroll
            for (int q = 0; q < 4; ++q) { hv_[q] = *(const bf16x8*)(H + on + 8 * q); os_[q] = *(const bf16x8*)(OS + on + 8 * q); xc_[q] = *(const bf16x8*)(XC + on + 8 * q); zs_[q] = *(const bf16x8*)(ZS + on + 8 * q); } }
        float hv[4][8]; float s = 0.f;
#pragma unroll
        for (int q = 0; q < 4; ++q) { unpack8(hc[q], hv[q]);
#pragma unroll
            for (int e8 = 0; e8 < 8; ++e8) s += hv[q][e8]; }
        s += __shfl_xor(s, 1); s += __shfl_xor(s, 2); s += __shfl_xor(s, 4); s += __shfl_xor(s, 8);
        const float mu = s * (1.f / 512.f); float qq = 0.f;
#pragma unroll
        for (int q = 0; q < 4; ++q)
#pragma unroll
            for (int e8 = 0; e8 < 8; ++e8) { const float dl = hv[q][e8] - mu; qq += dl * dl; }
        qq += __shfl_xor(qq, 1); qq += __shfl_xor(qq, 2); qq += __shfl_xor(qq, 4); qq += __shfl_xor(qq, 8);
        const float rs = 1.f / sqrtf(qq * (1.f / 512.f) + EPS);
#pragma unroll
        for (int q = 0; q < 4; ++q) { float os[8], xc[8], zs[8], res[8];
            unpack8(oc[q], os); unpack8(xcur[q], xc); unpack8(zc[q], zs);
            const f32x4 n0 = *(const f32x4*)(hn + 8 * q), n1 = *(const f32x4*)(hn + 8 * q + 4), k0 = *(const f32x4*)(sk + 8 * q), k1 = *(const f32x4*)(sk + 8 * q + 4);
#pragma unroll
            for (int e8 = 0; e8 < 8; ++e8) { const float nwe = e8 < 4 ? n0[e8 & 3] : n1[e8 & 3], kwe = e8 < 4 ? k0[e8 & 3] : k1[e8 & 3]; res[e8] = (os[e8] * ((hv[q][e8] - mu) * rs * nwe) + kwe * xc[e8]) * zs[e8]; }
            *(bf16x8*)(A2 + o + 8 * q) = pack8(res); }
    }
}
template <class ColMap>
__device__ __forceinline__ void transpose_item(const float* W, int K, int N, bf16* WT, int ldt, ColMap cmap, float scale, LAS float* scr, int item, int lane) {
    const int nblk = N / 32, kb = item / nblk, nb = item % nblk, k0 = 64 * kb, n0 = 32 * nb;
    float tv[32];
#pragma unroll
    for (int i = 0; i < 32; ++i) tv[i] = W[(size_t)(k0 + 2 * i + (lane >> 5)) * N + cmap(n0 + (lane & 31))];
#pragma unroll
    for (int i = 0; i < 32; ++i) scr[(2 * i + (lane >> 5)) * 33 + (lane & 31)] = tv[i];
    asm volatile("s_waitcnt lgkmcnt(0)" ::: "memory");
    const int c = lane & 7;
#pragma unroll
    for (int jj = 0; jj < 4; ++jj) { const int n = (lane >> 3) + 8 * jj; const LAS float* s = scr + (8 * c) * 33 + n;
        u32x4 o; o[0] = pg8::cvt_pk_bf16(s[0 * 33] * scale, s[1 * 33] * scale); o[1] = pg8::cvt_pk_bf16(s[2 * 33] * scale, s[3 * 33] * scale); o[2] = pg8::cvt_pk_bf16(s[4 * 33] * scale, s[5 * 33] * scale); o[3] = pg8::cvt_pk_bf16(s[6 * 33] * scale, s[7 * 33] * scale);
        *(u32x4*)(WT + (size_t)(n0 + n) * ldt + k0 + 8 * c) = o; }
    asm volatile("s_waitcnt lgkmcnt(0)" ::: "memory");
}
struct MapId { __device__ __forceinline__ int operator()(int n) const { return n; } };
struct MapSwa { __device__ __forceinline__ int operator()(int n) const { return swa_pos2orig(n); } };
__device__ __forceinline__ void convert_set(const Params& P, LAS unsigned char* lds, int set, int iw, int nw, int wave, int lane) {
    const float* wq_ = lp(P.in[I_MWQ]); const float* wk_ = lp(P.in[I_MWK]); const float* wv_ = lp(P.in[I_MWV]);
    LAS float* scr = (LAS float*)(lds + wave * 16384);
    constexpr int I_SW = (D / 64) * (SWA_N / 32), I_SO = (D / 64) * (D / 32), I_MW = (D / 64) * (ML_N / 32), I_QK = (512 / 64) * (512 / 32), I_MO = (MI / 64) * (D / 32);
    constexpr int N_SWA = I_SW + I_SO, N_ML = I_MW + 12 * I_QK + I_MO;
    const int total = set == 0 ? N_SWA : set == 1 ? N_ML : N_SWA + N_ML;
    for (int it = iw; it < total; it += nw) { int r = it; int j = set == 0 ? 0 : set == 1 ? 0 : 1; bool swa = set == 0;
        if (set == 2) { if (r < N_SWA) swa = true; else r -= N_SWA; }
        if (swa) {
            if (r < I_SW) { transpose_item(P.in[I_SWIN] + (size_t)j * D * SWA_N, D, SWA_N, WSP(bf16, W_SWIN) + (size_t)j * SWA_N * D, D, MapSwa(), 1.f, scr, r, lane); continue; } r -= I_SW;
            transpose_item(P.in[I_SWOUT] + (size_t)j * D * D, D, D, WSP(bf16, W_SWOUT) + (size_t)j * D * D, D, MapId(), 1.f, scr, r, lane); continue; }
        if (r < I_MW) { transpose_item(P.in[I_MWIN] + (size_t)j * D * ML_N, D, ML_N, WSP(bf16, W_MWIN) + (size_t)j * ML_N * D, D, MapId(), 1.f, scr, r, lane); continue; } r -= I_MW;
        if (r < 12 * I_QK) { const int w = r / (4 * I_QK), h = (r / I_QK) % 4, q = r % I_QK;
            transpose_item((w == 0 ? wq_ : w == 1 ? wk_ : wv_) + ((size_t)j * 4 + h) * 512 * 512, 512, 512, WSP(bf16, W_MWQ) + (size_t)(j * 3 + w) * 4 * 512 * 512 + h * 512, 2048, MapId(), w == 1 ? 0.044194173824159216f : 1.f, scr, q, lane); continue; } r -= 12 * I_QK;
        transpose_item(P.in[I_MWOUT] + (size_t)j * MI * D, MI, D, WSP(bf16, W_MWOUT) + (size_t)j * D * MI, MI, MapId(), 1.f, scr, r, lane);
    }
}
__device__ __forceinline__ void prologue_fast(const Params& P, LAS unsigned char* lds, int gw, int ngw, int wave, int lane, long gt, long gs) {
    const float* wq_ = lp(P.in[I_MWQ]); const float* wk_ = lp(P.in[I_MWK]); const float* wv_ = lp(P.in[I_MWV]);
    convert_set(P, lds, 0, gw, ngw, wave, lane);
    { float* bt = WSP(float, W_BIAS); const float* rb = P.in[I_RELB]; for (long i = gt; i < 16 * 132; i += gs) { const int h = (int)(i / 132), dd = (int)(i % 132); bt[i] = rb[rel_bucket(dd > 128 ? 128 : dd) * 16 + h]; } }
}
__device__ __forceinline__ void gmat_items(const Params& P, int j, int it0, int n, int wave, int lane) {
    const float* wq_ = lp(P.in[I_MWQ]); const float* wk_ = lp(P.in[I_MWK]); const float* wv_ = lp(P.in[I_MWV]);
    float* G = WSP(float, W_G);
    for (int it = it0 + wave; it < it0 + n; it += 8) { const int d = it & 511, h = (it >> 9) & 3, kg = (it >> 11) & 1;
        float a[8];
#pragma unroll
        for (int g = 0; g < 8; ++g) a[g] = 0.f;
        for (int part = 0; part < (kg == 0 ? 2 : 1); ++part) { const int w = kg == 0 ? part : 2; const float sc = w == 1 ? 0.044194173824159216f : 1.f;
            const float* wr = (w == 0 ? wq_ : w == 1 ? wk_ : wv_) + (((size_t)j * 4 + h) * 512 + d) * 512 + 8 * lane; const float* wg = P.in[I_MWG] + (size_t)j * 6144 * 8 + (size_t)(w * 2048 + h * 512 + 8 * lane) * 8;
            const f32x4 x0 = *(const f32x4*)wr * sc, x1 = *(const f32x4*)(wr + 4) * sc;
#pragma unroll
            for (int e8 = 0; e8 < 8; ++e8) { const float x = e8 < 4 ? x0[e8 & 3] : x1[e8 & 3]; const f32x4 g0 = *(const f32x4*)(wg + e8 * 8), g1 = *(const f32x4*)(wg + e8 * 8 + 4);
#pragma unroll
                for (int g = 0; g < 4; ++g) { a[g] += x * g0[g]; a[4 + g] += x * g1[g]; } } }
#pragma unroll
        for (int g = 0; g < 8; ++g) a[g] = wsum(a[g]);
        if (lane < 8) { float v = 0.f;
#pragma unroll
            for (int g = 0; g < 8; ++g) v = lane == g ? a[g] : v;
            G[(size_t)j * 4096 * 8 + (size_t)(kg * 2048 + h * 512 + d) * 8 + lane] = v; } }
}
__device__ __forceinline__ int wq_pull(unsigned* ctr, LAS unsigned* slot, int tid);
__device__ __forceinline__ void gmat_deferred(const Params& P, int j, unsigned* ctr, LAS unsigned* slot, int tid) {
    for (;;) { const int c = wq_pull(ctr, slot, tid); if (c >= 256) break; gmat_items(P, j, c * 16, 16, tid >> 6, tid & 63); }
}
__device__ __forceinline__ void cache_part(const Params& P, int part, long gt, long gs) {
    bf16* KC = WSP(bf16, W_KC); bf16* VTC = WSP(bf16, W_VTC);
    const float* cmk = lp(P.in[I_CMK]); const float* ck = lp(P.in[I_CK]); const float* cmv = lp(P.in[I_CMV]); const float* cv = lp(P.in[I_CV]);
    if (part < 2) { const long jb0 = (long)part * DECB;
        for (long i = gt; i < (long)DECB * KCN * 32; i += gs) { const int c8 = (int)(i % 32) * 8, key = (int)((i / 32) % KCN); const long jb = jb0 + i / (32 * KCN);
            float f[8];
#pragma unroll
            for (int e = 0; e < 8; ++e) f[e] = 0.f;
            const float* src = key < 16 ? cmk + ((size_t)jb * 16 + key) * 256 + c8 : key < 144 ? ck + ((size_t)jb * 128 + key - 16) * 256 + c8 : nullptr;
            if (src) { const f32x4 a = *(const f32x4*)src, b = *(const f32x4*)(src + 4);
#pragma unroll
                for (int e = 0; e < 4; ++e) { f[e] = a[e]; f[4 + e] = b[e]; } }
            *(bf16x8*)(KC + ((size_t)jb * KCN + key) * 256 + c8) = pack8(f); }
        for (long i = gt; i < (long)DECB * 256 * (KCN / 8); i += gs) { const int c = (int)(i % 256), k8 = (int)((i / 256) % (KCN / 8)) * 8; const long jb = jb0 + i / (256 * (KCN / 8));
            float f[8];
#pragma unroll
            for (int e = 0; e < 8; ++e) { const int key = k8 + e; f[e] = key < 16 ? cmv[((size_t)jb * 16 + key) * 256 + c] : key < 144 ? cv[((size_t)jb * 128 + key - 16) * 256 + c] : 0.f; }
            *(bf16x8*)(VTC + ((size_t)jb * 256 + c) * KCN + k8) = pack8(f); }
    } else { const float* src = part == 2 ? ck : cv; float* dst = P.out + (part == 2 ? O_SK : O_SV);
        for (long i = gt; i < 2L * DECB * 124 * 64; i += gs) { const int c4 = (int)(i % 64) * 4, key = (int)((i / 64) % 124); const long jb = i / (64 * 124);
            *(f32x4*)(dst + ((size_t)jb * 128 + key) * 256 + c4) = *(const f32x4*)(src + ((size_t)jb * 128 + key + 4) * 256 + c4); } }
}
__device__ __forceinline__ int wq_pull(unsigned* ctr, LAS unsigned* slot, int tid);
__device__ __forceinline__ void cache_deferred(const Params& P, int part, unsigned* ctr, LAS unsigned* slot, int tid) {
    constexpr int NCHUNK = 256;
    for (;;) { const int c = wq_pull(ctr, slot, tid); if (c >= NCHUNK) break; cache_part(P, part, (long)c * 512 + tid, (long)NCHUNK * 512); }
}
__device__ __forceinline__ void sample_item(const Params& P, int j, LAS unsigned char* lds, int it, int tid) {
    const int bs = it >> 2, h = it & 3, row0 = ROW_SAMP + bs * TS, wave = tid >> 6, lane = tid & 63;
    LAS float* qk = (LAS float*)lds;
    LAS float* red = (LAS float*)(lds + 16384);
    LAS float* sc = (LAS float*)(lds + 16384 + 32768);
    LAS float* vs = (LAS float*)(lds + 16384 + 32768 + 1024);
    const bf16* Q = WSP(bf16, W_MQ); const bf16* K = WSP(bf16, W_MK); const bf16* VT = WSP(bf16, W_MVT); bf16* H = WSP(bf16, W_H);
    const size_t so = (((size_t)j * DECB + bs) * 4 + h) * 512 * 512, no = (((size_t)j * DECB + bs) * 4 + h) * 512;
    const float* cin = P.in[I_SC] + so; float* cout = P.out + O_SCC + so; const float* nin = P.in[I_SN] + no;
    const int e4 = (tid & 127) * 4, dq = tid >> 7;
    const float* cp = cin + (size_t)(dq * 128) * 512 + e4; float* op = cout + (size_t)(dq * 128) * 512 + e4;
    f32x4 ca[8], cb[8], cc[8];
#define SI_LOAD(blk, r0) do { _Pragma("unroll") for (int u = 0; u < 8; ++u) blk[u] = __builtin_nontemporal_load((const f32x4*)(cp + (size_t)((r0) + u) * 512)); __builtin_amdgcn_sched_barrier(0); } while (0)
    SI_LOAD(ca, 0); SI_LOAD(cb, 8);
    { const int d = tid;
#pragma unroll
      for (int t = 0; t < 4; ++t) { qk[d * 8 + t] = bf2f(Q[(size_t)(row0 + t) * MI + h * 512 + d]); qk[d * 8 + 4 + t] = bf2f(K[(size_t)(row0 + t) * MI + h * 512 + d]); vs[t * 512 + d] = bf2f(VT[vtb_idx(row0 + t, h, d)]); } }
    __syncthreads();
    for (int idx = wave; idx < 14; idx += 8) { int t, jj; float a = 0.f;
        if (idx < 10) { t = idx < 1 ? 0 : idx < 3 ? 1 : idx < 6 ? 2 : 3; jj = idx - (t * (t + 1)) / 2;
            for (int d = lane; d < 512; d += 64) a += qk[d * 8 + t] * qk[d * 8 + 4 + jj];
            a = wsum(a); if (lane == 0) sc[t * 4 + jj] = a; }
        else { t = idx - 10; for (int d = lane; d < 512; d += 64) a += qk[d * 8 + t] * nin[d]; a = wsum(a); if (lane == 0) sc[16 + t] = a; } }
    __syncthreads();
    if (tid < 4) { const int t = tid, r = row0 + t; const float sa = WSP(float, W_SA)[(size_t)r * 4 + h], wi = WSP(float, W_SWI)[(size_t)r * 4 + h]; float s = 0.f;
        for (int jj = 0; jj < 4; ++jj) { float p = 0.f; if (jj <= t) p = sc[t * 4 + jj] * __expf(sa + WSP(float, W_SCJ)[(size_t)(row0 + jj) * 4 + h]); sc[32 + t * 4 + jj] = p; s += p; }
        const float den = s + wi * sc[16 + t]; sc[48 + t] = fmaxf(fabsf(den), WSP(float, W_SEM)[(size_t)r * 4 + h]); sc[52 + t] = wi; sc[56 + t] = WSP(float, W_SWK)[(size_t)r * 4 + h];
        if (t == 0) sc[60] = WSP(float, W_DEC)[(size_t)BATCH * 4 * NCH + it]; }
    __syncthreads();
    const float dec = sc[60];
    f32x4 wv[4], acc[4];
#pragma unroll
    for (int t = 0; t < 4; ++t) { wv[t] = *(const LAS f32x4*)(vs + t * 512 + e4) * sc[56 + t]; acc[t] = (f32x4){0.f, 0.f, 0.f, 0.f}; }
    const LAS float* qp = qk + (dq * 128) * 8;
#define SI_PROC(blk, r0) do { _Pragma("unroll") for (int u = 0; u < 8; ++u) { const f32x4 qv = *(const LAS f32x4*)(qp + ((r0) + u) * 8), kv = *(const LAS f32x4*)(qp + ((r0) + u) * 8 + 4); \
        f32x4 o = blk[u] * dec; _Pragma("unroll") for (int t = 0; t < 4; ++t) { acc[t] += blk[u] * qv[t]; o += wv[t] * kv[t]; } \
        __builtin_nontemporal_store(o, (f32x4*)(op + (size_t)((r0) + u) * 512)); __builtin_amdgcn_sched_barrier(0); } } while (0)
#pragma unroll 1
    for (int d0 = 0; d0 < 120; d0 += 24) {
        SI_LOAD(cc, d0 + 16); SI_PROC(ca, d0);
        SI_LOAD(ca, d0 + 24); SI_PROC(cb, d0 + 8);
        SI_LOAD(cb, (d0 + 32 < 128 ? d0 + 32 : 120)); SI_PROC(cc, d0 + 16); }
    SI_PROC(ca, 120);
#undef SI_LOAD
#undef SI_PROC
#pragma unroll
    for (int t = 0; t < 4; ++t) *(LAS f32x4*)(red + (dq * 4 + t) * 512 + e4) = acc[t];
    __syncthreads();
    { const int e = tid;
#pragma unroll
      for (int t = 0; t < 4; ++t) { float a = (red[(0 * 4 + t) * 512 + e] + red[(1 * 4 + t) * 512 + e]) + (red[(2 * 4 + t) * 512 + e] + red[(3 * 4 + t) * 512 + e]); a *= sc[52 + t];
#pragma unroll
          for (int jj = 0; jj < 4; ++jj) a += sc[32 + t * 4 + jj] * vs[jj * 512 + e];
          H[(size_t)(row0 + t) * MI + h * 512 + e] = f2bf(a / sc[48 + t]); }
      float n = dec * nin[e];
#pragma unroll
      for (int t = 0; t < 4; ++t) n += sc[56 + t] * qk[e * 8 + 4 + t];
      P.out[O_SNN + no + e] = n; }
    __syncthreads();
}
__device__ __forceinline__ int wq_pull(unsigned* ctr, LAS unsigned* slot, int tid) {
    if (tid == 0) *slot = __hip_atomic_fetch_add(ctr, 1u, __ATOMIC_RELAXED, __HIP_MEMORY_SCOPE_AGENT);
    __syncthreads(); const int v = (int)*slot; __syncthreads(); return v;
}
__device__ __forceinline__ void meta_scores(const Params& P, int wv, int nwv, int lane) {
    const bf16* Q = WSP(bf16, W_MQ); const bf16* K = WSP(bf16, W_MK); const float* SA = WSP(float, W_SA); const float* SCJ = WSP(float, W_SCJ); float* PSM = WSP(float, W_PSM); float* DEN = WSP(float, W_DEN);
    for (int i = wv; i < BATCH * 4 * NMETA; i += nwv) { const int it = i >> 4, t = i & 15, b = it >> 2, h = it & 3, row0 = ROW_META + b * NMETA, r = row0 + t;
        float qv[8]; unpack8(*(const bf16x8*)(Q + (size_t)r * MI + h * 512 + 8 * lane), qv); float s = 0.f;
        for (int jj = 0; jj < NMETA; ++jj) { float v = 0.f;
            if (jj <= t) { float kv[8]; unpack8(*(const bf16x8*)(K + (size_t)(row0 + jj) * MI + h * 512 + 8 * lane), kv); float a = 0.f;
#pragma unroll
                for (int e8 = 0; e8 < 8; ++e8) a += qv[e8] * kv[e8];
                v = wsum(a) * __expf(SA[(size_t)r * 4 + h] + SCJ[(size_t)(row0 + jj) * 4 + h]); }
            if (lane == 0) PSM[(size_t)it * 256 + t * 16 + jj] = v; s += v; }
        if (lane == 0) DEN[(size_t)r * 4 + h] = s; }
}
}
constexpr int LDS_MISC_OFF = 131072, LDS_BYTES = 147456;
constexpr int CW_BAR = 4096, CW_QUEUE = 16384;
#ifndef QA_ITEMS
#define QA_ITEMS (DECB * 4)
#endif
#define GAS __attribute__((address_space(1)))
template <class T> __device__ __forceinline__ T* GP(T* p) { return (T*)(T GAS*)p; }
template <class T> __device__ __forceinline__ T* GPL(T* p) { T GAS* g = (T GAS*)p; asm volatile("" : "+s"(g)); return (T*)g; }
__global__ void __launch_bounds__(512, 2) mega(Params P) {
    extern __shared__ __attribute__((aligned(16))) unsigned char lds[];
    LAS unsigned char* ldsb = (LAS unsigned char*)lds;
    LAS unsigned* misc = (LAS unsigned*)(ldsb + LDS_MISC_OFF);
    if (threadIdx.x < 64) misc[threadIdx.x] = 0u;
    __syncthreads();
    XcdBarrier bar = xcd_barrier_post((unsigned*)(P.ws + W_CTL) + CW_BAR, (volatile LAS unsigned*)(misc + 8));
    const long gt = (long)blockIdx.x * 512 + threadIdx.x, gs = (long)gridDim.x * 512;
    const int G = (int)gridDim.x, cwg = (int)blockIdx.x;
#define LAUNDER() Params Pl = P; { Pl.ws = GPL(Pl.ws); Pl.out = GPL(Pl.out); \
    _Pragma("unroll") for (int i_ = 0; i_ < N_IN; ++i_) Pl.in[i_] = GP(Pl.in[i_]); } long gtl = gt; asm volatile("" : "+v"(gtl))
#define RUNNB(ph, a0, a1) do { LAUNDER(); dispatch<ph>(Pl, a0, a1, gtl, gs); } while (0)
#define RUN(ph, a0, a1) do { RUNNB(ph, a0, a1); xcd_barrier(bar); } while (0)
#define BAR() xcd_barrier(bar)
#ifndef PR_A
#define PR_A 1
#endif
#ifndef PR_A2
#define PR_A2 PR_A
#endif
#ifndef PR_A3
#define PR_A3 PR_A
#endif
#ifndef PR_A3_KMODE
#define PR_A3_KMODE 0
#endif
#ifndef PR_F
#define PR_F 0
#endif
#ifndef PR_B
#define PR_B 1
#endif
#ifndef PR_C
#define PR_C 1
#endif
#ifndef PR_D
#define PR_D 1
#endif
#ifndef PR_D1
#define PR_D1 PR_D
#endif
#ifndef PR_D2
#define PR_D2 PR_D
#endif
#ifndef PR_D3
#define PR_D3 PR_D
#endif
#ifndef PR_D4
#define PR_D4 PR_D
#endif
#ifndef PR_D5
#define PR_D5 PR_D
#endif
#ifndef PR_E
#define PR_E 1
#endif
#define REP(n) for (int rp_ = 0; rp_ < (n); ++rp_)
#define WV_ARGS (int)(gtl >> 6), G * 8, (int)(gtl & 63)
    REP(PR_E) {
    { LAUNDER(); el::prologue_fast(Pl, ldsb, (int)(gtl >> 6), G * 8, (int)((gtl >> 6) & 7), (int)(gtl & 63), gtl, gs); el::cache_part(Pl, 0, gtl, gs); }
    BAR(); }
    for (int layer = 0; layer < 4; ++layer) {
        const int j = layer >> 1;
        REP(PR_D1) { { LAUNDER(); el::norm_fast(Pl, layer, WV_ARGS); }
        BAR(); }
        if ((layer & 1) == 0) {
            REP(PR_A) { { LAUNDER(); pg8::PlainOrder S; S.init(WSP2(Pl, bf16, W_XN), D, WSP2(Pl, bf16, W_SWIN) + (size_t)j * SWA_N * D, D, MPAD, SWA_N, D, G, cwg);
              pg8::EpiSwaIn E{Pl, j}; pg8::gemm_phase(ldsb, D, D, S, E);
              constexpr int NU = (MPAD / 256) * (SWA_N / 256); const int first_idle = NU % G;
              if (layer == 2) el::cache_deferred(Pl, 2, (unsigned*)(Pl.ws + W_CTL) + CW_QUEUE + (20 + rp_) * 64, misc + 16, (int)(gtl & 511));
              if (layer == 0 && cwg >= first_idle) el::convert_set(Pl, ldsb, 1, (cwg - first_idle) * 8 + (int)((gtl >> 6) & 7), (G - first_idle) * 8, (int)((gtl >> 6) & 7), (int)(gtl & 63)); }
            BAR(); }
            REP(PR_B) { RUNNB(PH_SWAOUT, j, 0);
            { LAUNDER(); at::att_phase(Pl, j, ldsb, (int)(gtl >> 6), G * 8, (int)(gtl & 511)); }
            BAR(); }
            for (int rp_ = PR_F; rp_ >= 0; --rp_) { { LAUNDER(); pg8::SplitTailOrder S; S.init(WSP2(Pl, bf16, W_OG), D, WSP2(Pl, bf16, W_SWOUT) + (size_t)j * D * D, D, D, G, cwg);
              pg8::EpiResid E{Pl.in[I_XP], WSP2(Pl, bf16, W_X16), WSP2(Pl, float, W_X), Pl.out, layer == 0 ? 0 : 1, rp_ ? (long)(512u << 20) / 4 : 0L}; pg8::gemm_phase(ldsb, D, D, S, E); }
            { LAUNDER(); el::gmat_deferred(Pl, j, (unsigned*)(Pl.ws + W_CTL) + CW_QUEUE + (28 + j * 2 + rp_) * 64, misc + 16, (int)(gtl & 511)); }
            BAR(); }
        } else {
            REP(PR_A2) { { LAUNDER(); pg8::PlainOrder S; S.init(WSP2(Pl, bf16, W_XN), D, WSP2(Pl, bf16, W_MWIN) + (size_t)j * ML_N * D, D, MPAD, ML_N, D, G, cwg);
              pg8::EpiMlIn E{Pl, j}; pg8::gemm_phase(ldsb, D, D, S, E);
              constexpr int NU = (MPAD / 256) * (ML_N / 256); const int first_idle = NU % G;
              if (layer == 3) el::cache_deferred(Pl, 3, (unsigned*)(Pl.ws + W_CTL) + CW_QUEUE + (24 + rp_) * 64, misc + 16, (int)(gtl & 511));
              if (layer == 1 && cwg >= first_idle) el::convert_set(Pl, ldsb, 2, (cwg - first_idle) * 8 + (int)((gtl >> 6) & 7), (G - first_idle) * 8, (int)((gtl >> 6) & 7), (int)(gtl & 63)); }
            BAR(); }
            REP(PR_D2) { { LAUNDER(); el::convgates_fast(Pl, j, ldsb, WV_ARGS, (int)(gtl & 511)); }
            BAR(); }
            constexpr int NSCG = BATCH * 4 + 1;
            REP(PR_A3) { if (cwg >= G - NSCG) { LAUNDER(); el::scal_wg(Pl, j, ldsb, cwg - (G - NSCG), (int)(gtl & 511)); }
            else
            { LAUNDER(); pg8::M3Order S{(const char*)WSP2(Pl, bf16, W_XC), (const char*)WSP2(Pl, bf16, W_XM), (const char*)(WSP2(Pl, bf16, W_MWQ) + (size_t)j * 3 * 4 * 512 * 512), MPAD / 256, G - NSCG, cwg, rp_ == 0 ? 0 : PR_A3_KMODE};
              pg8::EpiM3 E{Pl}; pg8::gemm_phase(ldsb, MI, MI, S, E); }
            if (layer == 1) { LAUNDER(); el::cache_deferred(Pl, 1, (unsigned*)(Pl.ws + W_CTL) + CW_QUEUE + (16 + rp_) * 64, misc + 16, (int)(gtl & 511)); }
            BAR(); }
            constexpr int NSAMP_A = QA_ITEMS;
            constexpr int NSTW = BATCH * 4 * 16;
            REP(PR_C) { if (cwg < NSTW) {
                { LAUNDER(); st::state_scan(Pl, j, ldsb, cwg, (int)threadIdx.x); }
                { LAUNDER(); pg8::POrder S{(const char*)WSP2(Pl, bf16, W_MQ), (const char*)WSP2(Pl, bf16, W_MK), (NP / 256) * 4, NSTW, cwg};
                  pg8::EpiP E{Pl}; pg8::gemm_phase(ldsb, MI, MI, S, E); } }
            else { LAUNDER(); el::meta_scores(Pl, (int)(gtl >> 6) - NSTW * 8, (G - NSTW) * 8, (int)(gtl & 63)); }
            { LAUNDER(); unsigned* ctr = (unsigned*)(Pl.ws + W_CTL) + CW_QUEUE + (j * 2 + rp_ * 4) * 64; for (;;) { const int it = el::wq_pull(ctr, misc + 16, (int)(gtl & 511)); if (it >= NSAMP_A) break; el::sample_item(Pl, j, ldsb, it, (int)(gtl & 511)); } }
            BAR(); }
            REP(PR_D3) { { LAUNDER(); ph_den_fast(Pl, (int)(gtl >> 6), G * 8, (int)(gtl & 63)); }
            RUNNB(PH_SMALLM, j, 1);
            { LAUNDER(); unsigned* ctr = (unsigned*)(Pl.ws + W_CTL) + CW_QUEUE + (j * 2 + 1 + rp_ * 4) * 64; for (;;) { const int it = NSAMP_A + el::wq_pull(ctr, misc + 16, (int)(gtl & 511)); if (it >= DECB * 4) break; el::sample_item(Pl, j, ldsb, it, (int)(gtl & 511)); } }
            BAR(); }
            REP(PR_D4) {
            { LAUNDER(); el::hnorm_fast(Pl, j, NP, WV_ARGS); }
            { LAUNDER(); pg8::NumOrder S{(const char*)WSP2(Pl, bf16, W_MQ), (const char*)WSP2(Pl, bf16, W_P), (const char*)WSP2(Pl, bf16, W_CT), (const char*)WSP2(Pl, bf16, W_MVT), (NP / 256) * 4, G, cwg};
              pg8::EpiNum E{Pl}; pg8::gemm_phase(ldsb, MI, MI, S, E);
              asm volatile("s_waitcnt vmcnt(0)" ::: "memory"); __syncthreads(); __builtin_amdgcn_fence(__ATOMIC_ACQUIRE, "agent"); asm volatile("s_waitcnt vmcnt(0)" ::: "memory");
              for (int k = 0;; ++k) { const int id = S.job(k); if (id < 0) break; el::hnorm_block(Pl, j, id >> 2, id & 3, (int)((gtl >> 6) & 7), (int)(gtl & 63)); } }
            BAR(); }
            for (int rp_ = PR_F; rp_ >= 0; --rp_) { { LAUNDER(); pg8::SplitTailOrder S; S.init(WSP2(Pl, bf16, W_A2), MI, WSP2(Pl, bf16, W_MWOUT) + (size_t)j * D * MI, MI, MI, G, cwg);
              pg8::EpiResid E{Pl.in[I_XP], WSP2(Pl, bf16, W_X16), WSP2(Pl, float, W_X), Pl.out, layer == 3 ? 2 : 1, rp_ ? (long)(512u << 20) / 4 : 0L}; pg8::gemm_phase(ldsb, MI, MI, S, E); }
            BAR(); }
        }
    }
    { LAUNDER(); const float* X = WSP2(Pl, float, W_X) + (size_t)ROW_SAMP * D; float* ys = Pl.out + O_YS; for (long i = gtl; i < (long)NS * D / 4; i += gs) *(pg8::f32x4*)(ys + 4 * i) = *(const pg8::f32x4*)(X + 4 * i); }
}
extern "C" void kernel_launch(void* const* d_in, const int* in_sizes, int n_in, void* d_out, int out_size, void* d_ws, size_t ws_size, hipStream_t stream) {
    Params P; memset(&P, 0, sizeof(P));
    for (int i = 0; i < N_IN; ++i) P.in[i] = (const float*)d_in[i];
    P.out = (float*)d_out; P.ws = (unsigned char*)d_ws;
    if (ws_size < W_END) { fprintf(stderr, "ws too small: %zu < %zu\n", ws_size, (size_t)W_END); return; }
    static int grid = 0;
    if (!grid) {
        int dev = 0, cus = 0, per_cu = 0;
        (void)hipGetDevice(&dev);
        (void)hipDeviceGetAttribute(&cus, hipDeviceAttributeMultiprocessorCount, dev);
        (void)hipFuncSetAttribute((const void*)mega, hipFuncAttributeMaxDynamicSharedMemorySize, LDS_BYTES);
        (void)hipOccupancyMaxActiveBlocksPerMultiprocessor(&per_cu, mega, 512, LDS_BYTES);
        if (per_cu < 1) { fprintf(stderr, "mega: occupancy query says 0 blocks per CU\n"); per_cu = 1; }
        grid = cus;
    }
    (void)hipMemsetAsync(P.ws + W_CTL, 0, 1u << 20, stream);
    mega<<<grid, 512, LDS_BYTES, stream>>>(P);
}
```

```cpp
#include <hip/hip_runtime.h>
#include <cstdio>
#include <cstring>
#include <cmath>
#define HD __device__ static
#define UNROLL _Pragma("unroll")
#ifndef SEQ
#define SEQ 8192
#endif
#ifndef BATCH
#define BATCH 2
#endif
#ifndef DECB
#define DECB 128
#endif
typedef unsigned short bf16;
constexpr int D = 1024, NMETA = 16, TS = 4, PAST = 8192;
constexpr int NP = BATCH * SEQ, NM = BATCH * NMETA, NS = DECB * TS;
constexpr int ROW_META = NP, ROW_SAMP = NP + NM, NROWS = NP + NM + NS, MPAD = (NROWS + 255) / 256 * 256;
constexpr int SWA_N = 2560, MI = 2048, MH = 4, MD = 512, ML_N = 6144;
constexpr int LCH = 256, NCH = SEQ / LCH + 1;
constexpr int KCN = 160;
constexpr float EPS = 1e-6f;

enum { I_XP = 0, I_XS, I_CK, I_CV, I_CMK, I_CMV, I_SC, I_SN, I_SM, I_SCONV, I_META, I_RELB, I_NORMW, I_SWIN, I_SQN, I_SKN, I_SSINK, I_SWOUT,
       I_MWIN, I_MCW, I_MCB, I_MWQ, I_MWK, I_MWV, I_MWG, I_MBG, I_MHN, I_MSKIP, I_MWOUT, N_IN };
constexpr size_t O_YP = 0, O_YS = O_YP + (size_t)NP * D, O_PK = O_YS + (size_t)NS * D, O_PV = O_PK + (size_t)2 * BATCH * 128 * 256,
    O_PMK = O_PV + (size_t)2 * BATCH * 128 * 256, O_PMV = O_PMK + (size_t)2 * BATCH * 16 * 256, O_PC = O_PMV + (size_t)2 * BATCH * 16 * 256,
    O_PN = O_PC + (size_t)2 * BATCH * 4 * 512 * 512, O_PM = O_PN + (size_t)2 * BATCH * 4 * 512, O_PCONV = O_PM + (size_t)2 * BATCH * 4,
    O_SK = O_PCONV + (size_t)2 * BATCH * 3 * 2048, O_SV = O_SK + (size_t)2 * DECB * 128 * 256, O_SCC = O_SV + (size_t)2 * DECB * 128 * 256,
    O_SNN = O_SCC + (size_t)2 * DECB * 4 * 512 * 512, O_SMM = O_SNN + (size_t)2 * DECB * 4 * 512, O_SCONV = O_SMM + (size_t)2 * DECB * 4,
    O_END = O_SCONV + (size_t)2 * DECB * 3 * 2048;
constexpr size_t al(size_t x) { return (x + 255) / 256 * 256; }
constexpr size_t W_CTL = 0;
constexpr size_t W_X = 1u << 20;
constexpr size_t W_XN = W_X + al((size_t)MPAD * D * 4);
constexpr size_t W_SWIN = W_XN + al((size_t)MPAD * D * 2);
constexpr size_t W_SWOUT = W_SWIN + al((size_t)2 * SWA_N * D * 2);
constexpr size_t W_MWIN = W_SWOUT + al((size_t)2 * D * D * 2);
constexpr size_t W_MWQ = W_MWIN + al((size_t)2 * ML_N * D * 2);
constexpr size_t W_MWOUT = W_MWQ + al((size_t)2 * 3 * 4 * 512 * 512 * 2);
constexpr size_t W_G = W_MWOUT + al((size_t)2 * D * MI * 2);
constexpr size_t W_BIAS = W_G + al((size_t)2 * 4096 * 8 * 4);
constexpr size_t W_Q = W_BIAS + al(16 * 132 * 4);
constexpr size_t W_K = W_Q + al((size_t)MPAD * D * 2);
constexpr size_t W_VT = W_K + al((size_t)MPAD * 256 * 2);
constexpr size_t W_GS = W_VT + al((size_t)MPAD * 256 * 2);
constexpr size_t W_OG = W_GS + al((size_t)MPAD * D * 2);
constexpr size_t W_KC = W_OG + al((size_t)MPAD * D * 2);
constexpr size_t W_VTC = W_KC + al((size_t)2 * DECB * KCN * 256 * 2);
constexpr size_t W_XM = W_VTC + al((size_t)2 * DECB * KCN * 256 * 2);
constexpr size_t W_ZS = W_XM + al((size_t)MPAD * MI * 2);
constexpr size_t W_OS = W_ZS + al((size_t)MPAD * MI * 2);
constexpr size_t W_XC = W_OS + al((size_t)MPAD * MI * 2);
constexpr size_t W_GATES = W_XC + al((size_t)MPAD * MI * 2);
constexpr size_t W_MQ = W_GATES + al((size_t)MPAD * 8 * 4);
constexpr size_t W_MK = W_MQ + al((size_t)MPAD * MI * 2);
constexpr size_t W_MKT = W_MK + al((size_t)MPAD * MI * 2);
constexpr size_t W_MVT = W_MKT + al((size_t)MPAD * MI * 2);
constexpr size_t W_SA = W_MVT + al((size_t)(MPAD / 256) * 512 * 2048 * 2);
constexpr size_t W_SCJ = W_SA + al((size_t)MPAD * 4 * 4);
constexpr size_t W_SWI = W_SCJ + al((size_t)MPAD * 4 * 4);
constexpr size_t W_SEM = W_SWI + al((size_t)MPAD * 4 * 4);
constexpr size_t W_SWK = W_SEM + al((size_t)MPAD * 4 * 4);
constexpr size_t W_DEC = W_SWK + al((size_t)MPAD * 4 * 4);
constexpr size_t W_P = W_DEC + al((size_t)(BATCH * 4 * NCH + DECB * 4) * 4);
constexpr size_t W_DENI = W_P + al((size_t)NP * 2048 * 2);
constexpr size_t W_DEN = W_DENI + al((size_t)NP * 16 * 4);
constexpr size_t W_CT = W_DEN + al((size_t)MPAD * 4 * 4);
constexpr size_t W_CST = W_CT + al((size_t)BATCH * 4 * (NCH - 1) * 512 * 512 * 2);
constexpr size_t W_NST = W_CST + al((size_t)BATCH * 4 * 512 * 512 * 4);
constexpr size_t W_NRUN = W_NST + al((size_t)BATCH * 4 * NCH * 512 * 4);
constexpr size_t W_PSM = W_NRUN + al((size_t)BATCH * 4 * 512 * 4);
constexpr size_t W_H = W_PSM + al((size_t)(BATCH + DECB) * 4 * 256 * 4);
constexpr size_t W_A2 = W_H + al((size_t)MPAD * MI * 2);
constexpr size_t W_TMP = W_A2 + al((size_t)MPAD * MI * 2);
constexpr size_t W_END = W_TMP + al((size_t)MPAD * ML_N * 4);
constexpr size_t W_X16 = W_TMP;

struct Params {
    const float* in[N_IN];
    float* out;
    unsigned char* ws;
};
#define WSP(T, off) ((T*)(P.ws + (off)))

HD inline float bf2f(bf16 v) { unsigned u = (unsigned)v << 16; float f; __builtin_memcpy(&f, &u, 4); return f; }
HD inline bf16 f2bf(float f) { unsigned u; __builtin_memcpy(&u, &f, 4); u += 0x7fffu + ((u >> 16) & 1u); return (bf16)(u >> 16); }
HD inline float siluf(float x) { return x / (1.f + expf(-x)); }
HD inline float sigmf(float x) { return 1.f / (1.f + expf(-x)); }
HD inline float logsigf(float x) { return x >= 0.f ? -log1pf(expf(-x)) : x - log1pf(expf(x)); }

HD inline int swa_pos2orig(int n) { const int t = n & ~255, l = n & 255; return t + (((l >> 5) & 3) << 6) + ((l >> 7) << 5) + (l & 31); }
HD inline int swa_orig2pos(int o) { const int t = o & ~255, l = o & 255; return t + (((l >> 5) & 1) << 7) + ((l >> 6) << 5) + (l & 31); }

HD inline size_t vtb_idx(int row, int h, int e) { return ((size_t)(row >> 8) * 512 + e) * 2048 + h * 512 + (row & 255); }
HD inline size_t ctb_idx(int c, int b, int h, int e, int d) { return (((size_t)(c - 1) * BATCH + b) * 512 + e) * 2048 + h * 512 + d; }
HD inline int rel_bucket(int n) {
    if (n < 16) return n;
    int v = 16 + (int)(logf((float)n / 16.f) / 2.0794415416798357f * 16.f);
    return v > 31 ? 31 : v;
}

HD inline int prev_row(int r) {
    if (r < NP) { const int t = r % SEQ; return t > 0 ? r - 1 : ROW_META + (r / SEQ) * NMETA + (NMETA - 1); }
    if (r < ROW_SAMP) { const int i = (r - ROW_META) % NMETA; return i > 0 ? r - 1 : -1; }
    return ((r - ROW_SAMP) % TS) > 0 ? r - 1 : -2;
}

enum { PH_WCONV = 0, PH_GMAT, PH_INITX, PH_CACHE, PH_NORM, PH_S1E, PH_ATT, PH_RESID, PH_M1E, PH_CONV, PH_GATES, PH_SCAL, PH_PMAT, PH_STATE, PH_DEN, PH_NUM,
       PH_SMALLS, PH_SMALLM, PH_HNORM, PH_SWAOUT, PH_FINAL };

HD inline void ph_wconv(const Params& P, long gt, long gs) {
    for (int j = 0; j < 2; ++j) {
        { bf16* dst = WSP(bf16, W_SWIN) + (size_t)j * SWA_N * D; const float* src = P.in[I_SWIN] + (size_t)j * D * SWA_N;
          for (long i = gt; i < (long)SWA_N * D; i += gs) { const int n = (int)(i / D), k = (int)(i % D); dst[i] = f2bf(src[(size_t)k * SWA_N + swa_pos2orig(n)]); } }
        { bf16* dst = WSP(bf16, W_SWOUT) + (size_t)j * D * D; const float* src = P.in[I_SWOUT] + (size_t)j * D * D;
          for (long i = gt; i < (long)D * D; i += gs) { const int n = (int)(i / D), k = (int)(i % D); dst[i] = f2bf(src[(size_t)k * D + n]); } }
        { bf16* dst = WSP(bf16, W_MWIN) + (size_t)j * ML_N * D; const float* src = P.in[I_MWIN] + (size_t)j * D * ML_N;
          for (long i = gt; i < (long)ML_N * D; i += gs) { const int n = (int)(i / D), k = (int)(i % D); dst[i] = f2bf(src[(size_t)k * ML_N + n]); } }
        for (int w = 0; w < 3; ++w) { bf16* dst = WSP(bf16, W_MWQ) + (size_t)(j * 3 + w) * 4 * 512 * 512; const float* src = P.in[I_MWQ + w] + (size_t)j * 4 * 512 * 512;
          const float sc = (w == 1) ? 0.044194173824159216f : 1.f;
          for (long i = gt; i < (long)4 * 512 * 512; i += gs) { const int e = (int)(i >> 11), h = (int)((i >> 9) & 3), d = (int)(i & 511); dst[i] = f2bf(src[((size_t)h * 512 + d) * 512 + e] * sc); } }
        { bf16* dst = WSP(bf16, W_MWOUT) + (size_t)j * D * MI; const float* src = P.in[I_MWOUT] + (size_t)j * MI * D;
          for (long i = gt; i < (long)D * MI; i += gs) { const int n = (int)(i / MI), k = (int)(i % MI); dst[i] = f2bf(src[(size_t)k * D + n]); } }
    }
    { float* bt = WSP(float, W_BIAS); const float* rb = P.in[I_RELB];
      for (long i = gt; i < 16 * 132; i += gs) { const int h = (int)(i / 132), dd = (int)(i % 132); bt[i] = rb[rel_bucket(dd > 128 ? 128 : dd) * 16 + h]; } }
}
HD inline void ph_gmat(const Params& P, long gt, long gs) {
    float* G = WSP(float, W_G);
    for (long i = gt; i < 2L * 4096 * 8; i += gs) {
        const int j = (int)(i / (4096 * 8)), c = (int)((i / 8) % 4096), g = (int)(i % 8);
        const float* wg = P.in[I_MWG] + (size_t)j * 6144 * 8;
        float acc = 0.f;
        if (c < 2048) { const int h = c >> 9, d = c & 511;
            const float* wq = P.in[I_MWQ] + ((size_t)(j * 4 + h) * 512 + d) * 512; const float* wk = P.in[I_MWK] + ((size_t)(j * 4 + h) * 512 + d) * 512;
            float a = 0.f, b = 0.f;
            for (int e = 0; e < 512; ++e) { a += wq[e] * wg[(size_t)(h * 512 + e) * 8 + g]; b += wk[e] * wg[(size_t)(2048 + h * 512 + e) * 8 + g]; }
            acc = a + b * 0.044194173824159216f;
        } else { const int cc = c - 2048, h = cc >> 9, d = cc & 511;
            const float* wv = P.in[I_MWV] + ((size_t)(j * 4 + h) * 512 + d) * 512;
            for (int e = 0; e < 512; ++e) acc += wv[e] * wg[(size_t)(4096 + h * 512 + e) * 8 + g];
        }
        G[i] = acc;
    }
}
HD inline void ph_initx(const Params& P, long gt, long gs) {
    float* X = WSP(float, W_X);
    for (long i = gt; i < (long)MPAD * D; i += gs) { const int r = (int)(i / D), c = (int)(i % D); float v = 0.f;
        if (r < NP) v = P.in[I_XP][i]; else if (r < ROW_SAMP) v = P.in[I_META][(size_t)((r - ROW_META) % NMETA) * D + c]; else if (r < NROWS) v = P.in[I_XS][(size_t)(r - ROW_SAMP) * D + c];
        X[i] = v; }
}
HD inline void ph_cache(const Params& P, long gt, long gs) {
    bf16* KC = WSP(bf16, W_KC); bf16* VTC = WSP(bf16, W_VTC);
    for (long i = gt; i < 2L * DECB * KCN * 256; i += gs) {
        const int c = (int)(i % 256), key = (int)((i / 256) % KCN); const long jb = i / (256 * KCN);
        float kv = 0.f, vv = 0.f;
        if (key < 16) { kv = P.in[I_CMK][((size_t)jb * 16 + key) * 256 + c]; vv = P.in[I_CMV][((size_t)jb * 16 + key) * 256 + c]; }
        else if (key < 144) { kv = P.in[I_CK][((size_t)jb * 128 + key - 16) * 256 + c]; vv = P.in[I_CV][((size_t)jb * 128 + key - 16) * 256 + c]; }
        { KC[i] = f2bf(kv); VTC[((size_t)jb * 256 + c) * KCN + key] = f2bf(vv); }
    }
    for (long i = gt; i < 2L * DECB * 124 * 256; i += gs) { const int c = (int)(i % 256), key = (int)((i / 256) % 124); const long jb = i / (256 * 124);
        P.out[O_SK + ((size_t)jb * 128 + key) * 256 + c] = P.in[I_CK][((size_t)jb * 128 + key + 4) * 256 + c];
        P.out[O_SV + ((size_t)jb * 128 + key) * 256 + c] = P.in[I_CV][((size_t)jb * 128 + key + 4) * 256 + c]; }
}
HD inline void ph_norm(const Params& P, int layer, long gt, long gs) {
    const float* X = WSP(float, W_X); bf16* XN = WSP(bf16, W_XN); const float* w = P.in[I_NORMW] + (size_t)layer * D;
    for (long r = gt; r < MPAD; r += gs) {
        const float* x = X + (size_t)r * D; bf16* o = XN + (size_t)r * D;
        if (r >= NROWS) { for (int c = 0; c < D; ++c) o[c] = 0; continue; }
        float s = 0.f; for (int c = 0; c < D; ++c) s += x[c] * x[c];
        const float rs = 1.f / sqrtf(s / D + EPS);
        for (int c = 0; c < D; ++c) o[c] = f2bf(x[c] * rs * w[c]);
    }
}
HD inline void swa_store_kv(const Params& P, int j, int r, int kvh, int d, float val, bool isv) {
    if (!isv) WSP(bf16, W_K)[(size_t)r * 256 + kvh * 64 + d] = f2bf(val); else WSP(bf16, W_VT)[(size_t)(kvh * 64 + d) * MPAD + r] = f2bf(val);
}
HD inline void ph_swaout(const Params& P, int j, long gt, long gs) {
    const bf16* K = WSP(bf16, W_K); const bf16* VT = WSP(bf16, W_VT);
    constexpr int NOR = BATCH * 128 + NM + NS;
    for (long i = gt; i < (long)NOR * 256; i += gs) { const int c = (int)(i % 256); int q = (int)(i / 256); int r; size_t ok, ov;
        if (q < BATCH * 128) { const int b = q / 128, tt = q % 128; r = b * SEQ + SEQ - 128 + tt; ok = O_PK + (((size_t)j * BATCH + b) * 128 + tt) * 256 + c; ov = ok - O_PK + O_PV; }
        else if (q < BATCH * 128 + NM) { q -= BATCH * 128; r = ROW_META + q; ok = O_PMK + ((size_t)j * NM + q) * 256 + c; ov = ok - O_PMK + O_PMV; }
        else { q -= BATCH * 128 + NM; r = ROW_SAMP + q; const int bs = q / TS, t = q % TS; ok = O_SK + (((size_t)j * DECB + bs) * 128 + 124 + t) * 256 + c; ov = ok - O_SK + O_SV; }
        P.out[ok] = bf2f(K[(size_t)r * 256 + c]); P.out[ov] = bf2f(VT[(size_t)c * MPAD + r]); }
}
HD inline void ph_s1e(const Params& P, int j, long gt, long gs) {
    const float* T = WSP(float, W_TMP);
    for (long i = gt; i < (long)MPAD * 40; i += gs) {
        const int r = (int)(i / 40), g = (int)(i % 40);
        float x[64];
        UNROLL for (int d = 0; d < 64; ++d) x[d] = T[(size_t)r * SWA_N + swa_orig2pos(g * 64 + d)];
        if (g < 20) {
            float s = 0.f; UNROLL for (int d = 0; d < 64; ++d) s += x[d] * x[d];
            const float rs = 1.f / sqrtf(s / 64.f + EPS);
            if (g < 16) { const float* qn = P.in[I_SQN] + j * 64; bf16* Q = WSP(bf16, W_Q) + (size_t)r * D + g * 64;
                UNROLL for (int d = 0; d < 64; ++d) Q[d] = f2bf(x[d] * rs * qn[d] * 0.125f); }
            else { const float* kn = P.in[I_SKN] + j * 64; UNROLL for (int d = 0; d < 64; ++d) swa_store_kv(P, j, r, g - 16, d, x[d] * rs * kn[d], false); }
        } else if (g < 24) { UNROLL for (int d = 0; d < 64; ++d) swa_store_kv(P, j, r, g - 20, d, x[d], true); }
        else { bf16* GS = WSP(bf16, W_GS) + (size_t)r * D + (g - 24) * 64; UNROLL for (int d = 0; d < 64; ++d) GS[d] = f2bf(siluf(x[d])); }
    }
}
HD inline void att_key(const bf16* kp, const bf16* vp, long vstride, const bf16* q, float bias, float& m, float& l, float* o) {
    float s = 0.f; UNROLL for (int d = 0; d < 64; ++d) s += bf2f(q[d]) * bf2f(kp[d]);
    s += bias;
    if (s > m) { const float c = expf(m - s); l *= c; UNROLL for (int d = 0; d < 64; ++d) o[d] *= c; m = s; }
    const float p = expf(s - m); l += p;
    UNROLL for (int d = 0; d < 64; ++d) o[d] += p * bf2f(vp[(size_t)d * vstride]);
}
HD inline void ph_att(const Params& P, int j, long gt, long gs) {
    const bf16* Q = WSP(bf16, W_Q); const bf16* K = WSP(bf16, W_K); const bf16* VT = WSP(bf16, W_VT); const float* BT = WSP(float, W_BIAS);
    const bf16* GS = WSP(bf16, W_GS); bf16* OG = WSP(bf16, W_OG);
    for (long i = gt; i < (long)NROWS * 16; i += gs) {
        const int r = (int)(i / 16), h = (int)(i % 16), kvh = h >> 2;
        float o[64]; UNROLL for (int d = 0; d < 64; ++d) o[d] = 0.f; const bf16* q = Q + (size_t)r * D + h * 64;
        float m = P.in[I_SSINK][j * 16 + h], l = 1.f; const float* bt = BT + h * 132;
        if (r < ROW_SAMP) {
            int b, pos; if (r < NP) { b = r / SEQ; pos = r % SEQ + 16; } else { b = (r - ROW_META) / NMETA; pos = (r - ROW_META) % NMETA; }
            for (int mi = 0; mi < 16 && mi <= pos; ++mi) { const int kr = ROW_META + b * NMETA + mi; const int dist = pos - mi;
                att_key(K + (size_t)kr * 256 + kvh * 64, VT + (size_t)(kvh * 64) * MPAD + kr, MPAD, q, bt[dist > 128 ? 128 : dist], m, l, o); }
            if (r < NP) { const int t = pos - 16; for (int t2 = (t > 128 ? t - 128 : 0); t2 <= t; ++t2) { const int kr = b * SEQ + t2;
                att_key(K + (size_t)kr * 256 + kvh * 64, VT + (size_t)(kvh * 64) * MPAD + kr, MPAD, q, bt[t - t2], m, l, o); } }
        } else {
            const int bs = (r - ROW_SAMP) / TS, t = (r - ROW_SAMP) % TS;
            const bf16* kc = WSP(bf16, W_KC) + ((size_t)j * DECB + bs) * KCN * 256 + kvh * 64; const bf16* vc = WSP(bf16, W_VTC) + (((size_t)j * DECB + bs) * 256 + kvh * 64) * KCN;
            for (int key = 0; key < 148; ++key) {
                int dist; if (key < 16) dist = PAST + t - key; else if (key < 144) { dist = 128 + t - (key - 16); if (dist > 128) continue; } else { dist = t - (key - 144); if (dist < 0) continue; }
                if (key < 144) att_key(kc + (size_t)key * 256, vc + key, KCN, q, bt[dist > 128 ? 128 : dist], m, l, o);
                else { const int kr = ROW_SAMP + bs * TS + (key - 144); att_key(K + (size_t)kr * 256 + kvh * 64, VT + (size_t)(kvh * 64) * MPAD + kr, MPAD, q, bt[dist], m, l, o); } }
        }
        const float inv = 1.f / l;
        UNROLL for (int d = 0; d < 64; ++d) OG[(size_t)r * D + h * 64 + d] = f2bf(o[d] * inv * bf2f(GS[(size_t)r * D + h * 64 + d]));
    }
}
HD inline void ph_resid(const Params& P, int last, long gt, long gs) {
    float* X = WSP(float, W_X); const float* T = WSP(float, W_TMP);
    for (long i = gt; i < (long)NROWS * D; i += gs) { const float v = X[i] + T[i]; X[i] = v;
        if (last) { const int r = (int)(i / D); if (r < NP) P.out[O_YP + i] = v; else if (r >= ROW_SAMP) P.out[O_YS + (i - (size_t)ROW_SAMP * D)] = v; } }
}
HD inline void ph_m1e(const Params& P, int j, long gt, long gs) {
    const float* T = WSP(float, W_TMP); bf16* XM = WSP(bf16, W_XM); bf16* ZS = WSP(bf16, W_ZS); bf16* OS = WSP(bf16, W_OS);
    for (long i = gt; i < (long)MPAD * ML_N; i += gs) { const int r = (int)(i / ML_N), c = (int)(i % ML_N); const float v = T[i];
        if (c < 2048) { XM[(size_t)r * MI + c] = f2bf(v);
            if (r < NP) { const int b = r / SEQ, t = r % SEQ; if (t >= SEQ - 3) P.out[O_PCONV + (((size_t)j * BATCH + b) * 3 + (t - (SEQ - 3))) * 2048 + c] = v; }
            else if (r >= ROW_SAMP && r < NROWS) { const int bs = (r - ROW_SAMP) / TS, t = (r - ROW_SAMP) % TS; if (t >= 1) P.out[O_SCONV + (((size_t)j * DECB + bs) * 3 + (t - 1)) * 2048 + c] = v; } }
        else if (c < 4096) ZS[(size_t)r * MI + c - 2048] = f2bf(siluf(v));
        else OS[(size_t)r * MI + c - 4096] = f2bf(sigmf(v)); }
}
HD inline float conv_in(const Params& P, int j, int r, int back, int c) {
    int rr = r;
    for (int s = 0; s < back; ++s) { const int p = prev_row(rr);
        if (p == -1) return 0.f;
        if (p == -2) { const int bs = (r - ROW_SAMP) / TS; const int remaining = back - s;
            return P.in[I_SCONV][(((size_t)j * DECB + bs) * 3 + (3 - remaining)) * 2048 + c]; }
        rr = p; }
    return bf2f(WSP(bf16, W_XM)[(size_t)rr * MI + c]);
}
HD inline void ph_conv(const Params& P, int j, long gt, long gs) {
    bf16* XC = WSP(bf16, W_XC); const float* cw = P.in[I_MCW] + (size_t)j * 4 * 2048; const float* cb = P.in[I_MCB] + (size_t)j * 2048;
    for (long i = gt; i < (long)MPAD * MI; i += gs) { const int r = (int)(i / MI), c = (int)(i % MI);
        if (r >= NROWS) { XC[i] = 0; continue; }
        float a = cb[c];
        for (int w = 0; w < 4; ++w) a += conv_in(P, j, r, 3 - w, c) * cw[w * 2048 + c];
        XC[i] = f2bf(siluf(a)); }
}
HD inline void ph_gates(const Params& P, int j, long gt, long gs) {
    const bf16* XC = WSP(bf16, W_XC); const bf16* XM = WSP(bf16, W_XM); const float* G = WSP(float, W_G) + (size_t)j * 4096 * 8; float* GA = WSP(float, W_GATES);
    for (long i = gt; i < (long)NROWS * 8; i += gs) { const int r = (int)(i / 8), g = (int)(i % 8);
        float a = P.in[I_MBG][j * 8 + g];
        for (int c = 0; c < 2048; ++c) a += bf2f(XC[(size_t)r * MI + c]) * G[(size_t)c * 8 + g] + bf2f(XM[(size_t)r * MI + c]) * G[(size_t)(2048 + c) * 8 + g];
        GA[i] = a; }
}
HD inline void scal_chunk(const float* GA, int h, int row0, int L, float& m, float* SA, float* SCJ, float* SWI, float* SEM, float* SWK, float& decay) {
    float b = 0.f, pm = -3.0e38f; const float m_prev = m; float mt = m_prev;
    for (int t = 0; t < L; ++t) { const int r = row0 + t; const float ip = GA[(size_t)r * 8 + h], lf = logsigf(GA[(size_t)r * 8 + 4 + h]);
        b += lf; const float cj = ip - b; pm = cj > pm ? cj : pm; const float mx = m_prev > pm ? m_prev : pm;
        mt = b + mx; SA[r * 4 + h] = -mx; SCJ[r * 4 + h] = cj; SWI[r * 4 + h] = expf(m_prev - mx); SEM[r * 4 + h] = expf(-mt); }
    const float g = b, m_new = mt;
    for (int t = 0; t < L; ++t) { const int r = row0 + t; SWK[r * 4 + h] = expf(g + SCJ[r * 4 + h] - m_new); }
    decay = expf(g + m_prev - m_new); m = m_new;
}
HD inline void ph_scal(const Params& P, int j, long gt, long gs) {
    const float* GA = WSP(float, W_GATES); float* SA = WSP(float, W_SA); float* SCJ = WSP(float, W_SCJ); float* SWI = WSP(float, W_SWI); float* SEM = WSP(float, W_SEM); float* SWK = WSP(float, W_SWK);
    float* DEC = WSP(float, W_DEC);
    for (long i = gt; i < (long)(BATCH + DECB) * 4; i += gs) {
        if (i < BATCH * 4) { const int b = (int)(i / 4), h = (int)(i % 4); float m = 0.f;
            for (int c = 0; c < NCH; ++c) { float dec; const int row0 = c == 0 ? ROW_META + b * NMETA : b * SEQ + (c - 1) * LCH;
                scal_chunk(GA, h, row0, c == 0 ? NMETA : LCH, m, SA, SCJ, SWI, SEM, SWK, dec); DEC[(size_t)i * NCH + c] = dec; }
            P.out[O_PM + (size_t)j * BATCH * 4 + i] = m;
        } else { const long k = i - BATCH * 4; const int bs = (int)(k / 4), h = (int)(k % 4); float m = P.in[I_SM][(size_t)j * DECB * 4 + k]; float dec;
            scal_chunk(GA, h, ROW_SAMP + bs * TS, TS, m, SA, SCJ, SWI, SEM, SWK, dec); DEC[(size_t)BATCH * 4 * NCH + k] = dec;
            P.out[O_SMM + (size_t)j * DECB * 4 + k] = m; }
    }
}
HD inline void ph_pmat(const Params& P, long gt, long gs) {
    const bf16* Q = WSP(bf16, W_MQ); const bf16* K = WSP(bf16, W_MK); const float* SA = WSP(float, W_SA); const float* SCJ = WSP(float, W_SCJ); bf16* PM = WSP(bf16, W_P);
    for (long i = gt; i < (long)NP * 4 * 64; i += gs) { const int j4 = (int)(i % 64) * 4, h = (int)((i / 64) % 4), r = (int)(i / 256);
        const int tt = r % LCH, r0 = r - tt; const bf16* q = Q + (size_t)r * MI + h * 512;
        for (int jj = j4; jj < j4 + 4; ++jj) { float v = 0.f;
            if (jj <= tt) { const bf16* k = K + (size_t)(r0 + jj) * MI + h * 512; float s = 0.f; for (int d = 0; d < 512; ++d) s += bf2f(q[d]) * bf2f(k[d]);
                v = s * expf(SA[r * 4 + h] + SCJ[(r0 + jj) * 4 + h]); }
            PM[(size_t)r * 2048 + h * 512 + jj] = f2bf(v); } }
}
HD inline void ph_state(const Params& P, int j, int c, long gt, long gs) {
    const bf16* KT = WSP(bf16, W_MKT); const bf16* VT = WSP(bf16, W_MVT); const float* SWK = WSP(float, W_SWK); const float* DEC = WSP(float, W_DEC);
    float* CST = WSP(float, W_CST); bf16* CT = WSP(bf16, W_CT); float* NST = WSP(float, W_NST); float* NRUN = WSP(float, W_NRUN);
    const int L = c == 0 ? NMETA : LCH;
    for (long i = gt; i < (long)BATCH * 4 * 512 * 128; i += gs) { const int d4 = (int)(i % 128) * 4, e = (int)((i / 128) % 512), bh = (int)(i / (128 * 512)); const int b = bh / 4, h = bh % 4;
        const int row0 = c == 0 ? ROW_META + b * NMETA : b * SEQ + (c - 1) * LCH; const float dec = DEC[(size_t)bh * NCH + c];
        float acc[4] = {0.f, 0.f, 0.f, 0.f};
        const bf16* vt = VT + vtb_idx(row0, h, e);
        for (int t = 0; t < L; ++t) { const float wv = SWK[(row0 + t) * 4 + h] * bf2f(vt[t]);
            UNROLL for (int u = 0; u < 4; ++u) acc[u] += wv * bf2f(KT[(size_t)(h * 512 + d4 + u) * MPAD + row0 + t]); }
        UNROLL for (int u = 0; u < 4; ++u) { const size_t si = ((size_t)bh * 512 + e) * 512 + d4 + u; const float old = c == 0 ? 0.f : CST[si];
            if (c >= 1) CT[ctb_idx(c, b, h, e, d4 + u)] = f2bf(old);
            const float nv = dec * old + acc[u]; CST[si] = nv;
            if (c == NCH - 1) P.out[O_PC + (((size_t)j * BATCH * 4 + bh) * 512 + d4 + u) * 512 + e] = nv; }
        if (e == 0) UNROLL for (int u = 0; u < 4; ++u) { const int d = d4 + u; float a = 0.f;
            for (int t = 0; t < L; ++t) a += SWK[(row0 + t) * 4 + h] * bf2f(KT[(size_t)(h * 512 + d) * MPAD + row0 + t]);
            const float old = c == 0 ? 0.f : NRUN[bh * 512 + d]; NST[((size_t)bh * NCH + c) * 512 + d] = old; const float nv = dec * old + a; NRUN[bh * 512 + d] = nv;
            if (c == NCH - 1) P.out[O_PN + ((size_t)j * BATCH * 4 + bh) * 512 + d] = nv; }
    }
}
HD inline void ph_den(const Params& P, long gt, long gs) {
    const bf16* Q = WSP(bf16, W_MQ); const bf16* PM = WSP(bf16, W_P); const float* NST = WSP(float, W_NST); const float* SWI = WSP(float, W_SWI); float* DEN = WSP(float, W_DEN);
    for (long i = gt; i < (long)NP * 4; i += gs) { const int r = (int)(i / 4), h = (int)(i % 4), b = r / SEQ, c = (r % SEQ) / LCH + 1, bh = b * 4 + h;
        float s = 0.f; for (int jj = 0; jj < 256; ++jj) s += bf2f(PM[(size_t)r * 2048 + h * 512 + jj]);
        float qn = 0.f; const float* n = NST + ((size_t)bh * NCH + c) * 512; for (int d = 0; d < 512; ++d) qn += bf2f(Q[(size_t)r * MI + h * 512 + d]) * n[d];
        DEN[r * 4 + h] = s + SWI[r * 4 + h] * qn; }
}
HD inline void ph_num(const Params& P, long gt, long gs) {
    const bf16* Q = WSP(bf16, W_MQ); const bf16* PM = WSP(bf16, W_P); const bf16* CT = WSP(bf16, W_CT); const bf16* VT = WSP(bf16, W_MVT);
    const float* SWI = WSP(float, W_SWI); const float* SEM = WSP(float, W_SEM); const float* DEN = WSP(float, W_DEN); bf16* H = WSP(bf16, W_H);
    for (long i = gt; i < (long)NP * 4 * 128; i += gs) { const int e4 = (int)(i % 128) * 4, h = (int)((i / 128) % 4), r = (int)(i / 512); const int b = r / SEQ, tt = r % LCH, r0 = r - tt, c = (r % SEQ) / LCH + 1, bh = b * 4 + h;
        const bf16* q = Q + (size_t)r * MI + h * 512; const bf16* p = PM + (size_t)r * 2048 + h * 512;
        const float wi = SWI[r * 4 + h]; const float den = DEN[r * 4 + h]; const float dd = fmaxf(fabsf(den), SEM[r * 4 + h]);
        UNROLL for (int u = 0; u < 4; ++u) { const int e = e4 + u; const bf16* ct = CT + ctb_idx(c, b, h, e, 0);
            float a = 0.f; for (int d = 0; d < 512; ++d) a += bf2f(q[d]) * bf2f(ct[d]);
            a *= wi; const bf16* vt = VT + vtb_idx(r0, h, e);
            for (int jj = 0; jj <= tt; ++jj) a += bf2f(p[jj]) * bf2f(vt[jj]);
            H[(size_t)r * MI + h * 512 + e] = f2bf(a / dd); } }
}
HD inline void small_item(long it, int& h, int& row0, int& L, bool& samp, int& idx) {
    if (it < BATCH * 4) { idx = (int)(it / 4); h = (int)(it % 4); row0 = ROW_META + idx * NMETA; L = NMETA; samp = false; }
    else { const long k = it - BATCH * 4; idx = (int)(k / 4); h = (int)(k % 4); row0 = ROW_SAMP + idx * TS; L = TS; samp = true; }
}
HD inline void ph_smalls(const Params& P, int j, int only_meta, long gt, long gs) {
    const bf16* Q = WSP(bf16, W_MQ); const bf16* K = WSP(bf16, W_MK); const float* SA = WSP(float, W_SA); const float* SCJ = WSP(float, W_SCJ); const float* SWI = WSP(float, W_SWI);
    float* PSM = WSP(float, W_PSM); float* DEN = WSP(float, W_DEN);
    for (long i = gt; i < (long)(only_meta ? BATCH : BATCH + DECB) * 4 * 16; i += gs) { const long it = i / 16; const int t = (int)(i % 16); int h, row0, L, idx; bool samp; small_item(it, h, row0, L, samp, idx);
        if (t >= L) continue; const int r = row0 + t; const bf16* q = Q + (size_t)r * MI + h * 512; float s = 0.f;
        for (int jj = 0; jj < 16; ++jj) { float v = 0.f;
            if (jj <= t) { const bf16* k = K + (size_t)(row0 + jj) * MI + h * 512; float a = 0.f; for (int d = 0; d < 512; ++d) a += bf2f(q[d]) * bf2f(k[d]); v = a * expf(SA[r * 4 + h] + SCJ[(row0 + jj) * 4 + h]); }
            PSM[(size_t)it * 256 + t * 16 + jj] = v; s += v; }
        float qn = 0.f;
        if (samp) { const float* n = P.in[I_SN] + (((size_t)j * DECB + idx) * 4 + h) * 512; for (int d = 0; d < 512; ++d) qn += bf2f(q[d]) * n[d]; }
        DEN[r * 4 + h] = s + SWI[r * 4 + h] * qn; }
}
HD inline void ph_smallm(const Params& P, int j, int only_meta, long gt, long gs) {
    const bf16* Q = WSP(bf16, W_MQ); const bf16* K = WSP(bf16, W_MK); const bf16* VT = WSP(bf16, W_MVT); const float* PSM = WSP(float, W_PSM);
    const float* SWI = WSP(float, W_SWI); const float* SEM = WSP(float, W_SEM); const float* SWK = WSP(float, W_SWK); const float* DEN = WSP(float, W_DEN); const float* DEC = WSP(float, W_DEC); bf16* H = WSP(bf16, W_H);
    for (long i = gt; i < (long)(only_meta ? BATCH : BATCH + DECB) * 4 * 512; i += gs) { const long it = i / 512; const int x = (int)(i % 512); int h, row0, L, idx; bool samp; small_item(it, h, row0, L, samp, idx);
        float v[16];
        UNROLL for (int t = 0; t < 16; ++t) v[t] = t < L ? bf2f(VT[vtb_idx(row0 + t, h, x)]) : 0.f;
        float acc0 = 0.f, acc1 = 0.f, acc2 = 0.f, acc3 = 0.f;
        if (samp) { const size_t so = (((size_t)j * DECB + idx) * 4 + h) * 512 * 512; const float* cin = P.in[I_SC] + so; float* cout = P.out + O_SCC + so; const float dec = DEC[(size_t)BATCH * 4 * NCH + (it - BATCH * 4)];
            const float wv0 = SWK[(row0 + 0) * 4 + h] * v[0], wv1 = SWK[(row0 + 1) * 4 + h] * v[1], wv2 = SWK[(row0 + 2) * 4 + h] * v[2], wv3 = SWK[(row0 + 3) * 4 + h] * v[3];
            const bf16* q0 = Q + (size_t)row0 * MI + h * 512; const bf16* k0 = K + (size_t)row0 * MI + h * 512;
            for (int d = 0; d < 512; ++d) { const float ci = cin[(size_t)d * 512 + x]; float a = dec * ci;
                acc0 += bf2f(q0[d]) * ci; acc1 += bf2f(q0[MI + d]) * ci; acc2 += bf2f(q0[2 * MI + d]) * ci; acc3 += bf2f(q0[3 * MI + d]) * ci;
                a += wv0 * bf2f(k0[d]) + wv1 * bf2f(k0[MI + d]) + wv2 * bf2f(k0[2 * MI + d]) + wv3 * bf2f(k0[3 * MI + d]);
                cout[(size_t)d * 512 + x] = a; }
            const size_t no = (((size_t)j * DECB + idx) * 4 + h) * 512 + x; float a = dec * P.in[I_SN][no];
            for (int t = 0; t < 4; ++t) a += SWK[(row0 + t) * 4 + h] * bf2f(K[(size_t)(row0 + t) * MI + h * 512 + x]);
            P.out[O_SNN + no] = a; }
        UNROLL for (int t = 0; t < 16; ++t) { if (t < L) { const int r = row0 + t; const float ac = t == 0 ? acc0 : t == 1 ? acc1 : t == 2 ? acc2 : t == 3 ? acc3 : 0.f; float a = SWI[r * 4 + h] * ac;
            UNROLL for (int jj = 0; jj < 16; ++jj) if (jj <= t) a += PSM[(size_t)it * 256 + t * 16 + jj] * v[jj];
            H[(size_t)r * MI + h * 512 + x] = f2bf(a / fmaxf(fabsf(DEN[r * 4 + h]), SEM[r * 4 + h])); } } }
}
HD inline void ph_hnorm(const Params& P, int j, long gt, long gs) {
    const bf16* H = WSP(bf16, W_H); const bf16* OS = WSP(bf16, W_OS); const bf16* XC = WSP(bf16, W_XC); const bf16* ZS = WSP(bf16, W_ZS); bf16* A2 = WSP(bf16, W_A2);
    const float* hn = P.in[I_MHN] + (size_t)j * 2048; const float* sk = P.in[I_MSKIP] + (size_t)j * 2048;
    for (long i = gt; i < (long)MPAD * 4; i += gs) { const int r = (int)(i / 4), h = (int)(i % 4); const size_t o = (size_t)r * MI + h * 512;
        if (r >= NROWS) { for (int e = 0; e < 512; ++e) A2[o + e] = 0; continue; }
        float s = 0.f; for (int e = 0; e < 512; ++e) s += bf2f(H[o + e]); const float mu = s / 512.f;
        float q = 0.f; for (int e = 0; e < 512; ++e) { const float dlt = bf2f(H[o + e]) - mu; q += dlt * dlt; } const float rs = 1.f / sqrtf(q / 512.f + EPS);
        for (int e = 0; e < 512; ++e) { const int c = h * 512 + e; const float y = (bf2f(H[o + e]) - mu) * rs * hn[c];
            A2[o + e] = f2bf((bf2f(OS[o + e]) * y + sk[c] * bf2f(XC[o + e])) * bf2f(ZS[o + e])); } }
}

template <int PH> HD inline void dispatch(const Params& P, int a0, int a1, long gt, long gs) {
    if constexpr (PH == PH_WCONV) ph_wconv(P, gt, gs);
    else if constexpr (PH == PH_GMAT) ph_gmat(P, gt, gs);
    else if constexpr (PH == PH_INITX) ph_initx(P, gt, gs);
    else if constexpr (PH == PH_CACHE) ph_cache(P, gt, gs);
    else if constexpr (PH == PH_NORM) ph_norm(P, a0, gt, gs);
    else if constexpr (PH == PH_S1E) ph_s1e(P, a0, gt, gs);
    else if constexpr (PH == PH_ATT) ph_att(P, a0, gt, gs);
    else if constexpr (PH == PH_RESID) ph_resid(P, a0, gt, gs);
    else if constexpr (PH == PH_M1E) ph_m1e(P, a0, gt, gs);
    else if constexpr (PH == PH_CONV) ph_conv(P, a0, gt, gs);
    else if constexpr (PH == PH_GATES) ph_gates(P, a0, gt, gs);
    else if constexpr (PH == PH_SCAL) ph_scal(P, a0, gt, gs);
    else if constexpr (PH == PH_PMAT) ph_pmat(P, gt, gs);
    else if constexpr (PH == PH_STATE) ph_state(P, a0, a1, gt, gs);
    else if constexpr (PH == PH_DEN) ph_den(P, gt, gs);
    else if constexpr (PH == PH_NUM) ph_num(P, gt, gs);
    else if constexpr (PH == PH_SMALLS) ph_smalls(P, a0, a1, gt, gs);
    else if constexpr (PH == PH_SMALLM) ph_smallm(P, a0, a1, gt, gs);
    else if constexpr (PH == PH_HNORM) ph_hnorm(P, a0, gt, gs);
    else if constexpr (PH == PH_SWAOUT) ph_swaout(P, a0, gt, gs);
}
struct GemmDesc { const bf16* A; const bf16* B; void* C; long lda, ldb, ldc; int M, N, K, mode; };
HD inline void ph_gemm(const GemmDesc& g, long gt, long gs) {
    const int nm = g.M / 4, nn = g.N / 4;
    for (long i = gt; i < (long)nm * nn; i += gs) { const int m0 = (int)(i / nn) * 4, n0 = (int)(i % nn) * 4;
        float acc[4][4]; UNROLL for (int a = 0; a < 4; ++a) UNROLL for (int b = 0; b < 4; ++b) acc[a][b] = 0.f;
        for (int k = 0; k < g.K; k += 8) {
            float av[4][8], bv[4][8];
            UNROLL for (int a = 0; a < 4; ++a) UNROLL for (int kk = 0; kk < 8; ++kk) av[a][kk] = bf2f(g.A[(size_t)(m0 + a) * g.lda + k + kk]);
            UNROLL for (int b = 0; b < 4; ++b) UNROLL for (int kk = 0; kk < 8; ++kk) bv[b][kk] = bf2f(g.B[(size_t)(n0 + b) * g.ldb + k + kk]);
            UNROLL for (int a = 0; a < 4; ++a) UNROLL for (int b = 0; b < 4; ++b) UNROLL for (int kk = 0; kk < 8; ++kk) acc[a][b] += av[a][kk] * bv[b][kk];
        }
        UNROLL for (int a = 0; a < 4; ++a) UNROLL for (int b = 0; b < 4; ++b) { const float v = acc[a][b];
            if (g.mode == 0) ((float*)g.C)[(size_t)(m0 + a) * g.ldc + n0 + b] = v;
            else if (g.mode == 1) ((bf16*)g.C)[(size_t)(m0 + a) * g.ldc + n0 + b] = f2bf(v);
            else ((bf16*)g.C)[(size_t)(n0 + b) * g.ldc + m0 + a] = f2bf(v); }
    }
}
#define LAS __attribute__((address_space(3)))
#define XB_TMO      128
#define XB_XCNT(j)  (256  + 64 * (j))
#define XB_XSUB(j)  (1280 + 64 * (j))
#define XB_XGEN(j)  (2304 + 64 * (j))
#define XB_TOP      3328
#define XB_TOPGEN   3392
#define XCD_BAR_WORDS 3456
#define XB_SPIN_CAP (1u << 24)

__device__ __forceinline__ unsigned xb_ld(unsigned* p)              { return __hip_atomic_load(p, __ATOMIC_RELAXED, __HIP_MEMORY_SCOPE_AGENT); }
__device__ __forceinline__ unsigned xb_add(unsigned* p, unsigned v) { return __hip_atomic_fetch_add(p, v, __ATOMIC_RELAXED, __HIP_MEMORY_SCOPE_AGENT); }
__device__ __forceinline__ unsigned xb_xcc_id() { return (unsigned)__builtin_amdgcn_s_getreg((3 << 11) | 20) & 0xFu; }
#define XB_SPIN(cond, bar) do { unsigned _sp = 0; while (cond) { __builtin_amdgcn_s_sleep(1); \
    if ((++_sp & 255u) == 0u) { if (xb_ld(&(bar)[XB_TMO])) break; if (_sp > XB_SPIN_CAP) { atomicAdd(&(bar)[XB_TMO], 1u); break; } } } } while (0)

struct XcdBarrier {
    unsigned* bar; unsigned x;
    volatile LAS unsigned* st;
};

__device__ __forceinline__ XcdBarrier xcd_barrier_post(unsigned* bar, volatile LAS unsigned* st) {
    XcdBarrier b; b.bar = bar; b.x = xb_xcc_id(); b.st = st;
    if (threadIdx.x == 0) (void)xb_add(&bar[XB_XCNT(b.x)], 1u);
    return b;
}
__device__ __forceinline__ void xcd_barrier_complete(unsigned* bar, unsigned x, unsigned& nloc, unsigned& nx) {
    const unsigned G = gridDim.x * gridDim.y * gridDim.z;
    unsigned sum, cnt, mine, sp = 0u;
    for (;;) {
        sum = 0u; cnt = 0u; mine = 0u;
#pragma unroll
        for (unsigned j = 0; j < 16; ++j) { const unsigned c = xb_ld(&bar[XB_XCNT(j)]); sum += c; cnt += (c > 0u) ? 1u : 0u; mine = (j == x) ? c : mine; }
        if (sum == G) break;
        __builtin_amdgcn_s_sleep(1);
        if ((++sp & 255u) == 0u) { if (xb_ld(&bar[XB_TMO])) break; if (sp > XB_SPIN_CAP) { atomicAdd(&bar[XB_TMO], 1u); break; } }
    }
    nloc = mine > 0u ? mine : 1u; nx = cnt > 0u ? cnt : 1u;
}

__device__ __forceinline__ void xcd_barrier(const XcdBarrier& b) {
    asm volatile("s_waitcnt vmcnt(0)" ::: "memory");
    __syncthreads();
    if (threadIdx.x == 0) {
        unsigned* bar = b.bar;
        __builtin_amdgcn_s_waitcnt(0);
        unsigned nloc = b.st[0], nx = b.st[1];
        if (nloc == 0u) { xcd_barrier_complete(bar, b.x, nloc, nx); b.st[0] = nloc; b.st[1] = nx; }
        const unsigned old = xb_add(&bar[XB_XSUB(b.x)], 1u);
        const unsigned gen = old / nloc;
        if (old + 1u == (gen + 1u) * nloc) {
            __builtin_amdgcn_fence(__ATOMIC_RELEASE, "agent");
            asm volatile("s_waitcnt vmcnt(0)" ::: "memory");
            const unsigned og = xb_add(&bar[XB_TOP], 1u);
            const unsigned tg = og / nx;
            if (og + 1u == (tg + 1u) * nx) xb_add(&bar[XB_TOPGEN], 1u);
            else XB_SPIN(xb_ld(&bar[XB_TOPGEN]) == tg, bar);
            __builtin_amdgcn_fence(__ATOMIC_ACQUIRE, "agent");
            xb_add(&bar[XB_XGEN(b.x)], 1u);
            asm volatile("s_waitcnt vmcnt(0)" ::: "memory");
        } else {
            XB_SPIN(xb_ld(&bar[XB_XGEN(b.x)]) == gen, bar);
            __builtin_amdgcn_fence(__ATOMIC_ACQUIRE, "agent");
            asm volatile("s_waitcnt vmcnt(0)" ::: "memory");
        }
    }
    __syncthreads();
}

#define WSP2(PP, T, off) ((T*)((PP).ws + (off)))
namespace pg8 {
typedef short bf16x8 __attribute__((ext_vector_type(8)));
typedef float f32x4 __attribute__((ext_vector_type(4)));
typedef unsigned u32x2 __attribute__((ext_vector_type(2)));
constexpr int BM = 256, BK = 64, HALF = 128, HTB = HALF * BK * 2, STAGE_BYTES = 8 * HTB;
__device__ __forceinline__ int lds_byte(int r, int c) { const int st = (r >> 4) * 2 + (c >> 5), rr = r & 15, cc = c & 31, ob = rr * 64 + cc * 2; return st * 1024 + (ob ^ (((ob >> 9) & 1) << 5)); }
__device__ __forceinline__ void stage_rc(int b, int& R, int& C) { const int st = b / 1024, sb = b % 1024, swz = sb ^ (((sb >> 9) & 1) << 5); R = (st >> 1) * 16 + swz / 64; C = (st & 1) * 32 + (swz % 64) / 2; }
__device__ __forceinline__ unsigned cvt_pk_bf16(float lo, float hi) {
    typedef __bf16 b2_t __attribute__((ext_vector_type(2))); typedef float f2_t __attribute__((ext_vector_type(2)));
    const f2_t v = {lo, hi}; const b2_t r = __builtin_convertvector(v, b2_t); return __builtin_bit_cast(unsigned, r); }
__device__ __forceinline__ int perm32(int rho) { const int n = rho >> 4, i = rho & 15; return 8 * (i >> 2) + 4 * n + (i & 3); }
struct Unit { const char* A; const char* B; int pm, pn, aux, nt; };
template <class Epi, class Sched>
__device__ __forceinline__ void gemm_phase(LAS unsigned char* lds, const int lda, const int ldb, const Sched& S, const Epi& E) {
    int tid = threadIdx.x; asm volatile("" : "+v"(tid));
    const int wid = __builtin_amdgcn_readfirstlane(tid >> 6), lane = tid & 63, wr = wid >> 2, wc = wid & 3, fr = lane & 15, fq = lane >> 4;
    unsigned voffA[2], voffB[2];
#pragma unroll
    for (int i = 0; i < 2; ++i) { int R, C; stage_rc(tid * 16 + i * 8192, R, C); const int Rb = Epi::PERM ? ((R & ~31) + perm32(R & 31)) : R;
        voffA[i] = (unsigned)(R * lda + C) * 2u; voffB[i] = (unsigned)(Rb * ldb + C) * 2u; }
    const size_t kstep = (size_t)(BK * 2);
    const size_t hstepA = (size_t)HALF * lda * 2, hstepB = (size_t)HALF * ldb * 2;
    const unsigned ldsw = (unsigned)wid * 1024u;
    const int aoff = lds_byte(wr * 64 + fr, fq * 8), boff = lds_byte(wc * 32 + fr, fq * 8);
#define PG8_SA(b, h) (((b) * 2 + (h)) * HTB)
#define PG8_SB(b, h) ((4 + (b) * 2 + (h)) * HTB)
#define PG8_STAGE(bufoff, gbase, voff) do { _Pragma("unroll") for (int _i = 0; _i < 2; ++_i) \
        __builtin_amdgcn_global_load_lds((const unsigned*)((const char*)(gbase) + (voff)[_i]), (LAS unsigned*)(lds + (bufoff) + ldsw + _i * 8192), 16, 0, 0); } while (0)
#define PG8_LDA(dst, b, h) do { _Pragma("unroll") for (int m = 0; m < 4; ++m) _Pragma("unroll") for (int k = 0; k < 2; ++k) dst[m][k] = *(const LAS bf16x8*)(lds + PG8_SA(b, h) + aoff + m * 2048 + k * 1024); } while (0)
#define PG8_LDB(dst, b, h) do { _Pragma("unroll") for (int n = 0; n < 2; ++n) _Pragma("unroll") for (int k = 0; k < 2; ++k) dst[n][k] = *(const LAS bf16x8*)(lds + PG8_SB(b, h) + boff + n * 2048 + k * 1024); } while (0)
#define PG8_MMA(ai, bj, At, Bt) do { __builtin_amdgcn_s_setprio(1); _Pragma("unroll") for (int m = 0; m < 4; ++m) _Pragma("unroll") for (int n = 0; n < 2; ++n) _Pragma("unroll") for (int k = 0; k < 2; ++k) \
        acc[ai][bj][m][n] = __builtin_amdgcn_mfma_f32_16x16x32_bf16(Bt[n][k], At[m][k], acc[ai][bj][m][n], 0, 0, 0); __builtin_amdgcn_s_setprio(0); } while (0)
#define PG8_WAIT_V(n) asm volatile("s_waitcnt vmcnt(" #n ")" ::: "memory")
#define PG8_WAIT_L(n) asm volatile("s_waitcnt lgkmcnt(" #n ")" ::: "memory")
#define PG8_BAR __builtin_amdgcn_s_barrier()
#define PG8_SCHED __builtin_amdgcn_sched_barrier(0)
    Unit cur, nxt; int ui = 0;
    if (!S.next(0, cur)) return;
    f32x4 acc[2][2][4][2];
#pragma unroll
    for (int a = 0; a < 2; ++a)
#pragma unroll
        for (int b = 0; b < 2; ++b)
#pragma unroll
            for (int m = 0; m < 4; ++m)
#pragma unroll
                for (int n = 0; n < 2; ++n) acc[a][b][m][n] = (f32x4){0.f, 0.f, 0.f, 0.f};
    bf16x8 At[4][2], B0[2][2], B1[2][2];
    const char* cA = cur.A; const char* cB = cur.B;
    PG8_STAGE(PG8_SB(0, 0), cB, voffB); PG8_STAGE(PG8_SB(0, 1), cB + hstepB, voffB); PG8_STAGE(PG8_SA(0, 0), cA, voffA); PG8_STAGE(PG8_SA(0, 1), cA + hstepA, voffA);
    if (wr == 1) PG8_BAR;
    PG8_WAIT_V(2); PG8_BAR;
    PG8_STAGE(PG8_SB(1, 0), cB + kstep, voffB); PG8_STAGE(PG8_SA(1, 0), cA + kstep, voffA); PG8_STAGE(PG8_SB(1, 1), cB + hstepB + kstep, voffB);
    PG8_WAIT_V(6); PG8_BAR;
    for (;;) {
        const bool has_next = S.next(ui + 1, nxt);
        const char* nA = has_next ? nxt.A : cA; const char* nB = has_next ? nxt.B : cB; const int nt = cur.nt;
        for (int t = 0; t < nt; t += 2) {
            const bool last = (t == nt - 2);
            const char* a1 = cA + (size_t)(t + 1) * kstep;
            const char* a2 = last ? nA : cA + (size_t)(t + 2) * kstep; const char* b2 = last ? nB : cB + (size_t)(t + 2) * kstep;
            const char* a3 = a2 + kstep; const char* b3 = b2 + kstep;
            PG8_LDB(B0, 0, 0); PG8_LDB(B1, 0, 1); PG8_SCHED; PG8_LDA(At, 0, 0); PG8_STAGE(PG8_SA(1, 1), a1 + hstepA, voffA);
            PG8_WAIT_V(8); PG8_WAIT_L(0); PG8_BAR; PG8_MMA(0, 0, At, B0); PG8_MMA(0, 1, At, B1); PG8_BAR; PG8_SCHED;
            PG8_LDA(At, 0, 1); PG8_STAGE(PG8_SB(0, 0), b2, voffB); PG8_STAGE(PG8_SB(0, 1), b2 + hstepB, voffB); PG8_STAGE(PG8_SA(0, 0), a2, voffA);
            PG8_WAIT_V(8); PG8_WAIT_L(0); PG8_BAR; PG8_MMA(1, 0, At, B0); PG8_MMA(1, 1, At, B1); PG8_BAR; PG8_SCHED;
            PG8_LDB(B0, 1, 0); PG8_LDB(B1, 1, 1); PG8_SCHED; PG8_LDA(At, 1, 0); PG8_STAGE(PG8_SA(0, 1), a2 + hstepA, voffA);
            PG8_WAIT_V(8); PG8_WAIT_L(0); PG8_BAR; PG8_MMA(0, 0, At, B0); PG8_MMA(0, 1, At, B1); PG8_BAR; PG8_SCHED;
            PG8_LDA(At, 1, 1); PG8_STAGE(PG8_SB(1, 0), b3, voffB); PG8_STAGE(PG8_SB(1, 1), b3 + hstepB, voffB); PG8_STAGE(PG8_SA(1, 0), a3, voffA);
            PG8_WAIT_V(8); PG8_WAIT_L(0); PG8_BAR; PG8_MMA(1, 0, At, B0); PG8_MMA(1, 1, At, B1); PG8_BAR; PG8_SCHED;
        }
        if (wr == 0) PG8_BAR;
        const bool keep = E(acc, cur, wr, wc, fr, fq);
        if (!has_next) break;
        if (!keep) {
#pragma unroll
        for (int a = 0; a < 2; ++a)
#pragma unroll
            for (int b = 0; b < 2; ++b)
#pragma unroll
                for (int m = 0; m < 4; ++m)
#pragma unroll
                    for (int n = 0; n < 2; ++n) acc[a][b][m][n] = (f32x4){0.f, 0.f, 0.f, 0.f};
        }
        cur = nxt; cA = nA; cB = nB; ++ui;
        if (wr == 1) PG8_BAR;
    }
    PG8_WAIT_V(0);
    PG8_BAR;
#undef PG8_SA
#undef PG8_SB
#undef PG8_STAGE
#undef PG8_LDA
#undef PG8_LDB
#undef PG8_MMA
#undef PG8_WAIT_V
#undef PG8_WAIT_L
#undef PG8_BAR
#undef PG8_SCHED
}
struct PlainOrder {
    const char* A; const char* B; size_t tstepA, tstepB; int nM, nN, nwg, G, c, nt;
    __device__ __forceinline__ void init(const bf16* A_, int lda, const bf16* B_, int ldb, int M, int N, int K, int G_, int c_) { nt = K / BK;
        A = (const char*)A_; B = (const char*)B_; tstepA = (size_t)BM * lda * 2; tstepB = (size_t)BM * ldb * 2; nM = M / BM; nN = N / BM; nwg = nM * nN; G = G_; c = c_; }
    __device__ __forceinline__ bool next(int i, Unit& u) const {
        const long L = (long)i * G + c; if (L >= nwg) return false;
        int wgid = (int)L; { const int q = nwg / 8, r = nwg % 8, xcd = wgid % 8, off = wgid / 8; wgid = (xcd < r ? xcd * (q + 1) : r * (q + 1) + (xcd - r) * q) + off; }
        const int nig = 8 * nN, gid = wgid / nig, fm = gid * 8, gsz = (nM - fm) < 8 ? (nM - fm) : 8;
        u.pm = fm + ((wgid % nig) % gsz); u.pn = (wgid % nig) / gsz; u.aux = 0; u.nt = nt;
        u.A = A + (size_t)u.pm * tstepA; u.B = B + (size_t)u.pn * tstepB; return true;
    }
};
struct SplitTailOrder {
    const char* A; const char* B; size_t tstepA, tstepB; int K, nmain, G, c, nM;
    __device__ __forceinline__ void init(const bf16* A_, int lda, const bf16* B_, int ldb, int K_, int G_, int c_) {
        A = (const char*)A_; B = (const char*)B_; tstepA = (size_t)BM * lda * 2; tstepB = (size_t)BM * ldb * 2; K = K_; nM = NP / BM; nmain = nM * 4; G = G_; c = c_; }
    __device__ __forceinline__ bool next(int i, Unit& u) const {
        const long L = (long)i * G + c;
        if (L < nmain) { int wgid = (int)L; { const int q = nmain / 8, r = nmain % 8, xcd = wgid % 8, off = wgid / 8; wgid = (xcd < r ? xcd * (q + 1) : r * (q + 1) + (xcd - r) * q) + off; }
            const int nig = 8 * 4, gid = wgid / nig, fm = gid * 8, gsz = (nM - fm) < 8 ? (nM - fm) : 8;
            u.pm = fm + ((wgid % nig) % gsz); u.pn = (wgid % nig) / gsz; u.aux = 0; u.nt = K / BK; u.A = A + (size_t)u.pm * tstepA; u.B = B + (size_t)u.pn * tstepB; return true; }
        const int s = (int)(L - nmain); if (s >= (MPAD / BM - nM) * 16) return false;
        const int kq = s & 3; u.pn = (s >> 2) & 3; u.pm = nM + (s >> 4); u.aux = 1; u.nt = K / BK / 4;
        u.A = A + (size_t)u.pm * tstepA + (size_t)kq * (K / 4) * 2; u.B = B + (size_t)u.pn * tstepB + (size_t)kq * (K / 4) * 2; return true;
    }
};
}
namespace pg8 {
__device__ __forceinline__ u32x2 pk4(f32x4 v) { u32x2 w; w.x = cvt_pk_bf16(v[0], v[1]); w.y = cvt_pk_bf16(v[2], v[3]); return w; }
typedef unsigned u32x4e __attribute__((ext_vector_type(4)));
__device__ __forceinline__ u32x4e pk8(f32x4 a, f32x4 b) { u32x4e w; w[0] = cvt_pk_bf16(a[0], a[1]); w[1] = cvt_pk_bf16(a[2], a[3]); w[2] = cvt_pk_bf16(b[0], b[1]); w[3] = cvt_pk_bf16(b[2], b[3]); return w; }
__device__ __forceinline__ float silu_fast(float x) { return x * __builtin_amdgcn_rcpf(1.f + __expf(-x)); }
__device__ __forceinline__ float sigm_fast(float x) { return __builtin_amdgcn_rcpf(1.f + __expf(-x)); }

struct EpiResid {
    static constexpr bool PERM = false;
    const float* xin; bf16* X16; float* X32; float* out; int mode; long dummy_off;
    __device__ __forceinline__ bool operator()(f32x4 (&acc)[2][2][4][2], const Unit& u, int wr, int wc, int fr_, int fq_) const {
        int fr = fr_, fq = fq_; asm volatile("" : "+v"(fr), "+v"(fq));
        const int row0 = u.pm * BM + wr * 64 + fr, col0 = u.pn * BM + wc * 32 + 4 * fq;
        if (u.aux == 1) {
#pragma unroll
            for (int ai = 0; ai < 2; ++ai)
#pragma unroll
                for (int m = 0; m < 4; ++m) { const int row = row0 + ai * HALF + m * 16;
                    if (row < NROWS) { float* ap = X32 + (size_t)row * D + col0 + dummy_off;
#pragma unroll
                        for (int bj = 0; bj < 2; ++bj)
#pragma unroll
                            for (int n = 0; n < 2; ++n)
#pragma unroll
                                for (int e = 0; e < 4; ++e) __hip_atomic_fetch_add(ap + bj * HALF + n * 16 + e, acc[ai][bj][m][n][e], __ATOMIC_RELAXED, __HIP_MEMORY_SCOPE_AGENT); } }
            return false;
        }
#pragma unroll
        for (int ai = 0; ai < 2; ++ai) { f32x4 xv[4][2][2];
#pragma unroll
            for (int m = 0; m < 4; ++m) { const size_t o = (size_t)(row0 + ai * HALF + m * 16) * D + col0;
#pragma unroll
                for (int bj = 0; bj < 2; ++bj)
#pragma unroll
                    for (int n = 0; n < 2; ++n) {
                        if (mode == 0) xv[m][bj][n] = __builtin_nontemporal_load((const f32x4*)(xin + o + bj * HALF + n * 16));
                        else { const u32x2 t = *(const u32x2*)(X16 + o + bj * HALF + n * 16); xv[m][bj][n] = (f32x4){__uint_as_float(t.x << 16), __uint_as_float(t.x & 0xffff0000u), __uint_as_float(t.y << 16), __uint_as_float(t.y & 0xffff0000u)}; } } }
#pragma unroll
            for (int m = 0; m < 4; ++m) { const size_t o = (size_t)(row0 + ai * HALF + m * 16) * D + col0;
#pragma unroll
                for (int bj = 0; bj < 2; ++bj)
#pragma unroll
                    for (int n = 0; n < 2; ++n) { const f32x4 v = xv[m][bj][n] + acc[ai][bj][m][n];
                        if (dummy_off) *(u32x2*)(X16 + (size_t)NP * D + o + bj * HALF + n * 16) = pk4(v);
                        else if (mode == 2) __builtin_nontemporal_store(v, (f32x4*)(out + O_YP + o + bj * HALF + n * 16));
                        else *(u32x2*)(X16 + o + bj * HALF + n * 16) = pk4(v); } }
            asm volatile("" ::: "memory"); }
        return false;
    }
};
struct EpiSwaIn {
    static constexpr bool PERM = true;
    Params P; int j;
    __device__ __forceinline__ static float rownorm(const f32x4 (&acc)[2][2][4][2], int ai, int m) {
        float ss = 0.f;
#pragma unroll
        for (int bj = 0; bj < 2; ++bj)
#pragma unroll
            for (int n = 0; n < 2; ++n) { const f32x4 x = acc[ai][bj][m][n]; ss += (x[0] * x[0] + x[1] * x[1]) + (x[2] * x[2] + x[3] * x[3]); }
        ss += __shfl_xor(ss, 16); ss += __shfl_xor(ss, 32);
        return 1.f / sqrtf(ss * (1.f / 64.f) + EPS);
    }
    __device__ __forceinline__ bool operator()(f32x4 (&acc)[2][2][4][2], const Unit& u, int wr, int wc, int fr_, int fq_) const {
        int fr = fr_, fq = fq_; asm volatile("" : "+v"(fr), "+v"(fq));
        const int row0 = u.pm * BM + wr * 64 + fr, pn = u.pn;
        if (pn < 5) { const bool isq = pn < 4; const float* nw = (isq ? P.in[I_SQN] : P.in[I_SKN]) + j * 64 + 8 * fq;
            bf16* dst = isq ? WSP(bf16, W_Q) + (size_t)row0 * D + (pn * 4 + wc) * 64 + 8 * fq : WSP(bf16, W_K) + (size_t)row0 * 256 + wc * 64 + 8 * fq; const size_t ld = isq ? D : 256;
            const float sc = isq ? 0.18033688011112042f   : 1.f;
            const f32x4 w00 = *(const f32x4*)(nw), w01 = *(const f32x4*)(nw + 4), w10 = *(const f32x4*)(nw + 32), w11 = *(const f32x4*)(nw + 36);
#pragma unroll
            for (int ai = 0; ai < 2; ++ai)
#pragma unroll
                for (int m = 0; m < 4; ++m) { const float rs = rownorm(acc, ai, m) * sc; bf16* qp = dst + (size_t)(ai * HALF + m * 16) * ld;
                    *(u32x4e*)(qp) = pk8(acc[ai][0][m][0] * w00 * rs, acc[ai][0][m][1] * w01 * rs);
                    *(u32x4e*)(qp + 32) = pk8(acc[ai][1][m][0] * w10 * rs, acc[ai][1][m][1] * w11 * rs); }
        } else if (pn == 5) { bf16* VT = WSP(bf16, W_VT) + (size_t)(wc * 64 + 8 * fq) * MPAD + row0;
#pragma unroll
            for (int ai = 0; ai < 2; ++ai)
#pragma unroll
                for (int m = 0; m < 4; ++m) {
#pragma unroll
                    for (int bj = 0; bj < 2; ++bj)
#pragma unroll
                        for (int n = 0; n < 2; ++n) { const f32x4 v = acc[ai][bj][m][n]; const int dd = 32 * bj + 4 * n;
#pragma unroll
                            for (int e = 0; e < 4; ++e) VT[(size_t)(dd + e) * MPAD + ai * HALF + m * 16] = f2bf(v[e]); } }
        } else { bf16* GS = WSP(bf16, W_GS) + (size_t)row0 * D + (pn - 6) * 256 + wc * 64 + 8 * fq;
#pragma unroll
            for (int ai = 0; ai < 2; ++ai)
#pragma unroll
                for (int m = 0; m < 4; ++m) { bf16* gp = GS + (size_t)(ai * HALF + m * 16) * D;
#pragma unroll
                    for (int bj = 0; bj < 2; ++bj) { f32x4 v0, v1;
#pragma unroll
                        for (int e = 0; e < 4; ++e) { v0[e] = silu_fast(acc[ai][bj][m][0][e]); v1[e] = silu_fast(acc[ai][bj][m][1][e]); }
                        *(u32x4e*)(gp + 32 * bj) = pk8(v0, v1); } }
        }
        return false;
    }
};
struct EpiMlIn {
    static constexpr bool PERM = true;
    Params P; int j;
    __device__ __forceinline__ bool operator()(f32x4 (&acc)[2][2][4][2], const Unit& u, int wr, int wc, int fr_, int fq_) const {
        int fr = fr_, fq = fq_; asm volatile("" : "+v"(fr), "+v"(fq));
        const int row0 = u.pm * BM + wr * 64 + fr, pn = u.pn, kind = pn >> 3, col0 = (pn & 7) * BM + wc * 32 + 8 * fq;
        bf16* dst = kind == 0 ? WSP(bf16, W_XM) : kind == 1 ? WSP(bf16, W_ZS) : WSP(bf16, W_OS);
#pragma unroll
        for (int ai = 0; ai < 2; ++ai)
#pragma unroll
            for (int m = 0; m < 4; ++m) { const int row = row0 + ai * HALF + m * 16; bf16* dp = dst + (size_t)row * MI + col0;
                float* op = nullptr;
                if (kind == 0) { if (row < NP) { const int b = row / SEQ, t = row % SEQ; if (t >= SEQ - 3) op = P.out + O_PCONV + (((size_t)j * BATCH + b) * 3 + (t - (SEQ - 3))) * 2048 + col0; }
                    else if (row >= ROW_SAMP && row < NROWS) { const int bs = (row - ROW_SAMP) / TS, t = (row - ROW_SAMP) % TS; if (t >= 1) op = P.out + O_SCONV + (((size_t)j * DECB + bs) * 3 + (t - 1)) * 2048 + col0; } }
#pragma unroll
                for (int bj = 0; bj < 2; ++bj) { const f32x4 x0 = acc[ai][bj][m][0], x1 = acc[ai][bj][m][1]; f32x4 v0 = x0, v1 = x1;
                    if (kind == 1) {
#pragma unroll
                        for (int e = 0; e < 4; ++e) { v0[e] = silu_fast(x0[e]); v1[e] = silu_fast(x1[e]); } }
                    if (kind == 2) {
#pragma unroll
                        for (int e = 0; e < 4; ++e) { v0[e] = sigm_fast(x0[e]); v1[e] = sigm_fast(x1[e]); } }
                    *(u32x4e*)(dp + bj * HALF) = pk8(v0, v1);
                    if (op) { *(f32x4*)(op + bj * HALF) = x0; *(f32x4*)(op + bj * HALF + 4) = x1; } } }
        return false;
    }
};
struct EpiM3 {
    static constexpr bool PERM = true;
    Params P;
    __device__ __forceinline__ bool operator()(f32x4 (&acc)[2][2][4][2], const Unit& u, int wr, int wc, int fr_, int fq_) const {
        int fr = fr_, fq = fq_; asm volatile("" : "+v"(fr), "+v"(fq));
        const int kind = u.aux >> 2, h = u.aux & 3;
        bf16* C; size_t ldc;
        if (kind == 0) { C = WSP(bf16, W_MQ) + h * 512; ldc = MI; } else if (kind == 1) { C = WSP(bf16, W_MK) + h * 512; ldc = MI; }
        else if (kind == 2) { C = WSP(bf16, W_MKT) + (size_t)h * 512 * MPAD; ldc = MPAD; } else { C = WSP(bf16, W_MVT) + (size_t)u.pn * 512 * 2048 + h * 512; ldc = 2048; }
        const int row0 = u.pm * BM + wr * 64 + fr, col0 = (kind == 3 ? 0 : u.pn * BM) + wc * 32 + 8 * fq;
#pragma unroll
        for (int ai = 0; ai < 2; ++ai)
#pragma unroll
            for (int m = 0; m < 4; ++m) { bf16* dp = C + (size_t)(row0 + ai * HALF + m * 16) * ldc + col0;
#pragma unroll
                for (int bj = 0; bj < 2; ++bj) *(u32x4e*)(dp + bj * HALF) = pk8(acc[ai][bj][m][0], acc[ai][bj][m][1]); }
        return false;
    }
};
struct M3Order {
    const char* XC; const char* XM; const char* W; int ntt, Gp, c, kmode;
    __device__ __forceinline__ bool next(int i, Unit& u) const {
        const int x = c & 7, r = c >> 3, nx = (Gp - x + 7) >> 3, id = i * nx + r;
        if (id >= ntt * 3) return false;
        const int tt = id / 3, kk = id - 3 * tt, kind = kk == 2 ? 3 : kk;
        const int h = x >> 1, half = x & 1;
        const char* act = (kind == 3 ? XM : XC) + ((size_t)tt * 256 * MI + h * 512) * 2;
        const char* w = W + ((size_t)(kind == 0 ? 0 : kind == 3 ? 2 : 1) * 512 * MI + (size_t)half * 256 * MI + h * 512) * 2;
        u.aux = kind * 4 + h; u.nt = 8;
        if (kind < 2) { u.A = act; u.B = w; u.pm = tt; u.pn = half; } else { u.A = w; u.B = act; u.pm = half; u.pn = tt; }
        return true;
    }
};
struct EpiP {
    static constexpr bool PERM = true;
    Params P;
    __device__ __forceinline__ bool operator()(f32x4 (&acc)[2][2][4][2], const Unit& u, int wr, int wc, int fr_, int fq_) const {
        int fr = fr_, fq = fq_; asm volatile("" : "+v"(fr), "+v"(fq));
        const int h = u.aux, r0 = u.pm * BM; const float* SA = WSP(float, W_SA); const float* SCJ = WSP(float, W_SCJ); bf16* PB = WSP(bf16, W_P); float* DENI = WSP(float, W_DENI);
        float cj[2][2][4];
#pragma unroll
        for (int bj = 0; bj < 2; ++bj)
#pragma unroll
            for (int n = 0; n < 2; ++n)
#pragma unroll
                for (int e = 0; e < 4; ++e) cj[bj][n][e] = SCJ[(size_t)(r0 + bj * HALF + wc * 32 + 8 * fq + 4 * n + e) * 4 + h];
#pragma unroll
        for (int ai = 0; ai < 2; ++ai)
#pragma unroll
            for (int m = 0; m < 4; ++m) { const int tl = ai * HALF + wr * 64 + m * 16 + fr; const float at = SA[(size_t)(r0 + tl) * 4 + h]; float s = 0.f;
                bf16* pp = PB + (size_t)(r0 + tl) * 2048 + h * 512 + wc * 32 + 8 * fq;
#pragma unroll
                for (int bj = 0; bj < 2; ++bj) { f32x4 v[2];
#pragma unroll
                    for (int n = 0; n < 2; ++n) { const int j0 = bj * HALF + wc * 32 + 8 * fq + 4 * n;
#pragma unroll
                        for (int e = 0; e < 4; ++e) { v[n][e] = (j0 + e <= tl) ? acc[ai][bj][m][n][e] * __expf(at + cj[bj][n][e]) : 0.f; s += v[n][e]; } }
                    *(u32x4e*)(pp + bj * HALF) = pk8(v[0], v[1]); }
                s += __shfl_xor(s, 16); s += __shfl_xor(s, 32);
                if (fq == 0) DENI[((size_t)(r0 + tl) * 4 + h) * 4 + wc] = s; }
        return false;
    }
};
struct POrder {
    const char* Q; const char* K; int nwg, G, c;
    __device__ __forceinline__ bool next(int i, Unit& u) const {
        const long L = (long)i * G + c; if (L >= nwg) return false;
        const int tt = (int)L >> 2, h = (int)L & 3; const size_t off = ((size_t)tt * 256 * MI + h * 512) * 2;
        u.A = Q + off; u.B = K + off; u.pm = tt; u.pn = 0; u.aux = h; u.nt = 8; return true;
    }
};
struct EpiNum {
    static constexpr bool PERM = true;
    Params P;
    __device__ __forceinline__ bool operator()(f32x4 (&acc)[2][2][4][2], const Unit& u, int wr, int wc, int fr_, int fq_) const {
        int fr = fr_, fq = fq_; asm volatile("" : "+v"(fr), "+v"(fq));
        const int h = u.aux >> 1, seg = u.aux & 1, row0 = u.pm * BM + wr * 64 + fr;
        if (seg == 0) { const float* SWI = WSP(float, W_SWI);
#pragma unroll
            for (int ai = 0; ai < 2; ++ai)
#pragma unroll
                for (int m = 0; m < 4; ++m) { const float wi = SWI[(size_t)(row0 + ai * HALF + m * 16) * 4 + h];
#pragma unroll
                    for (int bj = 0; bj < 2; ++bj)
#pragma unroll
                        for (int n = 0; n < 2; ++n) acc[ai][bj][m][n] *= wi; }
            return true;
        }
        const float* DEN = WSP(float, W_DEN); const float* SEM = WSP(float, W_SEM); bf16* H = WSP(bf16, W_H) + h * 512 + u.pn * BM + wc * 32 + 8 * fq;
#pragma unroll
        for (int ai = 0; ai < 2; ++ai)
#pragma unroll
            for (int m = 0; m < 4; ++m) { const size_t row = row0 + ai * HALF + m * 16; const float inv = 1.f / fmaxf(fabsf(DEN[row * 4 + h]), SEM[row * 4 + h]); bf16* hp = H + row * MI;
#pragma unroll
                for (int bj = 0; bj < 2; ++bj) *(u32x4e*)(hp + bj * HALF) = pk8(acc[ai][bj][m][0] * inv, acc[ai][bj][m][1] * inv); }
        return false;
    }
};
struct NumOrder {
    const char* Q; const char* PB; const char* CT; const char* VT; int njob, G, c;
    __device__ __forceinline__ int job(int k) const { const long L = (long)k * G + c; if (L >= njob) return -1; int id = (int)L; { const int q = njob / 8, r = njob % 8, xcd = id % 8, off = id / 8; id = (xcd < r ? xcd * (q + 1) : r * (q + 1) + (xcd - r) * q) + off; } return id; }
    __device__ __forceinline__ bool next(int i, Unit& u) const {
        const int id = job(i >> 2); if (id < 0) return false;
        const int tt = id >> 2, h = id & 3, half = (i >> 1) & 1, seg = i & 1;
        const int b = tt / (SEQ / 256), c1 = tt % (SEQ / 256) + 1;
        u.pm = tt; u.pn = half; u.aux = h * 2 + seg;
        if (seg == 0) { u.A = Q + ((size_t)tt * 256 * MI + h * 512) * 2; u.B = CT + ctb_idx(c1, b, h, half * 256, 0) * 2; u.nt = 8; }
        else { u.A = PB + ((size_t)tt * 256 * 2048 + h * 512) * 2; u.B = VT + (((size_t)tt * 512 + half * 256) * 2048 + h * 512) * 2; u.nt = 4; }
        return true;
    }
};
}
__device__ __forceinline__ void ph_den_fast(const Params& P, int gw, int ngw, int lane) {
    const bf16* Q = WSP(bf16, W_MQ); const float* NST = WSP(float, W_NST); const float* SWI = WSP(float, W_SWI); const float* DENI = WSP(float, W_DENI); float* DEN = WSP(float, W_DEN);
    const int h = lane >> 4, sub = lane & 15;
    for (int r = gw; r < NP; r += ngw) { const int b = r / SEQ, c = (r % SEQ) / LCH + 1;
        const bf16* q = Q + (size_t)r * MI + h * 512 + sub * 32; const float* n = NST + ((size_t)(b * 4 + h) * NCH + c) * 512 + sub * 32; float a = 0.f;
#pragma unroll
        for (int k = 0; k < 32; k += 8) { const pg8::bf16x8 qv = *(const pg8::bf16x8*)(q + k);
#pragma unroll
            for (int e = 0; e < 8; ++e) a += bf2f((bf16)qv[e]) * n[k + e]; }
        a += __shfl_xor(a, 1); a += __shfl_xor(a, 2); a += __shfl_xor(a, 4); a += __shfl_xor(a, 8);
        if (sub == 0) { const float* dp = DENI + ((size_t)r * 4 + h) * 4; DEN[(size_t)r * 4 + h] = (dp[0] + dp[1]) + (dp[2] + dp[3]) + SWI[(size_t)r * 4 + h] * a; } }
}

namespace st {
typedef short bf16x8 __attribute__((ext_vector_type(8)));
typedef float f32x16 __attribute__((ext_vector_type(16)));
typedef float f32x4 __attribute__((ext_vector_type(4)));
typedef unsigned u32x2 __attribute__((ext_vector_type(2)));
typedef unsigned u32x4 __attribute__((ext_vector_type(4)));
__device__ __forceinline__ bf16x8 scale8(bf16x8 v, const LAS float* w) {
    const f32x4 w0 = *(const LAS f32x4*)w, w1 = *(const LAS f32x4*)(w + 4);
    const u32x4 u = __builtin_bit_cast(u32x4, v); u32x4 r;
    r[0] = pg8::cvt_pk_bf16(__uint_as_float(u[0] << 16) * w0[0], __uint_as_float(u[0] & 0xffff0000u) * w0[1]);
    r[1] = pg8::cvt_pk_bf16(__uint_as_float(u[1] << 16) * w0[2], __uint_as_float(u[1] & 0xffff0000u) * w0[3]);
    r[2] = pg8::cvt_pk_bf16(__uint_as_float(u[2] << 16) * w1[0], __uint_as_float(u[2] & 0xffff0000u) * w1[1]);
    r[3] = pg8::cvt_pk_bf16(__uint_as_float(u[3] << 16) * w1[2], __uint_as_float(u[3] & 0xffff0000u) * w1[3]);
    return __builtin_bit_cast(bf16x8, r);
}
constexpr int ST_STAGE = 65536, ST_WK_OFF = 131072 + 1024;
__device__ __forceinline__ unsigned kkey(unsigned row) { return ((row & 3u) << 2) | ((row >> 2) & 3u); }
__device__ __forceinline__ void st_issue(LAS unsigned char* lds, int buf, const char* kbase, const char* vbase, int wave, int lane) {
    const int rsub = lane >> 4, q = lane & 15;
#pragma unroll
    for (int i = 0; i < 4; ++i) { const int row = wave * 16 + i * 4 + rsub;
        __builtin_amdgcn_global_load_lds((const unsigned*)(kbase + (size_t)row * 4096 + 16 * (q ^ kkey(row))), (LAS unsigned*)(lds + buf * ST_STAGE + (wave * 16 + i * 4) * 256), 16, 0, 0);
        __builtin_amdgcn_global_load_lds((const unsigned*)(vbase + (size_t)row * 4096 + 16 * (q ^ (row & 15))), (LAS unsigned*)(lds + buf * ST_STAGE + 32768 + (wave * 16 + i * 4) * 256), 16, 0, 0); }
}
typedef unsigned short u16x4 __attribute__((ext_vector_type(4)));
__device__ __forceinline__ void state_scan(const Params& P, int j, LAS unsigned char* lds, int w, int tid_) {
    int tid = tid_; asm volatile("" : "+v"(tid));
    const int bh = w >> 4, b = bh >> 2, h = bh & 3, dg = (w >> 2) & 3, eg = w & 3;
    const int wave = __builtin_amdgcn_readfirstlane(tid >> 6), lane = tid & 63, l32 = lane & 31, lh = lane >> 5;
    const int dt = wave >> 1, et = (wave & 1) * 2;
    const int dbase = dg * 128 + dt * 32, ebase = eg * 128 + et * 32;
    const bool do_n = (eg == 0) && ((wave & 1) == 0);
    const bf16* MK = WSP(bf16, W_MK); const bf16* VT = WSP(bf16, W_MVT); const float* SWK = WSP(float, W_SWK); const float* DEC = WSP(float, W_DEC);
    bf16* CT = WSP(bf16, W_CT); float* NST = WSP(float, W_NST);
    LAS float* wk = (LAS float*)(lds + ST_WK_OFF);
    f32x16 acc0, acc1, accn;
#pragma unroll
    for (int i = 0; i < 16; ++i) { acc0[i] = 0.f; acc1[i] = 0.f; accn[i] = 0.f; }
    u32x4 onesu; onesu[0] = onesu[1] = onesu[2] = onesu[3] = 0x3f803f80u; const bf16x8 ones = __builtin_bit_cast(bf16x8, onesu);
    {   const int row0 = ROW_META + b * NMETA;
        if (tid < NMETA) wk[tid] = SWK[(size_t)(row0 + tid) * 4 + h];
        __syncthreads();
        if (do_n && l32 == 0) {
#pragma unroll
            for (int i = 0; i < 16; ++i) NST[((size_t)bh * NCH + 0) * 512 + dbase + 8 * (i >> 2) + 4 * lh + (i & 3)] = 0.f; }
        u32x4 au;
#pragma unroll
        for (int i = 0; i < 4; ++i) { const unsigned lo = MK[(size_t)(row0 + 8 * lh + 2 * i) * MI + h * 512 + dbase + l32], hi = MK[(size_t)(row0 + 8 * lh + 2 * i + 1) * MI + h * 512 + dbase + l32]; au[i] = lo | (hi << 16); }
        const bf16x8 a = scale8(__builtin_bit_cast(bf16x8, au), wk + 8 * lh);
        const bf16* v0 = VT + vtb_idx(row0, h, ebase + l32) + 8 * lh;
        const bf16x8 b0 = *(const bf16x8*)v0, b1 = *(const bf16x8*)(v0 + (size_t)32 * 2048);
        acc0 = __builtin_amdgcn_mfma_f32_32x32x16_bf16(a, b0, acc0, 0, 0, 0); acc1 = __builtin_amdgcn_mfma_f32_32x32x16_bf16(a, b1, acc1, 0, 0, 0);
        if (do_n) accn = __builtin_amdgcn_mfma_f32_32x32x16_bf16(a, ones, accn, 0, 0, 0);
    }
    const int row1 = b * SEQ;
    const char* kcol = (const char*)(MK + h * 512 + dg * 128);
    st_issue(lds, 0, kcol + (size_t)row1 * 4096, (const char*)(VT + vtb_idx(row1, h, eg * 128)), wave, lane);
    unsigned tra[2];
    { const unsigned hh = lane >> 5, blk = (lane >> 4) & 1, q = (lane & 15) >> 2, p = lane & 3;
#pragma unroll
      for (unsigned t = 0; t < 2; ++t) { const unsigned row = 8 * hh + 4 * t + q, ch = 4 * dt + 2 * blk + (p >> 1); tra[t] = 256u * row + 16u * (ch ^ kkey(row)) + 8u * (p & 1); } }
    for (int sidx = 0; sidx < 2 * (NCH - 1); ++sidx) {
        const int c = 1 + (sidx >> 1), half = sidx & 1, row0 = row1 + (c - 1) * LCH, buf = sidx & 1;
        LAS float* wkc = wk + (c & 1) * 256;
        float dec = 1.f;
        if (half == 0) { if (tid < LCH) wkc[tid] = SWK[(size_t)(row0 + tid) * 4 + h]; dec = DEC[(size_t)bh * NCH + c]; }
        asm volatile("s_waitcnt vmcnt(0)" ::: "memory");
        __syncthreads();
        if (sidx + 1 < 2 * (NCH - 1)) { const int tok = row1 + (sidx + 1) * 128;
            st_issue(lds, buf ^ 1, kcol + (size_t)tok * 4096, (const char*)(VT + vtb_idx(tok, h, eg * 128)), wave, lane); }
        if (half == 0) {
#pragma unroll
            for (int g = 0; g < 4; ++g) { u32x2 p0, p1;
                p0.x = pg8::cvt_pk_bf16(acc0[4 * g], acc0[4 * g + 1]); p0.y = pg8::cvt_pk_bf16(acc0[4 * g + 2], acc0[4 * g + 3]);
                p1.x = pg8::cvt_pk_bf16(acc1[4 * g], acc1[4 * g + 1]); p1.y = pg8::cvt_pk_bf16(acc1[4 * g + 2], acc1[4 * g + 3]);
                *(u32x2*)(CT + ctb_idx(c, b, h, ebase + l32, dbase + 8 * g + 4 * lh)) = p0;
                *(u32x2*)(CT + ctb_idx(c, b, h, ebase + 32 + l32, dbase + 8 * g + 4 * lh)) = p1; }
            if (do_n && l32 == 0) {
#pragma unroll
                for (int i = 0; i < 16; ++i) NST[((size_t)bh * NCH + c) * 512 + dbase + 8 * (i >> 2) + 4 * lh + (i & 3)] = accn[i]; }
#pragma unroll
            for (int i = 0; i < 16; ++i) { acc0[i] *= dec; acc1[i] *= dec; accn[i] *= dec; }
        }
        u16x4 kt0[8], kt1[8];
        { const unsigned a0 = (unsigned)(buf * ST_STAGE) + tra[0], a1 = (unsigned)(buf * ST_STAGE) + tra[1];
          asm volatile(
            "ds_read_b64_tr_b16 %0, %16\n\tds_read_b64_tr_b16 %1, %17\n\tds_read_b64_tr_b16 %2, %16 offset:4096\n\tds_read_b64_tr_b16 %3, %17 offset:4096\n\t"
            "ds_read_b64_tr_b16 %4, %16 offset:8192\n\tds_read_b64_tr_b16 %5, %17 offset:8192\n\tds_read_b64_tr_b16 %6, %16 offset:12288\n\tds_read_b64_tr_b16 %7, %17 offset:12288\n\t"
            "ds_read_b64_tr_b16 %8, %16 offset:16384\n\tds_read_b64_tr_b16 %9, %17 offset:16384\n\tds_read_b64_tr_b16 %10, %16 offset:20480\n\tds_read_b64_tr_b16 %11, %17 offset:20480\n\t"
            "ds_read_b64_tr_b16 %12, %16 offset:24576\n\tds_read_b64_tr_b16 %13, %17 offset:24576\n\tds_read_b64_tr_b16 %14, %16 offset:28672\n\tds_read_b64_tr_b16 %15, %17 offset:28672\n\t"
            "s_waitcnt lgkmcnt(0)"
            : "=&v"(kt0[0]), "=&v"(kt1[0]), "=&v"(kt0[1]), "=&v"(kt1[1]), "=&v"(kt0[2]), "=&v"(kt1[2]), "=&v"(kt0[3]), "=&v"(kt1[3]),
              "=&v"(kt0[4]), "=&v"(kt1[4]), "=&v"(kt0[5]), "=&v"(kt1[5]), "=&v"(kt0[6]), "=&v"(kt1[6]), "=&v"(kt0[7]), "=&v"(kt1[7])
            : "v"(a0), "v"(a1) : "memory"); }
        const LAS unsigned char* v0 = lds + buf * ST_STAGE + 32768 + (et * 32 + l32) * 256; const LAS unsigned char* v1 = v0 + 32 * 256;
        const int sw = l32 & 15;
#pragma unroll
        for (int s = 0; s < 8; ++s) { const int slot = ((2 * s + lh) ^ sw) * 16;
            u32x4 au; { const u32x2 x0 = __builtin_bit_cast(u32x2, kt0[s]), x1 = __builtin_bit_cast(u32x2, kt1[s]); au[0] = x0.x; au[1] = x0.y; au[2] = x1.x; au[3] = x1.y; }
            const bf16x8 a = scale8(__builtin_bit_cast(bf16x8, au), wkc + half * 128 + s * 16 + 8 * lh);
            const bf16x8 b0 = *(const LAS bf16x8*)(v0 + slot), b1 = *(const LAS bf16x8*)(v1 + slot);
            acc0 = __builtin_amdgcn_mfma_f32_32x32x16_bf16(a, b0, acc0, 0, 0, 0);
            acc1 = __builtin_amdgcn_mfma_f32_32x32x16_bf16(a, b1, acc1, 0, 0, 0);
            if (do_n) accn = __builtin_amdgcn_mfma_f32_32x32x16_bf16(a, ones, accn, 0, 0, 0); }
    }
    float* oc = P.out + O_PC + ((size_t)j * BATCH * 4 + bh) * 512 * 512;
#pragma unroll
    for (int i = 0; i < 16; ++i) { const int d = dbase + 8 * (i >> 2) + 4 * lh + (i & 3); oc[(size_t)d * 512 + ebase + l32] = acc0[i]; oc[(size_t)d * 512 + ebase + 32 + l32] = acc1[i]; }
    if (do_n && l32 == 0) {
#pragma unroll
        for (int i = 0; i < 16; ++i) P.out[O_PN + ((size_t)j * BATCH * 4 + bh) * 512 + dbase + 8 * (i >> 2) + 4 * lh + (i & 3)] = accn[i]; }
    __syncthreads();
}
}
namespace at {
typedef short bf16x8 __attribute__((ext_vector_type(8)));
typedef float f32x16 __attribute__((ext_vector_type(16)));
typedef unsigned u32x2 __attribute__((ext_vector_type(2)));
typedef unsigned u32x4 __attribute__((ext_vector_type(4)));
constexpr int NI_P = (NP / 32) * 16, NI_M = BATCH * 16, NI_S = DECB * 4, NI = NI_P + NI_M + NI_S;
struct TileSrc { const bf16* k; const bf16* v; int vstride, kbase, thr, off, nval; };
__device__ __forceinline__ void att_phase(const Params& P, int j, LAS unsigned char* lds, int gw, int ngw, int tid_) {
    int tid = tid_; asm volatile("" : "+v"(tid));
    gw = __builtin_amdgcn_readfirstlane(gw);
    const int lane = tid & 63, l32 = lane & 31, lh = lane >> 5;
    LAS float* bt = (LAS float*)lds;
    LAS unsigned char* wl = lds + 16384 + ((tid >> 6) & 7) * 8192;
    { const float* BT = WSP(float, W_BIAS); for (int i = tid; i < 16 * 132; i += 512) bt[i] = BT[i] * 1.4426950408889634f; }
    __syncthreads();
    const bf16* Q = WSP(bf16, W_Q); const bf16* K = WSP(bf16, W_K); const bf16* VT = WSP(bf16, W_VT); const bf16* GS = WSP(bf16, W_GS); bf16* OG = WSP(bf16, W_OG);
    const bf16* KC = WSP(bf16, W_KC) + (size_t)j * DECB * KCN * 256; const bf16* VTC = WSP(bf16, W_VTC) + (size_t)j * DECB * 256 * KCN;
    const float* sinks = P.in[I_SSINK] + j * 16;
    for (int item = gw; item < NI; item += ngw) {
        int kind, b = 0, t0 = 0, bs = 0, h0, nq, pmask, hshift, qrow0, qpos0, ti0 = 0, ti1;
        if (item < NI_P) { kind = 0; const int qb = item >> 4; h0 = item & 15; qrow0 = qb * 32; b = qrow0 / SEQ; t0 = qrow0 % SEQ; nq = 32; pmask = 31; hshift = 5; qpos0 = 16 + t0; ti1 = 6; }
        else if (item < NI_P + NI_M) { kind = 1; const int i2 = item - NI_P; b = i2 >> 4; h0 = i2 & 15; qrow0 = ROW_META + b * NMETA; nq = 16; pmask = 15; hshift = 5; qpos0 = 0; ti1 = 1; }
        else { kind = 2; const int i3 = item - NI_P - NI_M; bs = i3 >> 2; h0 = (i3 & 3) * 4; qrow0 = ROW_SAMP + bs * TS; nq = 16; pmask = 3; hshift = 2; qpos0 = PAST; ti1 = 6; }
        const int kvh = h0 >> 2;
        const int cq = l32 < nq ? l32 : (l32 & (nq - 1));
        const int qrow = qrow0 + (cq & pmask), qhead = h0 + (cq >> hshift), qpos = qpos0 + (cq & pmask);
        auto tile_src = [&](int ti) -> TileSrc { TileSrc s;
            if (kind == 2) { if (ti < 5) { s.k = KC + ((size_t)bs * KCN + 32 * ti) * 256 + kvh * 64; s.v = VTC + ((size_t)bs * 256 + kvh * 64) * KCN + 32 * ti; s.vstride = KCN; s.kbase = 32 * ti; s.thr = 16; s.off = PAST - 128 - 16; s.nval = 144; }
                             else { s.k = K + (size_t)qrow0 * 256 + kvh * 64; s.v = VT + (size_t)(kvh * 64) * MPAD + qrow0; s.vstride = MPAD; s.kbase = PAST; s.thr = 0x7fffffff; s.off = 0; s.nval = PAST + TS; } }
            else if (ti == 0) { const int r = ROW_META + b * NMETA; s.k = K + (size_t)r * 256 + kvh * 64; s.v = VT + (size_t)(kvh * 64) * MPAD + r; s.vstride = MPAD; s.kbase = 0; s.thr = 0x7fffffff; s.off = 0; s.nval = 16; }
            else { const int tk0 = t0 - 128 + 32 * (ti - 1), r = b * SEQ + tk0; s.k = K + (size_t)r * 256 + kvh * 64; s.v = VT + (size_t)(kvh * 64) * MPAD + r; s.vstride = MPAD; s.kbase = 16 + tk0; s.thr = 0x7fffffff; s.off = 0; s.nval = 0x7fffffff; }
            return s; };
        auto next_ti = [&](int ti) -> int { int n = ti + 1; if (kind == 0 && ti == 0 && t0 < 128) n = 1 + (128 - t0) / 32; return n; };
        bf16x8 qf[4];
        { const bf16* qp = Q + (size_t)qrow * D + qhead * 64 + 8 * lh;
#pragma unroll
          for (int s = 0; s < 4; ++s) qf[s] = *(const bf16x8*)(qp + 16 * s); }
        const LAS float* bth = bt + qhead * 132;
        float m = sinks[qhead] * 1.4426950408889634f, l = 1.f;
        f32x16 o0, o1;
#pragma unroll
        for (int i = 0; i < 16; ++i) { o0[i] = 0.f; o1[i] = 0.f; }
        bf16x8 kr[4], vr[4];
        int ti = ti0; TileSrc cur = tile_src(ti);
        auto load_tile = [&](const TileSrc& s) {
            const bf16* kp = s.k + (size_t)(lane >> 3) * 256 + 8 * (lane & 7);
#pragma unroll
            for (int q = 0; q < 4; ++q) kr[q] = *(const bf16x8*)(kp + (size_t)q * 8 * 256);
            const bf16* vp = s.v + (size_t)(lane >> 2) * s.vstride + 8 * (lane & 3);
#pragma unroll
            for (int q = 0; q < 4; ++q) vr[q] = *(const bf16x8*)(vp + (size_t)q * 16 * s.vstride); };
        load_tile(cur);
        while (ti < ti1) {
#pragma unroll
            for (int q = 0; q < 4; ++q) { const int row = 8 * q + (lane >> 3); *(LAS bf16x8*)(wl + row * 128 + 16 * ((lane & 7) ^ ((row >> 1) & 7))) = kr[q]; }
#pragma unroll
            for (int q = 0; q < 4; ++q) { const int row = 16 * q + (lane >> 2); *(LAS bf16x8*)(wl + 4096 + row * 64 + 16 * ((lane & 3) ^ ((row >> 2) & 3))) = vr[q]; }
            const TileSrc me = cur;
            const int tn = next_ti(ti);
            if (tn < ti1) { cur = tile_src(tn); load_tile(cur); }
            bf16x8 kf[4];
#pragma unroll
            for (int s = 0; s < 4; ++s) kf[s] = *(const LAS bf16x8*)(wl + l32 * 128 + 16 * ((2 * s + lh) ^ ((l32 >> 1) & 7)));
            f32x16 sT;
#pragma unroll
            for (int i = 0; i < 16; ++i) sT[i] = 0.f;
#pragma unroll
            for (int s = 0; s < 4; ++s) sT = __builtin_amdgcn_mfma_f32_32x32x16_bf16(kf[s], qf[s], sT, 0, 0, 0);
            bf16x8 va[2][2];
#pragma unroll
            for (int dt = 0; dt < 2; ++dt)
#pragma unroll
                for (int s = 0; s < 2; ++s) { const int row = dt * 32 + l32, key = (row >> 2) & 3; const LAS unsigned char* rp = wl + 4096 + row * 64 + 8 * lh;
                    const u32x2 p0 = *(const LAS u32x2*)(rp + 16 * ((2 * s) ^ key)), p1 = *(const LAS u32x2*)(rp + 16 * ((2 * s + 1) ^ key));
                    u32x4 t; t[0] = p0.x; t[1] = p0.y; t[2] = p1.x; t[3] = p1.y; va[dt][s] = __builtin_bit_cast(bf16x8, t); }
            float mx = m;
            if (kind == 0 && ti >= 2 && ti <= 4) {
                const LAS float* bq = bth + (qpos - me.kbase - 31);
#pragma unroll
                for (int i = 0; i < 16; ++i) { const int kk = 8 * (i >> 2) + 4 * lh + (i & 3); const float sv = sT[i] + bq[31 - kk]; sT[i] = sv; mx = fmaxf(mx, sv); }
            } else {
#pragma unroll
                for (int i = 0; i < 16; ++i) { const int kk = 8 * (i >> 2) + 4 * lh + (i & 3), kg = me.kbase + kk, pos = kg + (kg >= me.thr ? me.off : 0), dist = qpos - pos;
                    const bool vis = (kg < me.nval) && (dist >= 0) && (dist <= 128 || pos < 16);
                    const int di = dist < 0 ? 0 : (dist > 128 ? 128 : dist);
                    const float sv = vis ? sT[i] + bth[di] : -3.0e38f; sT[i] = sv; mx = fmaxf(mx, sv); }
            }
            mx = fmaxf(mx, __shfl_xor(mx, 32));
            float ps = 0.f;
#pragma unroll
            for (int i = 0; i < 16; ++i) { const float p = __builtin_amdgcn_exp2f(sT[i] - mx); sT[i] = p; ps += p; }
            ps += __shfl_xor(ps, 32);
            if (__any(mx > m)) {
                const float corr = __builtin_amdgcn_exp2f(m - mx); m = mx; l *= corr;
#pragma unroll
                for (int i = 0; i < 16; ++i) { o0[i] *= corr; o1[i] *= corr; } }
            l += ps;
#pragma unroll
            for (int s = 0; s < 2; ++s) { u32x4 pk;
#pragma unroll
                for (int q = 0; q < 4; ++q) pk[q] = pg8::cvt_pk_bf16(sT[8 * s + 2 * q], sT[8 * s + 2 * q + 1]);
                const bf16x8 pb = __builtin_bit_cast(bf16x8, pk);
                o0 = __builtin_amdgcn_mfma_f32_32x32x16_bf16(va[0][s], pb, o0, 0, 0, 0);
                o1 = __builtin_amdgcn_mfma_f32_32x32x16_bf16(va[1][s], pb, o1, 0, 0, 0); }
            ti = tn;
        }
        if (l32 < nq) { const float inv = 1.f / l; const size_t ob = (size_t)qrow * D + qhead * 64 + 4 * lh;
#pragma unroll
            for (int g = 0; g < 4; ++g) {
                { const u32x2 gv = *(const u32x2*)(GS + ob + 8 * g); u32x2 w;
                  w.x = pg8::cvt_pk_bf16(o0[4 * g] * inv * __uint_as_float(gv.x << 16), o0[4 * g + 1] * inv * __uint_as_float(gv.x & 0xffff0000u));
                  w.y = pg8::cvt_pk_bf16(o0[4 * g + 2] * inv * __uint_as_float(gv.y << 16), o0[4 * g + 3] * inv * __uint_as_float(gv.y & 0xffff0000u)); *(u32x2*)(OG + ob + 8 * g) = w; }
                { const u32x2 gv = *(const u32x2*)(GS + ob + 32 + 8 * g); u32x2 w;
                  w.x = pg8::cvt_pk_bf16(o1[4 * g] * inv * __uint_as_float(gv.x << 16), o1[4 * g + 1] * inv * __uint_as_float(gv.x & 0xffff0000u));
                  w.y = pg8::cvt_pk_bf16(o1[4 * g + 2] * inv * __uint_as_float(gv.y << 16), o1[4 * g + 3] * inv * __uint_as_float(gv.y & 0xffff0000u)); *(u32x2*)(OG + ob + 32 + 8 * g) = w; } }
        }
    }
    __syncthreads();
}
}
namespace el {
__device__ __forceinline__ const float* lp(const float* p) { const float __attribute__((address_space(1)))* g = (const float __attribute__((address_space(1)))*)p; asm volatile("" : "+s"(g));
    return (const float*)g; }
typedef short bf16x8 __attribute__((ext_vector_type(8)));
typedef float f32x4 __attribute__((ext_vector_type(4)));
typedef unsigned u32x2 __attribute__((ext_vector_type(2)));
typedef unsigned u32x4 __attribute__((ext_vector_type(4)));
__device__ __forceinline__ float wsum(float v) {
#pragma unroll
    for (int o = 1; o < 64; o <<= 1) v += __shfl_xor(v, o);
    return v;
}
__device__ __forceinline__ void unpack8(bf16x8 v, float (&f)[8]) { const u32x4 u = __builtin_bit_cast(u32x4, v);
#pragma unroll
    for (int i = 0; i < 4; ++i) { f[2 * i] = __uint_as_float(u[i] << 16); f[2 * i + 1] = __uint_as_float(u[i] & 0xffff0000u); } }
__device__ __forceinline__ bf16x8 pack8(const float (&f)[8]) { u32x4 u;
#pragma unroll
    for (int i = 0; i < 4; ++i) u[i] = pg8::cvt_pk_bf16(f[2 * i], f[2 * i + 1]);
    return __builtin_bit_cast(bf16x8, u); }

__device__ __forceinline__ void norm_fast(const Params& P, int layer, int gw, int ngw, int lane) {
    float* X = WSP(float, W_X); const bf16* X16 = WSP(bf16, W_X16); bf16* XN = WSP(bf16, W_XN); const float* w = P.in[I_NORMW] + (size_t)layer * D;
    const float* xp_ = lp(P.in[I_XP]); const float* xm_ = lp(P.in[I_META]); const float* xs_ = lp(P.in[I_XS]);
    f32x4 wv[4];
#pragma unroll
    for (int k = 0; k < 4; ++k) wv[k] = *(const f32x4*)(w + 4 * lane + 256 * k);
    for (int r = gw; r < MPAD; r += ngw) {
        bf16* o = XN + (size_t)r * D + 4 * lane;
        if (r >= NROWS) {
#pragma unroll
            for (int k = 0; k < 4; ++k) *(u32x2*)(o + 256 * k) = (u32x2){0u, 0u};
            continue; }
        f32x4 v[4]; float s = 0.f;
        if (layer > 0 && r < NP) {
#pragma unroll
            for (int k = 0; k < 4; ++k) { const u32x2 t = *(const u32x2*)(X16 + (size_t)r * D + 4 * lane + 256 * k);
                v[k] = (f32x4){__uint_as_float(t.x << 16), __uint_as_float(t.x & 0xffff0000u), __uint_as_float(t.y << 16), __uint_as_float(t.y & 0xffff0000u)}; }
        } else { const float* src = X + (size_t)r * D;
            if (layer == 0) { if (r < NP) src = xp_ + (size_t)r * D; else if (r < ROW_SAMP) src = xm_ + (size_t)((r - ROW_META) % NMETA) * D; else src = xs_ + (size_t)(r - ROW_SAMP) * D; }
#pragma unroll
            for (int k = 0; k < 4; ++k) v[k] = *(const f32x4*)(src + 4 * lane + 256 * k); }
#pragma unroll
        for (int k = 0; k < 4; ++k) s += (v[k][0] * v[k][0] + v[k][1] * v[k][1]) + (v[k][2] * v[k][2] + v[k][3] * v[k][3]);
        const float rs = 1.f / sqrtf(wsum(s) * (1.f / D) + EPS);
#pragma unroll
        for (int k = 0; k < 4; ++k) { if (layer == 0 && r >= NP) *(f32x4*)(X + (size_t)r * D + 4 * lane + 256 * k) = v[k]; *(u32x2*)(o + 256 * k) = pg8::pk4(v[k] * wv[k] * rs); }
    }
}
__device__ __forceinline__ void convgates_fast(const Params& P, int j, LAS unsigned char* lds, int gw, int ngw, int lane, int tid) {
    const bf16* XM = WSP(bf16, W_XM); bf16* XC = WSP(bf16, W_XC); const float* G = WSP(float, W_G) + (size_t)j * 4096 * 8; float* GA = WSP(float, W_GATES);
    const float* cw = P.in[I_MCW] + (size_t)j * 4 * 2048; const float* cb = P.in[I_MCB] + (size_t)j * 2048;
    LAS float* Gt = (LAS float*)lds;
    for (int i = tid; i < 4096 * 2; i += 512) { const f32x4 v = *(const f32x4*)(G + (size_t)i * 4); const int c = i >> 1, g0 = (i & 1) * 4;
#pragma unroll
        for (int g = 0; g < 4; ++g) Gt[(g0 + g) * 4096 + c] = v[g]; }
    __syncthreads();
    for (int grp = gw; grp < MPAD / 4; grp += ngw) {
        const int r0 = grp * 4;
        if (r0 >= NROWS) { for (int t = 0; t < 4; ++t)
#pragma unroll
            for (int k = 0; k < 4; ++k) *(u32x4*)(XC + (size_t)(r0 + t) * MI + 8 * lane + 512 * k) = (u32x4){0u, 0u, 0u, 0u};
            continue; }
        int hmode, hrow = 0; const float* hs = nullptr;
        if (r0 < NP) { hmode = 1; const int t = r0 % SEQ; hrow = t > 0 ? r0 - 3 : ROW_META + (r0 / SEQ) * NMETA + NMETA - 3; }
        else if (r0 < ROW_SAMP) { const int i = (r0 - ROW_META) % NMETA; hmode = i > 0 ? 1 : 0; hrow = r0 - 3; }
        else { hmode = 2; hs = P.in[I_SCONV] + ((size_t)j * DECB + (r0 - ROW_SAMP) / TS) * 3 * 2048; }
        float ga[4][8];
#pragma unroll
        for (int t = 0; t < 4; ++t)
#pragma unroll
            for (int g = 0; g < 8; ++g) ga[t][g] = 0.f;
#pragma unroll 1
        for (int k = 0; k < 4; ++k) { const int c0 = 8 * lane + 512 * k;
            float x[7][8];
#pragma unroll
            for (int t = 0; t < 3; ++t) {
                if (hmode == 1) unpack8(*(const bf16x8*)(XM + (size_t)(hrow + t) * MI + c0), x[t]);
                else if (hmode == 2) { const f32x4 a = *(const f32x4*)(hs + (size_t)t * 2048 + c0), b = *(const f32x4*)(hs + (size_t)t * 2048 + c0 + 4);
#pragma unroll
                    for (int e = 0; e < 4; ++e) { x[t][e] = a[e]; x[t][4 + e] = b[e]; } }
                else {
#pragma unroll
                    for (int e = 0; e < 8; ++e) x[t][e] = 0.f; } }
#pragma unroll
            for (int t = 0; t < 4; ++t) unpack8(*(const bf16x8*)(XM + (size_t)(r0 + t) * MI + c0), x[3 + t]);
            float xc[4][8];
            { float wgt[5][8];
#pragma unroll
              for (int wv = 0; wv < 4; ++wv) { const f32x4 a = *(const f32x4*)(cw + (size_t)wv * 2048 + c0), b = *(const f32x4*)(cw + (size_t)wv * 2048 + c0 + 4);
#pragma unroll
                  for (int e = 0; e < 4; ++e) { wgt[wv][e] = a[e]; wgt[wv][4 + e] = b[e]; } }
              { const f32x4 a = *(const f32x4*)(cb + c0), b = *(const f32x4*)(cb + c0 + 4);
#pragma unroll
                for (int e = 0; e < 4; ++e) { wgt[4][e] = a[e]; wgt[4][4 + e] = b[e]; } }
#pragma unroll
              for (int t = 0; t < 4; ++t) {
#pragma unroll
                  for (int e = 0; e < 8; ++e) { const float a = wgt[4][e] + x[t][e] * wgt[0][e] + x[t + 1][e] * wgt[1][e] + x[t + 2][e] * wgt[2][e] + x[t + 3][e] * wgt[3][e]; xc[t][e] = pg8::silu_fast(a); }
                  *(bf16x8*)(XC + (size_t)(r0 + t) * MI + c0) = pack8(xc[t]); } }
#pragma unroll
            for (int g = 0; g < 8; ++g) { const LAS float* gq = Gt + g * 4096 + c0; const LAS float* gm = gq + 2048;
                const f32x4 q0 = *(const LAS f32x4*)gq, q1 = *(const LAS f32x4*)(gq + 4), m0 = *(const LAS f32x4*)gm, m1 = *(const LAS f32x4*)(gm + 4);
#pragma unroll
                for (int t = 0; t < 4; ++t) { float a = ga[t][g];
#pragma unroll
                    for (int e = 0; e < 4; ++e) a += xc[t][e] * q0[e] + xc[t][4 + e] * q1[e] + x[3 + t][e] * m0[e] + x[3 + t][4 + e] * m1[e];
                    ga[t][g] = a; }
                asm volatile("" ::: "memory"); }
        }
#pragma unroll
        for (int t = 0; t < 4; ++t)
#pragma unroll
            for (int g = 0; g < 8; ++g) ga[t][g] = wsum(ga[t][g]);
        if (lane < 32) { const int t = lane >> 3, g = lane & 7; float v = 0.f;
#pragma unroll
            for (int tt = 0; tt < 4; ++tt)
#pragma unroll
                for (int gg = 0; gg < 8; ++gg) v = (tt == t && gg == g) ? ga[tt][gg] : v;
            if (r0 + t < NROWS) GA[(size_t)(r0 + t) * 8 + g] = v + P.in[I_MBG][j * 8 + g]; }
    }
    __syncthreads();
}
__device__ __forceinline__ float scan_add(float v, int lane) {
#pragma unroll
    for (int o = 1; o < 64; o <<= 1) { const float t = __shfl_up(v, o); if (lane >= o) v += t; }
    return v; }
__device__ __forceinline__ float scan_max(float v, int lane) {
#pragma unroll
    for (int o = 1; o < 64; o <<= 1) { const float t = __shfl_up(v, o); if (lane >= o) v = fmaxf(v, t); }
    return v; }
constexpr int SC_MAXC = (NCH + 7) / 8;
__device__ __forceinline__ void scal_wg(const Params& P, int j, LAS unsigned char* lds, int team, int tid) {
    const float* GA = WSP(float, W_GATES); float* SA = WSP(float, W_SA); float* SCJ = WSP(float, W_SCJ); float* SWI = WSP(float, W_SWI); float* SEM = WSP(float, W_SEM); float* SWK = WSP(float, W_SWK); float* DEC = WSP(float, W_DEC);
    const int wave = tid >> 6, lane = tid & 63;
    LAS float* xg = (LAS float*)lds; LAS float* xp = xg + 64; LAS float* xm = xp + 64;
    if (team < BATCH * 4) { const int b = team >> 2, h = team & 3;
        float bl[SC_MAXC][4], cj[SC_MAXC][4], pex[SC_MAXC];
#pragma unroll
        for (int k = 0; k < SC_MAXC; ++k) { const int c = wave + 8 * k;
            if (c < NCH) { const int row0 = c == 0 ? ROW_META + b * NMETA : b * SEQ + (c - 1) * LCH; const int nper = c == 0 ? 1 : 4; const bool act = c == 0 ? lane < NMETA : true; const int tb = lane * nper;
                float ip[4]; float run = 0.f, pmx = -3.0e38f;
#pragma unroll
                for (int u = 0; u < 4; ++u) { if (u < nper && act) { const int r = row0 + tb + u; ip[u] = GA[(size_t)r * 8 + h]; run += logsigf(GA[(size_t)r * 8 + 4 + h]); } else ip[u] = 0.f; bl[k][u] = run; }
                const float incl = scan_add(run, lane), excl = incl - run;
#pragma unroll
                for (int u = 0; u < 4; ++u) { bl[k][u] += excl; cj[k][u] = (u < nper && act) ? ip[u] - bl[k][u] : -3.0e38f; pmx = fmaxf(pmx, cj[k][u]); }
                const float pin = scan_max(pmx, lane); float pe = __shfl_up(pin, 1); if (lane == 0) pe = -3.0e38f; pex[k] = pe;
                if (lane == 63) { xg[c] = incl; xp[c] = pin; } } }
        __syncthreads();
        if (tid == 0) { float m = 0.f; for (int c = 0; c < NCH; ++c) { xm[c] = m; const float g = xg[c], mn = g + fmaxf(m, xp[c]); DEC[(size_t)team * NCH + c] = __expf(g + m - mn); m = mn; }
            P.out[O_PM + (size_t)j * BATCH * 4 + team] = m; }
        __syncthreads();
#pragma unroll
        for (int k = 0; k < SC_MAXC; ++k) { const int c = wave + 8 * k;
            if (c < NCH) { const int row0 = c == 0 ? ROW_META + b * NMETA : b * SEQ + (c - 1) * LCH; const int nper = c == 0 ? 1 : 4; const bool act = c == 0 ? lane < NMETA : true; const int tb = lane * nper;
                const float m_prev = xm[c], g = xg[c], m_new = g + fmaxf(m_prev, xp[c]); float pr = pex[k];
#pragma unroll
                for (int u = 0; u < 4; ++u) if (u < nper && act) { const int r = row0 + tb + u; pr = fmaxf(pr, cj[k][u]); const float mx = fmaxf(m_prev, pr), mt = bl[k][u] + mx;
                    SA[(size_t)r * 4 + h] = -mx; SCJ[(size_t)r * 4 + h] = cj[k][u]; SWI[(size_t)r * 4 + h] = __expf(m_prev - mx); SEM[(size_t)r * 4 + h] = __expf(-mt); SWK[(size_t)r * 4 + h] = __expf(g + cj[k][u] - m_new); } } }
    } else { for (int k = tid; k < DECB * 4; k += 512) { const int bs = k >> 2, h = k & 3; float m = P.in[I_SM][(size_t)j * DECB * 4 + k]; float dec;
            scal_chunk(GA, h, ROW_SAMP + bs * TS, TS, m, SA, SCJ, SWI, SEM, SWK, dec); DEC[(size_t)BATCH * 4 * NCH + k] = dec; P.out[O_SMM + (size_t)j * DECB * 4 + k] = m; } }
    __syncthreads();
}
__device__ __forceinline__ void hnorm_fast(const Params& P, int j, int r_lo, int gw, int ngw, int lane) {
    const bf16* H = WSP(bf16, W_H); const bf16* OS = WSP(bf16, W_OS); const bf16* XC = WSP(bf16, W_XC); const bf16* ZS = WSP(bf16, W_ZS); bf16* A2 = WSP(bf16, W_A2);
    const float* hn = P.in[I_MHN] + (size_t)j * 2048 + 32 * lane; const float* sk = P.in[I_MSKIP] + (size_t)j * 2048 + 32 * lane;
    bf16x8 hv_[4], os_[4], xc_[4], zs_[4];
    int r = r_lo + gw;
    if (r < NROWS) { const size_t o = (size_t)r * MI + 32 * lane;
#pragma unroll
        for (int q = 0; q < 4; ++q) { hv_[q] = *(const bf16x8*)(H + o + 8 * q); os_[q] = *(const bf16x8*)(OS + o + 8 * q); xc_[q] = *(const bf16x8*)(XC + o + 8 * q); zs_[q] = *(const bf16x8*)(ZS + o + 8 * q); } }
    for (; r < MPAD; r += ngw) { const size_t o = (size_t)r * MI + 32 * lane;
        if (r >= NROWS) {
#pragma unroll
            for (int q = 0; q < 4; ++q) *(u32x4*)(A2 + o + 8 * q) = (u32x4){0u, 0u, 0u, 0u};
            continue; }
        bf16x8 hc[4], oc[4], xcur[4], zc[4];
#pragma unroll
        for (int q = 0; q < 4; ++q) { hc[q] = hv_[q]; oc[q] = os_[q]; xcur[q] = xc_[q]; zc[q] = zs_[q]; }
        const int rn = r + ngw;
        if (rn < NROWS) { const size_t on = (size_t)rn * MI + 32 * lane;
#pragma unroll
            for (int q = 0; q < 4; ++q) { hv_[q] = *(const bf16x8*)(H + on + 8 * q); os_[q] = *(const bf16x8*)(OS + on + 8 * q); xc_[q] = *(const bf16x8*)(XC + on + 8 * q); zs_[q] = *(const bf16x8*)(ZS + on + 8 * q); } }
        float hv[4][8]; float s = 0.f;
#pragma unroll
        for (int q = 0; q < 4; ++q) { unpack8(hc[q], hv[q]);
#pragma unroll
            for (int e = 0; e < 8; ++e) s += hv[q][e]; }
        s += __shfl_xor(s, 1); s += __shfl_xor(s, 2); s += __shfl_xor(s, 4); s += __shfl_xor(s, 8);
        const float mu = s * (1.f / 512.f); float qq = 0.f;
#pragma unroll
        for (int q = 0; q < 4; ++q)
#pragma unroll
            for (int e = 0; e < 8; ++e) { const float dl = hv[q][e] - mu; qq += dl * dl; }
        qq += __shfl_xor(qq, 1); qq += __shfl_xor(qq, 2); qq += __shfl_xor(qq, 4); qq += __shfl_xor(qq, 8);
        const float rs = 1.f / sqrtf(qq * (1.f / 512.f) + EPS);
#pragma unroll
        for (int q = 0; q < 4; ++q) { float os[8], xc[8], zs[8], res[8];
            unpack8(oc[q], os); unpack8(xcur[q], xc); unpack8(zc[q], zs);
            const f32x4 n0 = *(const f32x4*)(hn + 8 * q), n1 = *(const f32x4*)(hn + 8 * q + 4), k0 = *(const f32x4*)(sk + 8 * q), k1 = *(const f32x4*)(sk + 8 * q + 4);
#pragma unroll
            for (int e = 0; e < 8; ++e) { const float nwe = e < 4 ? n0[e & 3] : n1[e & 3], kwe = e < 4 ? k0[e & 3] : k1[e & 3]; res[e] = (os[e] * ((hv[q][e] - mu) * rs * nwe) + kwe * xc[e]) * zs[e]; }
            *(bf16x8*)(A2 + o + 8 * q) = pack8(res); }
    }
}
__device__ __forceinline__ void hnorm_block(const Params& P, int j, int tt, int h, int wave, int lane) {
    const bf16* H = WSP(bf16, W_H); const bf16* OS = WSP(bf16, W_OS); const bf16* XC = WSP(bf16, W_XC); const bf16* ZS = WSP(bf16, W_ZS); bf16* A2 = WSP(bf16, W_A2);
    const int sub = lane & 15, rq = lane >> 4; const int col = h * 512 + 32 * sub;
    const float* hn = P.in[I_MHN] + (size_t)j * 2048 + col; const float* sk = P.in[I_MSKIP] + (size_t)j * 2048 + col;
    bf16x8 hv_[4], os_[4], xc_[4], zs_[4];
    { const size_t o = (size_t)(tt * 256 + wave * 4 + rq) * MI + col;
#pragma unroll
      for (int q = 0; q < 4; ++q) { hv_[q] = *(const bf16x8*)(H + o + 8 * q); os_[q] = *(const bf16x8*)(OS + o + 8 * q); xc_[q] = *(const bf16x8*)(XC + o + 8 * q); zs_[q] = *(const bf16x8*)(ZS + o + 8 * q); } }
#pragma unroll 1
    for (int it = 0; it < 8; ++it) { const size_t o = (size_t)(tt * 256 + it * 32 + wave * 4 + rq) * MI + col;
        bf16x8 hc[4], oc[4], xcur[4], zc[4];
#pragma unroll
        for (int q = 0; q < 4; ++q) { hc[q] = hv_[q]; oc[q] = os_[q]; xcur[q] = xc_[q]; zc[q] = zs_[q]; }
        if (it < 7) { const size_t on = o + (size_t)32 * MI;
#pragma unroll
            for (int q = 0; q < 4; ++q) { hv_[q] = *(const bf16x8*)(H + on + 8 * q); os_[q] = *(const bf16x8*)(OS + on + 8 * q); xc_[q] = *(const bf16x8*)(XC + on + 8 * q); zs_[q] = *(const bf16x8*)(ZS + on + 8 * q); } }
        float hv[4][8]; float s = 0.f;
#pragma unroll
        for (int q = 0; q < 4; ++q) { unpack8(hc[q], hv[q]);
#pragma unroll
            for (int e8 = 0; e8 < 8; ++e8) s += hv[q][e8]; }
        s += __shfl_xor(s, 1); s += __shfl_xor(s, 2); s += __shfl_xor(s, 4); s += __shfl_xor(s, 8);
        const float mu = s * (1.f / 512.f); float qq = 0.f;
#pragma unroll
        for (int q = 0; q < 4; ++q)
#pragma unroll
            for (int e8 = 0; e8 < 8; ++e8) { const float dl = hv[q][e8] - mu; qq += dl * dl; }
        qq += __shfl_xor(qq, 1); qq += __shfl_xor(qq, 2); qq += __shfl_xor(qq, 4); qq += __shfl_xor(qq, 8);
        const float rs = 1.f / sqrtf(qq * (1.f / 512.f) + EPS);
#pragma unroll
        for (int q = 0; q < 4; ++q) { float os[8], xc[8], zs[8], res[8];
            unpack8(oc[q], os); unpack8(xcur[q], xc); unpack8(zc[q], zs);
            const f32x4 n0 = *(const f32x4*)(hn + 8 * q), n1 = *(const f32x4*)(hn + 8 * q + 4), k0 = *(const f32x4*)(sk + 8 * q), k1 = *(const f32x4*)(sk + 8 * q + 4);
#pragma unroll
            for (int e8 = 0; e8 < 8; ++e8) { const float nwe = e8 < 4 ? n0[e8 & 3] : n1[e8 & 3], kwe = e8 < 4 ? k0[e8 & 3] : k1[e8 & 3]; res[e8] = (os[e8] * ((hv[q][e8] - mu) * rs * nwe) + kwe * xc[e8]) * zs[e8]; }
            *(bf16x8*)(A2 + o + 8 * q) = pack8(res); }
    }
}
template <class ColMap>
__device__ __forceinline__ void transpose_item(const float* W, int K, int N, bf16* WT, int ldt, ColMap cmap, float scale, LAS float* scr, int item, int lane) {
    const int nblk = N / 32, kb = item / nblk, nb = item % nblk, k0 = 64 * kb, n0 = 32 * nb;
    float tv[32];
#pragma unroll
    for (int i = 0; i < 32; ++i) tv[i] = W[(size_t)(k0 + 2 * i + (lane >> 5)) * N + cmap(n0 + (lane & 31))];
#pragma unroll
    for (int i = 0; i < 32; ++i) scr[(2 * i + (lane >> 5)) * 33 + (lane & 31)] = tv[i];
    asm volatile("s_waitcnt lgkmcnt(0)" ::: "memory");
    const int c = lane & 7;
#pragma unroll
    for (int jj = 0; jj < 4; ++jj) { const int n = (lane >> 3) + 8 * jj; const LAS float* s = scr + (8 * c) * 33 + n;
        u32x4 o; o[0] = pg8::cvt_pk_bf16(s[0 * 33] * scale, s[1 * 33] * scale); o[1] = pg8::cvt_pk_bf16(s[2 * 33] * scale, s[3 * 33] * scale); o[2] = pg8::cvt_pk_bf16(s[4 * 33] * scale, s[5 * 33] * scale); o[3] = pg8::cvt_pk_bf16(s[6 * 33] * scale, s[7 * 33] * scale);
        *(u32x4*)(WT + (size_t)(n0 + n) * ldt + k0 + 8 * c) = o; }
    asm volatile("s_waitcnt lgkmcnt(0)" ::: "memory");
}
struct MapId { __device__ __forceinline__ int operator()(int n) const { return n; } };
struct MapSwa { __device__ __forceinline__ int operator()(int n) const { return swa_pos2orig(n); } };
__device__ __forceinline__ void convert_set(const Params& P, LAS unsigned char* lds, int set, int iw, int nw, int wave, int lane) {
    const float* wq_ = lp(P.in[I_MWQ]); const float* wk_ = lp(P.in[I_MWK]); const float* wv_ = lp(P.in[I_MWV]);
    LAS float* scr = (LAS float*)(lds + wave * 16384);
    constexpr int I_SW = (D / 64) * (SWA_N / 32), I_SO = (D / 64) * (D / 32), I_MW = (D / 64) * (ML_N / 32), I_QK = (512 / 64) * (512 / 32), I_MO = (MI / 64) * (D / 32);
    constexpr int N_SWA = I_SW + I_SO, N_ML = I_MW + 12 * I_QK + I_MO;
    const int total = set == 0 ? N_SWA : set == 1 ? N_ML : N_SWA + N_ML;
    for (int it = iw; it < total; it += nw) { int r = it; int j = set == 0 ? 0 : set == 1 ? 0 : 1; bool swa = set == 0;
        if (set == 2) { if (r < N_SWA) swa = true; else r -= N_SWA; }
        if (swa) {
            if (r < I_SW) { transpose_item(P.in[I_SWIN] + (size_t)j * D * SWA_N, D, SWA_N, WSP(bf16, W_SWIN) + (size_t)j * SWA_N * D, D, MapSwa(), 1.f, scr, r, lane); continue; } r -= I_SW;
            transpose_item(P.in[I_SWOUT] + (size_t)j * D * D, D, D, WSP(bf16, W_SWOUT) + (size_t)j * D * D, D, MapId(), 1.f, scr, r, lane); continue; }
        if (r < I_MW) { transpose_item(P.in[I_MWIN] + (size_t)j * D * ML_N, D, ML_N, WSP(bf16, W_MWIN) + (size_t)j * ML_N * D, D, MapId(), 1.f, scr, r, lane); continue; } r -= I_MW;
        if (r < 12 * I_QK) { const int w = r / (4 * I_QK), h = (r / I_QK) % 4, q = r % I_QK;
            transpose_item((w == 0 ? wq_ : w == 1 ? wk_ : wv_) + ((size_t)j * 4 + h) * 512 * 512, 512, 512, WSP(bf16, W_MWQ) + (size_t)(j * 3 + w) * 4 * 512 * 512 + h * 512, 2048, MapId(), w == 1 ? 0.044194173824159216f : 1.f, scr, q, lane); continue; } r -= 12 * I_QK;
        transpose_item(P.in[I_MWOUT] + (size_t)j * MI * D, MI, D, WSP(bf16, W_MWOUT) + (size_t)j * D * MI, MI, MapId(), 1.f, scr, r, lane);
    }
}
__device__ __forceinline__ void prologue_fast(const Params& P, LAS unsigned char* lds, int gw, int ngw, int wave, int lane, long gt, long gs) {
    const float* wq_ = lp(P.in[I_MWQ]); const float* wk_ = lp(P.in[I_MWK]); const float* wv_ = lp(P.in[I_MWV]);
    convert_set(P, lds, 0, gw, ngw, wave, lane);
    { float* bt = WSP(float, W_BIAS); const float* rb = P.in[I_RELB]; for (long i = gt; i < 16 * 132; i += gs) { const int h = (int)(i / 132), dd = (int)(i % 132); bt[i] = rb[rel_bucket(dd > 128 ? 128 : dd) * 16 + h]; } }
}
__device__ __forceinline__ void gmat_items(const Params& P, int j, int it0, int n, int wave, int lane) {
    const float* wq_ = lp(P.in[I_MWQ]); const float* wk_ = lp(P.in[I_MWK]); const float* wv_ = lp(P.in[I_MWV]);
    float* G = WSP(float, W_G);
    for (int it = it0 + wave; it < it0 + n; it += 8) { const int d = it & 511, h = (it >> 9) & 3, kg = (it >> 11) & 1;
        float a[8];
#pragma unroll
        for (int g = 0; g < 8; ++g) a[g] = 0.f;
        for (int part = 0; part < (kg == 0 ? 2 : 1); ++part) { const int w = kg == 0 ? part : 2; const float sc = w == 1 ? 0.044194173824159216f : 1.f;
            const float* wr = (w == 0 ? wq_ : w == 1 ? wk_ : wv_) + (((size_t)j * 4 + h) * 512 + d) * 512 + 8 * lane; const float* wg = P.in[I_MWG] + (size_t)j * 6144 * 8 + (size_t)(w * 2048 + h * 512 + 8 * lane) * 8;
            const f32x4 x0 = *(const f32x4*)wr * sc, x1 = *(const f32x4*)(wr + 4) * sc;
#pragma unroll
            for (int e8 = 0; e8 < 8; ++e8) { const float x = e8 < 4 ? x0[e8 & 3] : x1[e8 & 3]; const f32x4 g0 = *(const f32x4*)(wg + e8 * 8), g1 = *(const f32x4*)(wg + e8 * 8 + 4);
#pragma unroll
                for (int g = 0; g < 4; ++g) { a[g] += x * g0[g]; a[4 + g] += x * g1[g]; } } }
#pragma unroll
        for (int g = 0; g < 8; ++g) a[g] = wsum(a[g]);
        if (lane < 8) { float v = 0.f;
#pragma unroll
            for (int g = 0; g < 8; ++g) v = lane == g ? a[g] : v;
            G[(size_t)j * 4096 * 8 + (size_t)(kg * 2048 + h * 512 + d) * 8 + lane] = v; } }
}
__device__ __forceinline__ int wq_pull(unsigned* ctr, LAS unsigned* slot, int tid);
__device__ __forceinline__ void gmat_deferred(const Params& P, int j, unsigned* ctr, LAS unsigned* slot, int tid) {
    for (;;) { const int c = wq_pull(ctr, slot, tid); if (c >= 256) break; gmat_items(P, j, c * 16, 16, tid >> 6, tid & 63); }
}
__device__ __forceinline__ void cache_part(const Params& P, int part, long gt, long gs) {
    bf16* KC = WSP(bf16, W_KC); bf16* VTC = WSP(bf16, W_VTC);
    const float* cmk = lp(P.in[I_CMK]); const float* ck = lp(P.in[I_CK]); const float* cmv = lp(P.in[I_CMV]); const float* cv = lp(P.in[I_CV]);
    if (part < 2) { const long jb0 = (long)part * DECB;
        for (long i = gt; i < (long)DECB * KCN * 32; i += gs) { const int c8 = (int)(i % 32) * 8, key = (int)((i / 32) % KCN); const long jb = jb0 + i / (32 * KCN);
            float f[8];
#pragma unroll
            for (int e = 0; e < 8; ++e) f[e] = 0.f;
            const float* src = key < 16 ? cmk + ((size_t)jb * 16 + key) * 256 + c8 : key < 144 ? ck + ((size_t)jb * 128 + key - 16) * 256 + c8 : nullptr;
            if (src) { const f32x4 a = *(const f32x4*)src, b = *(const f32x4*)(src + 4);
#pragma unroll
                for (int e = 0; e < 4; ++e) { f[e] = a[e]; f[4 + e] = b[e]; } }
            *(bf16x8*)(KC + ((size_t)jb * KCN + key) * 256 + c8) = pack8(f); }
        for (long i = gt; i < (long)DECB * 256 * (KCN / 8); i += gs) { const int c = (int)(i % 256), k8 = (int)((i / 256) % (KCN / 8)) * 8; const long jb = jb0 + i / (256 * (KCN / 8));
            float f[8];
#pragma unroll
            for (int e = 0; e < 8; ++e) { const int key = k8 + e; f[e] = key < 16 ? cmv[((size_t)jb * 16 + key) * 256 + c] : key < 144 ? cv[((size_t)jb * 128 + key - 16) * 256 + c] : 0.f; }
            *(bf16x8*)(VTC + ((size_t)jb * 256 + c) * KCN + k8) = pack8(f); }
    } else { const float* src = part == 2 ? ck : cv; float* dst = P.out + (part == 2 ? O_SK : O_SV);
        for (long i = gt; i < 2L * DECB * 124 * 64; i += gs) { const int c4 = (int)(i % 64) * 4, key = (int)((i / 64) % 124); const long jb = i / (64 * 124);
            *(f32x4*)(dst + ((size_t)jb * 128 + key) * 256 + c4) = *(const f32x4*)(src + ((size_t)jb * 128 + key + 4) * 256 + c4); } }
}
__device__ __forceinline__ int wq_pull(unsigned* ctr, LAS unsigned* slot, int tid);
__device__ __forceinline__ void cache_deferred(const Params& P, int part, unsigned* ctr, LAS unsigned* slot, int tid) {
    constexpr int NCHUNK = 256;
    for (;;) { const int c = wq_pull(ctr, slot, tid); if (c >= NCHUNK) break; cache_part(P, part, (long)c * 512 + tid, (long)NCHUNK * 512); }
}
__device__ __forceinline__ void sample_item(const Params& P, int j, LAS unsigned char* lds, int it, int tid) {
    const int bs = it >> 2, h = it & 3, row0 = ROW_SAMP + bs * TS, wave = tid >> 6, lane = tid & 63;
    LAS float* qk = (LAS float*)lds;
    LAS float* red = (LAS float*)(lds + 16384);
    LAS float* sc = (LAS float*)(lds + 16384 + 32768);
    LAS float* vs = (LAS float*)(lds + 16384 + 32768 + 1024);
    const bf16* Q = WSP(bf16, W_MQ); const bf16* K = WSP(bf16, W_MK); const bf16* VT = WSP(bf16, W_MVT); bf16* H = WSP(bf16, W_H);
    const size_t so = (((size_t)j * DECB + bs) * 4 + h) * 512 * 512, no = (((size_t)j * DECB + bs) * 4 + h) * 512;
    const float* cin = P.in[I_SC] + so; float* cout = P.out + O_SCC + so; const float* nin = P.in[I_SN] + no;
    const int e4 = (tid & 127) * 4, dq = tid >> 7;
    const float* cp = cin + (size_t)(dq * 128) * 512 + e4; float* op = cout + (size_t)(dq * 128) * 512 + e4;
    f32x4 ca[8], cb[8], cc[8];
#define SI_LOAD(blk, r0) do { _Pragma("unroll") for (int u = 0; u < 8; ++u) blk[u] = __builtin_nontemporal_load((const f32x4*)(cp + (size_t)((r0) + u) * 512)); __builtin_amdgcn_sched_barrier(0); } while (0)
    SI_LOAD(ca, 0); SI_LOAD(cb, 8);
    { const int d = tid;
#pragma unroll
      for (int t = 0; t < 4; ++t) { qk[d * 8 + t] = bf2f(Q[(size_t)(row0 + t) * MI + h * 512 + d]); qk[d * 8 + 4 + t] = bf2f(K[(size_t)(row0 + t) * MI + h * 512 + d]); vs[t * 512 + d] = bf2f(VT[vtb_idx(row0 + t, h, d)]); } }
    __syncthreads();
    for (int idx = wave; idx < 14; idx += 8) { int t, jj; float a = 0.f;
        if (idx < 10) { t = idx < 1 ? 0 : idx < 3 ? 1 : idx < 6 ? 2 : 3; jj = idx - (t * (t + 1)) / 2;
            for (int d = lane; d < 512; d += 64) a += qk[d * 8 + t] * qk[d * 8 + 4 + jj];
            a = wsum(a); if (lane == 0) sc[t * 4 + jj] = a; }
        else { t = idx - 10; for (int d = lane; d < 512; d += 64) a += qk[d * 8 + t] * nin[d]; a = wsum(a); if (lane == 0) sc[16 + t] = a; } }
    __syncthreads();
    if (tid < 4) { const int t = tid, r = row0 + t; const float sa = WSP(float, W_SA)[(size_t)r * 4 + h], wi = WSP(float, W_SWI)[(size_t)r * 4 + h]; float s = 0.f;
        for (int jj = 0; jj < 4; ++jj) { float p = 0.f; if (jj <= t) p = sc[t * 4 + jj] * __expf(sa + WSP(float, W_SCJ)[(size_t)(row0 + jj) * 4 + h]); sc[32 + t * 4 + jj] = p; s += p; }
        const float den = s + wi * sc[16 + t]; sc[48 + t] = fmaxf(fabsf(den), WSP(float, W_SEM)[(size_t)r * 4 + h]); sc[52 + t] = wi; sc[56 + t] = WSP(float, W_SWK)[(size_t)r * 4 + h];
        if (t == 0) sc[60] = WSP(float, W_DEC)[(size_t)BATCH * 4 * NCH + it]; }
    __syncthreads();
    const float dec = sc[60];
    f32x4 wv[4], acc[4];
#pragma unroll
    for (int t = 0; t < 4; ++t) { wv[t] = *(const LAS f32x4*)(vs + t * 512 + e4) * sc[56 + t]; acc[t] = (f32x4){0.f, 0.f, 0.f, 0.f}; }
    const LAS float* qp = qk + (dq * 128) * 8;
#define SI_PROC(blk, r0) do { _Pragma("unroll") for (int u = 0; u < 8; ++u) { const f32x4 qv = *(const LAS f32x4*)(qp + ((r0) + u) * 8), kv = *(const LAS f32x4*)(qp + ((r0) + u) * 8 + 4); \
        f32x4 o = blk[u] * dec; _Pragma("unroll") for (int t = 0; t < 4; ++t) { acc[t] += blk[u] * qv[t]; o += wv[t] * kv[t]; } \
        __builtin_nontemporal_store(o, (f32x4*)(op + (size_t)((r0) + u) * 512)); __builtin_amdgcn_sched_barrier(0); } } while (0)
#pragma unroll 1
    for (int d0 = 0; d0 < 120; d0 += 24) {
        SI_LOAD(cc, d0 + 16); SI_PROC(ca, d0);
        SI_LOAD(ca, d0 + 24); SI_PROC(cb, d0 + 8);
        SI_LOAD(cb, (d0 + 32 < 128 ? d0 + 32 : 120)); SI_PROC(cc, d0 + 16); }
    SI_PROC(ca, 120);
#undef SI_LOAD
#undef SI_PROC
#pragma unroll
    for (int t = 0; t < 4; ++t) *(LAS f32x4*)(red + (dq * 4 + t) * 512 + e4) = acc[t];
    __syncthreads();
    { const int e = tid;
#pragma unroll
      for (int t = 0; t < 4; ++t) { float a = (red[(0 * 4 + t) * 512 + e] + red[(1 * 4 + t) * 512 + e]) + (red[(2 * 4 + t) * 512 + e] + red[(3 * 4 + t) * 512 + e]); a *= sc[52 + t];
#pragma unroll
          for (int jj = 0; jj < 4; ++jj) a += sc[32 + t * 4 + jj] * vs[jj * 512 + e];
          H[(size_t)(row0 + t) * MI + h * 512 + e] = f2bf(a / sc[48 + t]); }
      float n = dec * nin[e];
#pragma unroll
      for (int t = 0; t < 4; ++t) n += sc[56 + t] * qk[e * 8 + 4 + t];
      P.out[O_SNN + no + e] = n; }
    __syncthreads();
}
__device__ __forceinline__ int wq_pull(unsigned* ctr, LAS unsigned* slot, int tid) {
    if (tid == 0) *slot = __hip_atomic_fetch_add(ctr, 1u, __ATOMIC_RELAXED, __HIP_MEMORY_SCOPE_AGENT);
    __syncthreads(); const int v = (int)*slot; __syncthreads(); return v;
}
__device__ __forceinline__ void meta_scores(const Params& P, int wv, int nwv, int lane) {
    const bf16* Q = WSP(bf16, W_MQ); const bf16* K = WSP(bf16, W_MK); const float* SA = WSP(float, W_SA); const float* SCJ = WSP(float, W_SCJ); float* PSM = WSP(float, W_PSM); float* DEN = WSP(float, W_DEN);
    for (int i = wv; i < BATCH * 4 * NMETA; i += nwv) { const int it = i >> 4, t = i & 15, b = it >> 2, h = it & 3, row0 = ROW_META + b * NMETA, r = row0 + t;
        float qv[8]; unpack8(*(const bf16x8*)(Q + (size_t)r * MI + h * 512 + 8 * lane), qv); float s = 0.f;
        for (int jj = 0; jj < NMETA; ++jj) { float v = 0.f;
            if (jj <= t) { float kv[8]; unpack8(*(const bf16x8*)(K + (size_t)(row0 + jj) * MI + h * 512 + 8 * lane), kv); float a = 0.f;
#pragma unroll
                for (int e8 = 0; e8 < 8; ++e8) a += qv[e8] * kv[e8];
                v = wsum(a) * __expf(SA[(size_t)r * 4 + h] + SCJ[(size_t)(row0 + jj) * 4 + h]); }
            if (lane == 0) PSM[(size_t)it * 256 + t * 16 + jj] = v; s += v; }
        if (lane == 0) DEN[(size_t)r * 4 + h] = s; }
}
}
constexpr int LDS_MISC_OFF = 131072, LDS_BYTES = 147456;
constexpr int CW_BAR = 4096, CW_QUEUE = 16384;
#ifndef QA_ITEMS
#define QA_ITEMS (DECB * 4)
#endif
#define GAS __attribute__((address_space(1)))
template <class T> __device__ __forceinline__ T* GP(T* p) { return (T*)(T GAS*)p; }
template <class T> __device__ __forceinline__ T* GPL(T* p) { T GAS* g = (T GAS*)p; asm volatile("" : "+s"(g)); return (T*)g; }
__global__ void __launch_bounds__(512, 2) mega(Params P) {
    extern __shared__ __attribute__((aligned(16))) unsigned char lds[];
    LAS unsigned char* ldsb = (LAS unsigned char*)lds;
    LAS unsigned* misc = (LAS unsigned*)(ldsb + LDS_MISC_OFF);
    if (threadIdx.x < 64) misc[threadIdx.x] = 0u;
    __syncthreads();
    XcdBarrier bar = xcd_barrier_post((unsigned*)(P.ws + W_CTL) + CW_BAR, (volatile LAS unsigned*)(misc + 8));
    const long gt = (long)blockIdx.x * 512 + threadIdx.x, gs = (long)gridDim.x * 512;
    const int G = (int)gridDim.x, cwg = (int)blockIdx.x;
#define LAUNDER() Params Pl = P; { Pl.ws = GPL(Pl.ws); Pl.out = GPL(Pl.out); \
    _Pragma("unroll") for (int i_ = 0; i_ < N_IN; ++i_) Pl.in[i_] = GP(Pl.in[i_]); } long gtl = gt; asm volatile("" : "+v"(gtl))
#define RUNNB(ph, a0, a1) do { LAUNDER(); dispatch<ph>(Pl, a0, a1, gtl, gs); } while (0)
#define RUN(ph, a0, a1) do { RUNNB(ph, a0, a1); xcd_barrier(bar); } while (0)
#define BAR() xcd_barrier(bar)
#ifndef PR_A
#define PR_A 1
#endif
#ifndef PR_A2
#define PR_A2 PR_A
#endif
#ifndef PR_A3
#define PR_A3 PR_A
#endif
#ifndef PR_A3_KMODE
#define PR_A3_KMODE 0
#endif
#ifndef PR_F
#define PR_F 0
#endif
#ifndef PR_B
#define PR_B 1
#endif
#ifndef PR_C
#define PR_C 1
#endif
#ifndef PR_D
#define PR_D 1
#endif
#ifndef PR_D1
#define PR_D1 PR_D
#endif
#ifndef PR_D2
#define PR_D2 PR_D
#endif
#ifndef PR_D3
#define PR_D3 PR_D
#endif
#ifndef PR_D4
#define PR_D4 PR_D
#endif
#ifndef PR_D5
#define PR_D5 PR_D
#endif
#ifndef PR_E
#define PR_E 1
#endif
#define REP(n) for (int rp_ = 0; rp_ < (n); ++rp_)
#define WV_ARGS (int)(gtl >> 6), G * 8, (int)(gtl & 63)
    REP(PR_E) {
    { LAUNDER(); el::prologue_fast(Pl, ldsb, (int)(gtl >> 6), G * 8, (int)((gtl >> 6) & 7), (int)(gtl & 63), gtl, gs); el::cache_part(Pl, 0, gtl, gs); }
    BAR(); }
    for (int layer = 0; layer < 4; ++layer) {
        const int j = layer >> 1;
        REP(PR_D1) { { LAUNDER(); el::norm_fast(Pl, layer, WV_ARGS); }
        BAR(); }
        if ((layer & 1) == 0) {
            REP(PR_A) { { LAUNDER(); pg8::PlainOrder S; S.init(WSP2(Pl, bf16, W_XN), D, WSP2(Pl, bf16, W_SWIN) + (size_t)j * SWA_N * D, D, MPAD, SWA_N, D, G, cwg);
              pg8::EpiSwaIn E{Pl, j}; pg8::gemm_phase(ldsb, D, D, S, E);
              constexpr int NU = (MPAD / 256) * (SWA_N / 256); const int first_idle = NU % G;
              if (layer == 2) el::cache_deferred(Pl, 2, (unsigned*)(Pl.ws + W_CTL) + CW_QUEUE + (20 + rp_) * 64, misc + 16, (int)(gtl & 511));
              if (layer == 0 && cwg >= first_idle) el::convert_set(Pl, ldsb, 1, (cwg - first_idle) * 8 + (int)((gtl >> 6) & 7), (G - first_idle) * 8, (int)((gtl >> 6) & 7), (int)(gtl & 63)); }
            BAR(); }
            REP(PR_B) { RUNNB(PH_SWAOUT, j, 0);
            { LAUNDER(); at::att_phase(Pl, j, ldsb, (int)(gtl >> 6), G * 8, (int)(gtl & 511)); }
            BAR(); }
            for (int rp_ = PR_F; rp_ >= 0; --rp_) { { LAUNDER(); pg8::SplitTailOrder S; S.init(WSP2(Pl, bf16, W_OG), D, WSP2(Pl, bf16, W_SWOUT) + (size_t)j * D * D, D, D, G, cwg);
              pg8::EpiResid E{Pl.in[I_XP], WSP2(Pl, bf16, W_X16), WSP2(Pl, float, W_X), Pl.out, layer == 0 ? 0 : 1, rp_ ? (long)(512u << 20) / 4 : 0L}; pg8::gemm_phase(ldsb, D, D, S, E); }
            { LAUNDER(); el::gmat_deferred(Pl, j, (unsigned*)(Pl.ws + W_CTL) + CW_QUEUE + (28 + j * 2 + rp_) * 64, misc + 16, (int)(gtl & 511)); }
            BAR(); }
        } else {
            REP(PR_A2) { { LAUNDER(); pg8::PlainOrder S; S.init(WSP2(Pl, bf16, W_XN), D, WSP2(Pl, bf16, W_MWIN) + (size_t)j * ML_N * D, D, MPAD, ML_N, D, G, cwg);
              pg8::EpiMlIn E{Pl, j}; pg8::gemm_phase(ldsb, D, D, S, E);
              constexpr int NU = (MPAD / 256) * (ML_N / 256); const int first_idle = NU % G;
              if (layer == 3) el::cache_deferred(Pl, 3, (unsigned*)(Pl.ws + W_CTL) + CW_QUEUE + (24 + rp_) * 64, misc + 16, (int)(gtl & 511));
              if (layer == 1 && cwg >= first_idle) el::convert_set(Pl, ldsb, 2, (cwg - first_idle) * 8 + (int)((gtl >> 6) & 7), (G - first_idle) * 8, (int)((gtl >> 6) & 7), (int)(gtl & 63)); }
            BAR(); }
            REP(PR_D2) { { LAUNDER(); el::convgates_fast(Pl, j, ldsb, WV_ARGS, (int)(gtl & 511)); }
            BAR(); }
            constexpr int NSCG = BATCH * 4 + 1;
            REP(PR_A3) { if (cwg >= G - NSCG) { LAUNDER(); el::scal_wg(Pl, j, ldsb, cwg - (G - NSCG), (int)(gtl & 511)); }
            else
            { LAUNDER(); pg8::M3Order S{(const char*)WSP2(Pl, bf16, W_XC), (const char*)WSP2(Pl, bf16, W_XM), (const char*)(WSP2(Pl, bf16, W_MWQ) + (size_t)j * 3 * 4 * 512 * 512), MPAD / 256, G - NSCG, cwg, rp_ == 0 ? 0 : PR_A3_KMODE};
              pg8::EpiM3 E{Pl}; pg8::gemm_phase(ldsb, MI, MI, S, E); }
            if (layer == 1) { LAUNDER(); el::cache_deferred(Pl, 1, (unsigned*)(Pl.ws + W_CTL) + CW_QUEUE + (16 + rp_) * 64, misc + 16, (int)(gtl & 511)); }
            BAR(); }
            constexpr int NSAMP_A = QA_ITEMS;
            constexpr int NSTW = BATCH * 4 * 16;
            REP(PR_C) { if (cwg < NSTW) {
                { LAUNDER(); st::state_scan(Pl, j, ldsb, cwg, (int)threadIdx.x); }
                { LAUNDER(); pg8::POrder S{(const char*)WSP2(Pl, bf16, W_MQ), (const char*)WSP2(Pl, bf16, W_MK), (NP / 256) * 4, NSTW, cwg};
                  pg8::EpiP E{Pl}; pg8::gemm_phase(ldsb, MI, MI, S, E); } }
            else { LAUNDER(); el::meta_scores(Pl, (int)(gtl >> 6) - NSTW * 8, (G - NSTW) * 8, (int)(gtl & 63)); }
            { LAUNDER(); unsigned* ctr = (unsigned*)(Pl.ws + W_CTL) + CW_QUEUE + (j * 2 + rp_ * 4) * 64; for (;;) { const int it = el::wq_pull(ctr, misc + 16, (int)(gtl & 511)); if (it >= NSAMP_A) break; el::sample_item(Pl, j, ldsb, it, (int)(gtl & 511)); } }
            BAR(); }
            REP(PR_D3) { { LAUNDER(); ph_den_fast(Pl, (int)(gtl >> 6), G * 8, (int)(gtl & 63)); }
            RUNNB(PH_SMALLM, j, 1);
            { LAUNDER(); unsigned* ctr = (unsigned*)(Pl.ws + W_CTL) + CW_QUEUE + (j * 2 + 1 + rp_ * 4) * 64; for (;;) { const int it = NSAMP_A + el::wq_pull(ctr, misc + 16, (int)(gtl & 511)); if (it >= DECB * 4) break; el::sample_item(Pl, j, ldsb, it, (int)(gtl & 511)); } }
            BAR(); }
            REP(PR_D4) {
            { LAUNDER(); el::hnorm_fast(Pl, j, NP, WV_ARGS); }
            { LAUNDER(); pg8::NumOrder S{(const char*)WSP2(Pl, bf16, W_MQ), (const char*)WSP2(Pl, bf16, W_P), (const char*)WSP2(Pl, bf16, W_CT), (const char*)WSP2(Pl, bf16, W_MVT), (NP / 256) * 4, G, cwg};
              pg8::EpiNum E{Pl}; pg8::gemm_phase(ldsb, MI, MI, S, E);
              asm volatile("s_waitcnt vmcnt(0)" ::: "memory"); __syncthreads(); __builtin_amdgcn_fence(__ATOMIC_ACQUIRE, "agent"); asm volatile("s_waitcnt vmcnt(0)" ::: "memory");
              for (int k = 0;; ++k) { const int id = S.job(k); if (id < 0) break; el::hnorm_block(Pl, j, id >> 2, id & 3, (int)((gtl >> 6) & 7), (int)(gtl & 63)); } }
            BAR(); }
            for (int rp_ = PR_F; rp_ >= 0; --rp_) { { LAUNDER(); pg8::SplitTailOrder S; S.init(WSP2(Pl, bf16, W_A2), MI, WSP2(Pl, bf16, W_MWOUT) + (size_t)j * D * MI, MI, MI, G, cwg);
              pg8::EpiResid E{Pl.in[I_XP], WSP2(Pl, bf16, W_X16), WSP2(Pl, float, W_X), Pl.out, layer == 3 ? 2 : 1, rp_ ? (long)(512u << 20) / 4 : 0L}; pg8::gemm_phase(ldsb, MI, MI, S, E); }
            BAR(); }
        }
    }
    { LAUNDER(); const float* X = WSP2(Pl, float, W_X) + (size_t)ROW_SAMP * D; float* ys = Pl.out + O_YS; for (long i = gtl; i < (long)NS * D / 4; i += gs) *(pg8::f32x4*)(ys + 4 * i) = *(const pg8::f32x4*)(X + 4 * i); }
}
extern "C" void kernel_launch(void* const* d_in, const int* in_sizes, int n_in, void* d_out, int out_size, void* d_ws, size_t ws_size, hipStream_t stream) {
    Params P; memset(&P, 0, sizeof(P));
    for (int i = 0; i < N_IN; ++i) P.in[i] = (const float*)d_in[i];
    P.out = (float*)d_out; P.ws = (unsigned char*)d_ws;
    if (ws_size < W_END) { fprintf(stderr, "ws too small: %zu < %zu\n", ws_size, (size_t)W_END); return; }
    static int grid = 0;
    if (!grid) {
        int dev = 0, cus = 0, per_cu = 0;
        (void)hipGetDevice(&dev);
        (void)hipDeviceGetAttribute(&cus, hipDeviceAttributeMultiprocessorCount, dev);
        (void)hipFuncSetAttribute((const void*)mega, hipFuncAttributeMaxDynamicSharedMemorySize, LDS_BYTES);
        (void)hipOccupancyMaxActiveBlocksPerMultiprocessor(&per_cu, mega, 512, LDS_BYTES);
        if (per_cu < 1) { fprintf(stderr, "mega: occupancy query says 0 blocks per CU\n"); per_cu = 1; }
        grid = cus;
    }
    (void)hipMemsetAsync(P.ws + W_CTL, 0, 1u << 20, stream);
    mega<<<grid, 512, LDS_BYTES, stream>>>(P);
}
```
